# Optimizing an MI355X kernel written in HIP

```python
import math
import numpy as np
import jax
import jax.numpy as jnp
from jax import lax

D_MODEL = 1024
BATCH = 2
SEQ = 16384
DEPTH = 4

GRID_W = 64
N_EVEN = (DEPTH + 1) // 2
N_ODD = DEPTH // 2

NA_HEADS = 8
NA_HEAD_DIM = D_MODEL // 16
NA_WIDTH = NA_HEADS * NA_HEAD_DIM
NA_KH_MAX = 8
NA_KW = 16

RW_HEADS = 8
RW_HEAD_DIM = D_MODEL // 16
RW_WIDTH = RW_HEADS * RW_HEAD_DIM
RW_W_LORA = 64
RW_A_LORA = 64
RW_G_LORA = 128
RW_DECAY_SCALE = 0.606531
RW_GN_EPS = 64e-5
RW_PROJ = 3 * RW_WIDTH + 2 * RW_W_LORA + 2 * RW_A_LORA + RW_G_LORA
AB_PROJ = 3 * NA_WIDTH + RW_PROJ
MIX_WIDTH = NA_WIDTH + RW_WIDTH

HY_ORDER = 2
HY_EMB = 33
HY_FILTER_HIDDEN = 64
HY_FAST_DECAY_PCT = 0.3
HY_SLOW_DECAY_PCT = 1.5
HY_DECAY_TARGET = 1e-2

N_EXPERTS = 32
N_GROUPS = 8
EXPERTS_PER_GROUP = N_EXPERTS // N_GROUPS
TOP_K = 2
D_FF_EXPERT = (D_MODEL * 11) // 16
MOE_BLOCK = 256

ALPHA = (2 * DEPTH) ** 0.25
BETA = (8 * DEPTH) ** -0.25
LN_EPS = 1e-5

kernel_name = "hybrid_natten_rwkv7_hyena_moe_encoder"


def layer_norm(x, g, b):
    xf = x.astype(jnp.float32)
    mu = jnp.mean(xf, -1, keepdims=True)
    var = jnp.mean(jnp.square(xf - mu), -1, keepdims=True)
    return ((xf - mu) * lax.rsqrt(var + LN_EPS) * g.astype(jnp.float32) + b.astype(jnp.float32)).astype(x.dtype)


def modulate(x, shift, scale):
    return x * (1.0 + scale[:, None, :]) + shift[:, None, :]


def shift_prev(x):
    return jnp.pad(x, ((0, 0), (1, 0), (0, 0)))[:, :-1]


def shift_next(x):
    return jnp.pad(x, ((0, 0), (0, 1), (0, 0)))[:, 1:]


def neighbourhood_attention(q, k, v, rpb):
    B, L, H, Dh = q.shape
    rows = L // GRID_W
    kh = min(NA_KH_MAX, rows)
    qg = (q * (Dh ** -0.5)).reshape(B, rows, GRID_W, H, Dh)
    kg = k.reshape(B, rows, GRID_W, H, Dh)
    vg = v.reshape(B, rows, GRID_W, H, Dh)
    cols = np.arange(GRID_W)
    col_start = np.clip(cols - NA_KW // 2, 0, GRID_W - NA_KW)
    col_idx = col_start[:, None] + np.arange(NA_KW)[None, :]
    dc_idx = col_idx - cols[:, None] + (NA_KW - 1)

    def row_block(i):
        row_start = jnp.clip(i - kh // 2, 0, rows - kh)
        dr_idx = row_start + jnp.arange(kh) - i + (NA_KH_MAX - 1)
        bias = rpb[:, dr_idx[:, None, None], dc_idx[None, :, :]]
        q_row = lax.dynamic_index_in_dim(qg, i, axis=1, keepdims=False)
        k_rows = lax.dynamic_slice_in_dim(kg, row_start, kh, axis=1)
        v_rows = lax.dynamic_slice_in_dim(vg, row_start, kh, axis=1)
        k_win = jnp.take(k_rows, col_idx, axis=2)
        v_win = jnp.take(v_rows, col_idx, axis=2)
        s = jnp.einsum('bjhd,brjchd->bhjrc', q_row, k_win).astype(jnp.float32)
        s = s + bias.transpose(0, 2, 1, 3)[None].astype(jnp.float32)
        p = jax.nn.softmax(s.reshape(B, H, GRID_W, kh * NA_KW), axis=-1)
        p = p.reshape(B, H, GRID_W, kh, NA_KW).astype(v.dtype)
        return jnp.einsum('bhjrc,brjchd->bjhd', p, v_win)

    out = lax.map(row_block, jnp.arange(rows))
    return out.transpose(1, 0, 2, 3, 4).reshape(B, L, H * Dh)


def rwkv7_bidir(pb, w0, w_up, a0, a_up, g_up, k_k, k_a, r_k, gn_g, gn_b):
    f32 = jnp.float32
    B, L, _ = pb.shape
    H, N, W = RW_HEADS, RW_HEAD_DIM, RW_WIDTH
    r, k, v = pb[..., :W], pb[..., W:2 * W], pb[..., 2 * W:3 * W]
    o1 = 3 * W
    o2 = o1 + 2 * RW_W_LORA
    o3 = o2 + 2 * RW_A_LORA
    wd = pb[..., o1:o2].reshape(B, L, 2, RW_W_LORA)
    ad = pb[..., o2:o3].reshape(B, L, 2, RW_A_LORA)
    gd = pb[..., o3:]
    decay = jnp.exp(-RW_DECAY_SCALE * jax.nn.sigmoid((w0 + jnp.einsum('bldr,drc->bldc', jnp.tanh(wd), w_up)).astype(f32)))
    icl = jax.nn.sigmoid((a0 + jnp.einsum('bldr,drc->bldc', ad, a_up)).astype(f32))
    gate = jax.nn.sigmoid(gd) @ g_up
    kk = (k * k_k).astype(f32).reshape(B, L, H, N)
    kk = (kk * lax.rsqrt(jnp.sum(kk * kk, -1, keepdims=True) + 1e-12)).reshape(B, L, W)
    kd = k.astype(f32)[:, :, None, :] * (1.0 + (icl - 1.0) * k_a.astype(f32))

    def dirs(t):
        t = jnp.broadcast_to(t, (B, L, 2, W)).reshape(B, L, 2, H, N).transpose(1, 2, 0, 3, 4)
        return jnp.stack([t[:, 0], t[::-1, 1]], axis=1)

    xs = (dirs(r.astype(f32)[:, :, None]), dirs(decay), dirs(kd),
          dirs(v.astype(f32)[:, :, None]), dirs(-kk[:, :, None]), dirs(kk[:, :, None] * icl))

    def step(S, inp):
        r_t, w_t, k_t, v_t, a_t, b_t = inp
        sa = jnp.einsum('dbhvk,dbhk->dbhv', S, a_t)
        S = S * w_t[..., None, :] + sa[..., None] * b_t[..., None, :] + v_t[..., None] * k_t[..., None, :]
        return S, jnp.einsum('dbhvk,dbhk->dbhv', S, r_t)

    S0 = jnp.zeros((2, B, H, N, N), f32)
    _, o = lax.scan(step, S0, xs)
    o = (o[:, 0] + o[::-1, 1]).transpose(1, 0, 2, 3)
    mu = jnp.mean(o, -1, keepdims=True)
    var = jnp.mean(jnp.square(o - mu), -1, keepdims=True)
    o = ((o - mu) * lax.rsqrt(var + RW_GN_EPS)).reshape(B, L, W) * gn_g.astype(f32) + gn_b.astype(f32)
    bonus = jnp.sum((r.astype(f32) * (kd[:, :, 0] + kd[:, :, 1]) * r_k.astype(f32)).reshape(B, L, H, N), -1, keepdims=True)
    o = o + (bonus * v.astype(f32).reshape(B, L, H, N)).reshape(B, L, W)
    return (o * gate.astype(f32)).astype(pb.dtype)


def even_mixer(h, w_in, w_out, rpb, mu, w0, w_up, a0, a_up, g_up, k_k, k_a, r_k, gn_g, gn_b):
    B, L, _ = h.shape
    p = h @ w_in
    qa, ka, va = jnp.split(p[..., :3 * NA_WIDTH], 3, axis=-1)
    hd = lambda t: t.reshape(B, L, NA_HEADS, NA_HEAD_DIM)
    out_a = neighbourhood_attention(hd(qa), hd(ka), hd(va), rpb)
    pb = p[..., 3 * NA_WIDTH:]
    pb = pb + mu[0] * (shift_prev(pb) - pb) + mu[1] * (shift_next(pb) - pb)
    out_b = rwkv7_bidir(pb, w0, w_up, a0, a_up, g_up, k_k, k_a, r_k, gn_g, gn_b)
    return jnp.concatenate([out_a, out_b], axis=-1) @ w_out


def hyena_filters(L, D, w1, b1, w2, b2, w3, b3, freq, w4):
    f32 = jnp.float32
    t = jnp.linspace(0.0, 1.0, L, dtype=f32)[:, None]
    bands = (HY_EMB - 1) // 2
    ang = (2.0 * math.pi / L) * jnp.arange(L, dtype=f32)[:, None] * jnp.linspace(1e-4, bands - 1, bands, dtype=f32)[None, :]
    z = jnp.concatenate([t, jnp.cos(ang), -jnp.sin(ang)], axis=-1)
    fr = freq.astype(f32)
    hdn = jnp.sin(fr * (z @ w1.astype(f32) + b1.astype(f32)))
    hdn = jnp.sin(fr * (hdn @ w2.astype(f32) + b2.astype(f32)))
    hdn = jnp.sin(fr * (hdn @ w3.astype(f32) + b3.astype(f32)))
    filt = (hdn @ w4.astype(f32)).reshape(L, HY_ORDER, 2, D)
    max_decay = math.log(HY_DECAY_TARGET) / HY_FAST_DECAY_PCT
    min_decay = math.log(HY_DECAY_TARGET) / HY_SLOW_DECAY_PCT
    deltas = jnp.linspace(min_decay, max_decay, D, dtype=f32)
    filt = filt * jnp.exp(-t * jnp.abs(deltas))[:, None, None, :]
    full = jnp.concatenate([filt[:, :, 0], jnp.zeros((1, HY_ORDER, D), f32), filt[:0:-1, :, 1]], axis=0)
    full = full / (jnp.sum(jnp.abs(full), axis=0, keepdims=True) + 1e-6)
    return jnp.fft.rfft(full, axis=0)


def long_conv(u, filt_f, skip):
    L = u.shape[1]
    uf = u.astype(jnp.float32)
    y = jnp.fft.irfft(jnp.fft.rfft(uf, n=2 * L, axis=1) * filt_f[None], n=2 * L, axis=1)[:, :L]
    return (y + uf * skip.astype(jnp.float32)).astype(u.dtype)


def hyena_mixer(h, w_in, conv_w, conv_b, f_w1, f_b1, f_w2, f_b2, f_w3, f_b3, f_freq, f_w4, skip, w_out):
    B, L, D = h.shape
    u = h @ w_in
    u = conv_w[0] * shift_prev(u) + conv_w[1] * u + conv_w[2] * shift_next(u) + conv_b
    g1, g2, v = jnp.split(u, 3, axis=-1)
    filt_f = hyena_filters(L, D, f_w1, f_b1, f_w2, f_b2, f_w3, f_b3, f_freq, f_w4)
    y = long_conv(v, filt_f[:, 0], skip[0]) * g1
    y = long_conv(y, filt_f[:, 1], skip[1]) * g2
    return y @ w_out


def routed_experts(xt, experts, w_gate, w_up, w_down):
    T, D = xt.shape
    A = T * TOP_K
    flat_e = experts.reshape(A).astype(jnp.int32)
    flat_tok = jnp.repeat(jnp.arange(T, dtype=jnp.int32), TOP_K)
    order = jnp.argsort(flat_e)
    sorted_e = flat_e[order]
    counts = jnp.bincount(flat_e, length=N_EXPERTS).astype(jnp.int32)
    starts = jnp.cumsum(counts) - counts
    padded = (counts + MOE_BLOCK - 1) // MOE_BLOCK * MOE_BLOCK
    pad_ends = jnp.cumsum(padded)
    pad_starts = pad_ends - padded
    dest_sorted = pad_starts[sorted_e] + jnp.arange(A, dtype=jnp.int32) - starts[sorted_e]
    n_blocks = -(-A // MOE_BLOCK) + N_EXPERTS
    n_rows = n_blocks * MOE_BLOCK
    row_tok = jnp.full((n_rows,), T, jnp.int32).at[dest_sorted].set(flat_tok[order])
    block_e = jnp.minimum(jnp.searchsorted(pad_ends, jnp.arange(n_blocks, dtype=jnp.int32) * MOE_BLOCK, side='right'), N_EXPERTS - 1)
    xp = jnp.concatenate([xt, jnp.zeros((1, D), xt.dtype)], axis=0)[row_tok].reshape(n_blocks, MOE_BLOCK, D)

    def expert_block(args):
        xb, e = args
        return (jax.nn.silu(xb @ w_gate[e]) * (xb @ w_up[e])) @ w_down[e]

    yp = lax.map(expert_block, (xp, block_e)).reshape(n_rows, D)
    dest = jnp.zeros((A,), jnp.int32).at[order].set(dest_sorted)
    return yp[dest].reshape(T, TOP_K, D)


def moe_ffn(h, router_w, router_b, w_gate, w_up, w_down):
    B, L, D = h.shape
    T = B * L
    xt = h.reshape(T, D)
    probs = jax.nn.softmax((xt @ router_w + router_b).astype(jnp.float32), axis=-1)
    grp = probs.reshape(T, N_GROUPS, EXPERTS_PER_GROUP)
    grp_score = jnp.sum(lax.top_k(grp, TOP_K)[0], axis=-1)
    g_sel = jnp.argmax(grp_score, axis=-1)
    in_grp = grp[jnp.arange(T), g_sel]
    top_p, top_i = lax.top_k(in_grp, TOP_K)
    experts = g_sel[:, None] * EXPERTS_PER_GROUP + top_i
    gates = top_p / jnp.sum(top_p, axis=-1, keepdims=True)
    y = routed_experts(xt, experts, w_gate, w_up, w_down)
    out = jnp.sum(gates[..., None] * y.astype(jnp.float32), axis=1)
    return out.astype(h.dtype).reshape(B, L, D)


def setup_inputs(seed: int = 0) -> dict:
    key = jax.random.key(seed)
    ks = list(jax.random.split(key, 48))
    f32 = jnp.float32

    def nrm(shape, scale):
        return scale * jax.random.normal(ks.pop(), shape, f32)

    def unif(shape, lo, hi):
        return jax.random.uniform(ks.pop(), shape, f32, lo, hi)

    D = D_MODEL
    NE, NO = N_EVEN, N_ODD
    FH = HY_FILTER_HIDDEN
    gate_offset = jnp.tile(jnp.repeat(jnp.array([0.0, 0.0, 1.0], f32), D), 2)
    return {
        'x': nrm((BATCH, SEQ, D), 1.0),
        'c': nrm((BATCH, D), 1.0),
        'ada_w': nrm((DEPTH, D, 6 * D), 0.1 * D ** -0.5),
        'ada_b': nrm((DEPTH, 6 * D), 0.02) + gate_offset,
        'ln_g': 1.0 + nrm((DEPTH, 2, D), 0.02),
        'ln_b': nrm((DEPTH, 2, D), 0.02),
        'router_w': nrm((D, N_EXPERTS), D ** -0.5),
        'router_b': nrm((N_EXPERTS,), 0.01),
        'moe_w_gate': nrm((DEPTH, N_EXPERTS, D, D_FF_EXPERT), D ** -0.5),
        'moe_w_up': nrm((DEPTH, N_EXPERTS, D, D_FF_EXPERT), D ** -0.5),
        'moe_w_down': nrm((DEPTH, N_EXPERTS, D_FF_EXPERT, D), BETA * D_FF_EXPERT ** -0.5),
        'ab_w_in': nrm((NE, D, AB_PROJ), D ** -0.5),
        'ab_w_out': nrm((NE, MIX_WIDTH, D), BETA * MIX_WIDTH ** -0.5),
        'na_rpb': nrm((NE, NA_HEADS, 2 * NA_KH_MAX - 1, 2 * NA_KW - 1), 0.1),
        'rw_mu': unif((NE, 2, RW_PROJ), 0.0, 0.5),
        'rw_w0': nrm((NE, 2, RW_WIDTH), 0.5),
        'rw_w_up': nrm((NE, 2, RW_W_LORA, RW_WIDTH), 0.5 * RW_W_LORA ** -0.5),
        'rw_a0': nrm((NE, 2, RW_WIDTH), 0.5),
        'rw_a_up': nrm((NE, 2, RW_A_LORA, RW_WIDTH), 0.5 * RW_A_LORA ** -0.5),
        'rw_g_up': nrm((NE, RW_G_LORA, RW_WIDTH), RW_G_LORA ** -0.5),
        'rw_k_k': 0.85 + nrm((NE, RW_WIDTH), 0.02),
        'rw_k_a': 1.0 + nrm((NE, RW_WIDTH), 0.02),
        'rw_r_k': nrm((NE, RW_WIDTH), 0.1),
        'rw_gn_g': 1.0 + nrm((NE, RW_WIDTH), 0.02),
        'rw_gn_b': nrm((NE, RW_WIDTH), 0.02),
        'hy_w_in': nrm((NO, D, 3 * D), D ** -0.5),
        'hy_conv_w': nrm((NO, 3, 3 * D), 0.5),
        'hy_conv_b': nrm((NO, 3 * D), 0.02),
        'hy_f_w1': nrm((NO, HY_EMB, FH), HY_EMB ** -0.5),
        'hy_f_b1': nrm((NO, FH), 0.02),
        'hy_f_w2': nrm((NO, FH, FH), FH ** -0.5),
        'hy_f_b2': nrm((NO, FH), 0.02),
        'hy_f_w3': nrm((NO, FH, FH), FH ** -0.5),
        'hy_f_b3': nrm((NO, FH), 0.02),
        'hy_f_freq': 1.0 + nrm((NO, FH), 0.02),
        'hy_f_w4': nrm((NO, FH, HY_ORDER * 2 * D), FH ** -0.5),
        'hy_skip': nrm((NO, HY_ORDER, D), 0.5),
        'hy_w_out': nrm((NO, D, D), BETA * D ** -0.5),
    }


def reference(x, c, ada_w, ada_b, ln_g, ln_b, router_w, router_b, moe_w_gate, moe_w_up, moe_w_down,
              ab_w_in, ab_w_out, na_rpb, rw_mu, rw_w0, rw_w_up, rw_a0, rw_a_up, rw_g_up, rw_k_k, rw_k_a,
              rw_r_k, rw_gn_g, rw_gn_b, hy_w_in, hy_conv_w, hy_conv_b, hy_f_w1, hy_f_b1, hy_f_w2, hy_f_b2,
              hy_f_w3, hy_f_b3, hy_f_freq, hy_f_w4, hy_skip, hy_w_out):
    cond = jax.nn.silu(c)
    for layer in range(DEPTH):
        ada = cond @ ada_w[layer] + ada_b[layer]
        sh1, sc1, g1, sh2, sc2, g2 = jnp.split(ada, 6, axis=-1)
        i = layer // 2
        h = modulate(x, sh1, sc1)
        if layer % 2 == 0:
            y = even_mixer(h, ab_w_in[i], ab_w_out[i], na_rpb[i], rw_mu[i], rw_w0[i], rw_w_up[i], rw_a0[i],
                           rw_a_up[i], rw_g_up[i], rw_k_k[i], rw_k_a[i], rw_r_k[i], rw_gn_g[i], rw_gn_b[i])
        else:
            y = hyena_mixer(h, hy_w_in[i], hy_conv_w[i], hy_conv_b[i], hy_f_w1[i], hy_f_b1[i], hy_f_w2[i],
                            hy_f_b2[i], hy_f_w3[i], hy_f_b3[i], hy_f_freq[i], hy_f_w4[i], hy_skip[i], hy_w_out[i])
        x = layer_norm(ALPHA * x + g1[:, None, :] * y, ln_g[layer, 0], ln_b[layer, 0])
        h = modulate(x, sh2, sc2)
        y = moe_ffn(h, router_w, router_b, moe_w_gate[layer], moe_w_up[layer], moe_w_down[layer])
        x = layer_norm(ALPHA * x + g2[:, None, :] * y, ln_g[layer, 1], ln_b[layer, 1])
    return x
```

```cpp
#include <hip/hip_runtime.h>
#include <hip/hip_fp16.h>
#include <stdint.h>
#include <stdio.h>

#define XB_TMO      128
#define XB_XCNT(j)  (256  + 64 * (j))
#define XB_XSUB(j)  (1280 + 64 * (j))
#define XB_XGEN(j)  (2304 + 64 * (j))
#define XB_TOP      3328
#define XB_TOPGEN   3392
#define XCD_BAR_WORDS 3456
#define XB_SPIN_CAP (1u << 22)
#define LAS __attribute__((address_space(3)))

__device__ __forceinline__ unsigned xb_ld(unsigned* p)              { return __hip_atomic_load(p, __ATOMIC_RELAXED, __HIP_MEMORY_SCOPE_AGENT); }
__device__ __forceinline__ unsigned xb_add(unsigned* p, unsigned v) { return __hip_atomic_fetch_add(p, v, __ATOMIC_RELAXED, __HIP_MEMORY_SCOPE_AGENT); }
__device__ __forceinline__ unsigned xb_xcc_id() { return (unsigned)__builtin_amdgcn_s_getreg((3 << 11) | 20) & 0xFu; }
#define XB_SPIN(cond, bar) do { unsigned _sp = 0; while (cond) { __builtin_amdgcn_s_sleep(1); \
    if ((++_sp & 255u) == 0u) { if (xb_ld(&(bar)[XB_TMO])) break; if (_sp > XB_SPIN_CAP) { atomicAdd(&(bar)[XB_TMO], 1u); break; } } } } while (0)

struct XcdBarrier { unsigned* bar; unsigned x; volatile LAS unsigned* st; };

__device__ __forceinline__ XcdBarrier xcd_barrier_post(unsigned* bar, volatile LAS unsigned* st) {
    XcdBarrier b; b.bar = bar; b.x = xb_xcc_id(); b.st = st;
    if (threadIdx.x == 0) (void)xb_add(&bar[XB_XCNT(b.x)], 1u);
    return b;
}
__device__ __forceinline__ void xcd_barrier_complete(unsigned* bar, unsigned x, unsigned& nloc, unsigned& nx) {
    const unsigned G = gridDim.x * gridDim.y * gridDim.z;
    unsigned sum, cnt, mine, sp = 0u;
    for (;;) {
        sum = 0u; cnt = 0u; mine = 0u;
#pragma unroll
        for (unsigned j = 0; j < 16; ++j) { const unsigned c = xb_ld(&bar[XB_XCNT(j)]); sum += c; cnt += (c > 0u) ? 1u : 0u; mine = (j == x) ? c : mine; }
        if (sum == G) break;
        __builtin_amdgcn_s_sleep(1);
        if ((++sp & 255u) == 0u) { if (xb_ld(&bar[XB_TMO])) break; if (sp > XB_SPIN_CAP) { atomicAdd(&bar[XB_TMO], 1u); break; } }
    }
    nloc = mine > 0u ? mine : 1u; nx = cnt > 0u ? cnt : 1u;
}
__device__ __forceinline__ void xcd_barrier(const XcdBarrier& b) {
    asm volatile("s_waitcnt vmcnt(0)" ::: "memory");
    __syncthreads();
    if (threadIdx.x == 0) {
        unsigned* bar = b.bar;
        __builtin_amdgcn_s_waitcnt(0);
        unsigned nloc = b.st[0], nx = b.st[1];
        if (nloc == 0u) { xcd_barrier_complete(bar, b.x, nloc, nx); b.st[0] = nloc; b.st[1] = nx; }
        const unsigned old = xb_add(&bar[XB_XSUB(b.x)], 1u);
        const unsigned gen = old / nloc;
        if (old + 1u == (gen + 1u) * nloc) {
            __builtin_amdgcn_fence(__ATOMIC_RELEASE, "agent");
            asm volatile("s_waitcnt vmcnt(0)" ::: "memory");
            const unsigned og = xb_add(&bar[XB_TOP], 1u);
            const unsigned tg = og / nx;
            if (og + 1u == (tg + 1u) * nx) xb_add(&bar[XB_TOPGEN], 1u);
            else XB_SPIN(xb_ld(&bar[XB_TOPGEN]) == tg, bar);
            __builtin_amdgcn_fence(__ATOMIC_ACQUIRE, "agent");
            xb_add(&bar[XB_XGEN(b.x)], 1u);
            asm volatile("s_waitcnt vmcnt(0)" ::: "memory");
        } else {
            XB_SPIN(xb_ld(&bar[XB_XGEN(b.x)]) == gen, bar);
            __builtin_amdgcn_fence(__ATOMIC_ACQUIRE, "agent");
            asm volatile("s_waitcnt vmcnt(0)" ::: "memory");
        }
    }
    __syncthreads();
}

namespace {
constexpr int T_ = 32768, D_ = 1024, L_ = 16384;
constexpr int ABP = 3456;
constexpr int FF = 704;
constexpr int NSLOT = 73728;
constexpr float ALPHA_F = 1.681792830507429f;
constexpr int NTHR = 512;
constexpr int LDS_BYTES = 152 * 1024;

typedef unsigned short u16;
using bf16x8 = __attribute__((ext_vector_type(8))) short;
using f32x4  = __attribute__((ext_vector_type(4))) float;

constexpr size_t al(size_t x) { return (x + 255) & ~(size_t)255; }
constexpr size_t OFF_BAR   = 0;
constexpr size_t OFF_ADA   = al(OFF_BAR + 16384);
constexpr size_t OFF_CNT   = al(OFF_ADA + 4 * 2 * 6144 * 4);
constexpr size_t OFF_META  = al(OFF_CNT + 256 * 32 * 4);
constexpr size_t OFF_TOKE  = al(OFF_META + 4096);
constexpr size_t OFF_TOKG  = al(OFF_TOKE + (size_t)T_ * 2 * 4);
constexpr size_t OFF_TOKS  = al(OFF_TOKG + (size_t)T_ * 2 * 4);
constexpr size_t OFF_SLTK  = al(OFF_TOKS + (size_t)T_ * 2 * 4);
constexpr size_t OFF_HDN   = al(OFF_SLTK + (size_t)NSLOT * 4);
constexpr size_t OFF_WGU   = al(OFF_HDN + (size_t)2 * L_ * 64 * 2);
constexpr size_t OFF_WD    = al(OFF_WGU + (size_t)4 * 32 * 1536 * 1024 * 2);
constexpr size_t OFF_WINE  = al(OFF_WD + (size_t)4 * 32 * 1024 * 704 * 2);
constexpr size_t OFF_WOUTE = al(OFF_WINE + (size_t)2 * 3584 * 1024 * 2);
constexpr size_t OFF_WINH  = al(OFF_WOUTE + (size_t)2 * 1024 * 1024 * 2);
constexpr size_t OFF_WOUTH = al(OFF_WINH + (size_t)2 * 3072 * 1024 * 2);
constexpr size_t OFF_WUP   = al(OFF_WOUTH + (size_t)2 * 1024 * 1024 * 2);
constexpr size_t OFF_AUP   = al(OFF_WUP + (size_t)4 * 512 * 64 * 2);
constexpr size_t OFF_GUP   = al(OFF_AUP + (size_t)4 * 512 * 64 * 2);
constexpr size_t OFF_W4T   = al(OFF_GUP + (size_t)2 * 512 * 128 * 2);
constexpr size_t OFF_HBUF  = al(OFF_W4T + (size_t)2 * 4096 * 64 * 2);
constexpr size_t OFF_P     = al(OFF_HBUF + (size_t)T_ * 1024 * 2);
constexpr size_t SZ_P      = (size_t)T_ * ABP * 2;
constexpr size_t OFF_MIX   = al(OFF_P + SZ_P);
constexpr size_t OFF_RW    = al(OFF_MIX + (size_t)T_ * 1024 * 2);
constexpr size_t SZ_RW     = (size_t)320 << 20;
constexpr size_t OFF_O     = al(OFF_RW + SZ_RW);
constexpr size_t SZ_O      = (size_t)128 << 20;
constexpr size_t WS_NEED   = OFF_O + SZ_O;

constexpr size_t RW_R   = OFF_RW;
constexpr size_t RW_V   = RW_R + (size_t)T_ * 512 * 2;
constexpr size_t RW_KK  = RW_V + (size_t)T_ * 512 * 2;
constexpr size_t RW_G   = RW_KK + (size_t)T_ * 512 * 2;
constexpr size_t RW_W   = RW_G + (size_t)T_ * 512 * 2;
constexpr size_t RW_KD  = RW_W + (size_t)T_ * 1024 * 2;
constexpr size_t RW_BQ  = RW_KD + (size_t)T_ * 1024 * 2;
constexpr size_t O_OF   = OFF_O;
constexpr size_t O_OB   = OFF_O + (size_t)T_ * 512 * 4;
constexpr size_t O_KP   = OFF_O;
constexpr size_t O_AWD  = O_KP + (size_t)T_ * 512 * 2;
constexpr size_t O_AAD  = O_AWD + (size_t)T_ * 128 * 2;
constexpr size_t O_AGD  = O_AAD + (size_t)T_ * 128 * 2;
constexpr size_t MOE_H  = OFF_P;
constexpr size_t MOE_Y  = OFF_RW;
constexpr size_t HY_UT   = OFF_P;
constexpr size_t HY_TAPS = OFF_RW;
constexpr size_t HY_Y2   = OFF_RW + (size_t)4096 * L_ * 4;
constexpr size_t HY_Y2T  = OFF_MIX;
constexpr size_t HY_SPEC = OFF_O;
constexpr size_t HY_Y1   = OFF_HBUF;

struct P { const float* in[38]; float* out; char* ws; };
typedef const __attribute__((address_space(4))) P* KP;
struct PP { KP k;
    __device__ __forceinline__ const float* in(int i) const { return k->in[i]; }
    __device__ __forceinline__ char* ws() const { return k->ws; }
    __device__ __forceinline__ float* out() const { return k->out; } };

__device__ __forceinline__ int tid_opaque() { int t = threadIdx.x; asm volatile("" : "+v"(t)); return t; }
__device__ __forceinline__ float bf2f(u16 h) { return __uint_as_float(((unsigned)h) << 16); }
typedef float f32x2_t __attribute__((ext_vector_type(2)));
typedef __bf16 bf16x2_t __attribute__((ext_vector_type(2)));
__device__ __forceinline__ u16 f2bf(float f) { const __bf16 h = (__bf16)f; return __builtin_bit_cast(u16, h); }
__device__ __forceinline__ unsigned pack2(float a, float b) { const f32x2_t v = {a, b}; const bf16x2_t r = __builtin_convertvector(v, bf16x2_t); return __builtin_bit_cast(unsigned, r); }
__device__ __forceinline__ float lo2f(unsigned u) { return __uint_as_float(u << 16); }
__device__ __forceinline__ float hi2f(unsigned u) { return __uint_as_float(u & 0xffff0000u); }
__device__ __forceinline__ float4 up4(uint2 u) { return make_float4(lo2f(u.x), hi2f(u.x), lo2f(u.y), hi2f(u.y)); }
__device__ __forceinline__ float wave_sum(float v) {
#pragma unroll
    for (int o = 32; o >= 1; o >>= 1) v += __shfl_xor(v, o);
    return v;
}
__device__ __forceinline__ float wave_max(float v) {
#pragma unroll
    for (int o = 32; o >= 1; o >>= 1) v = fmaxf(v, __shfl_xor(v, o));
    return v;
}
__device__ __forceinline__ float sigmoidf_(float x) { return __builtin_amdgcn_rcpf(1.0f + __expf(-x)); }

constexpr int GLD = 72;
constexpr int G_AS = 256 * GLD;
constexpr int G_BS = 128 * GLD;

template <bool TR = false, class AL, class BL>
__device__ __forceinline__ void gemm_mainloop(u16* smem, int nk, AL aload, BL bload, f32x4 (&acc)[4][4]) {
    const int tid = tid_opaque(), lane = tid & 63, wid = tid >> 6;
    const int wm = wid >> 1, wn = wid & 1, fr = lane & 15, fq = lane >> 4;
    u16* As = smem; u16* Bs = smem + 2 * G_AS;
    const int arow = tid >> 3, akc = (tid & 7) * 8;
    uint4 ra[4], rb[2], ra2[4], rb2[2];
#pragma unroll
    for (int m = 0; m < 4; ++m)
#pragma unroll
        for (int n = 0; n < 4; ++n) acc[m][n] = f32x4{0.f, 0.f, 0.f, 0.f};
#define G_LOAD(RA, RB, KT) { _Pragma("unroll") for (int i = 0; i < 4; ++i) RA[i] = aload(i, arow + 64 * i, (KT) * 64 + akc); \
                             _Pragma("unroll") for (int i = 0; i < 2; ++i) RB[i] = bload(i, arow + 64 * i, (KT) * 64 + akc); }
#define G_STORE(RA, RB, BUF) { _Pragma("unroll") for (int i = 0; i < 4; ++i) *(uint4*)(As + (BUF) * G_AS + (arow + 64 * i) * GLD + akc) = RA[i]; \
                               _Pragma("unroll") for (int i = 0; i < 2; ++i) *(uint4*)(Bs + (BUF) * G_BS + (arow + 64 * i) * GLD + akc) = RB[i]; }
#define G_COMPUTE(BUF) { const u16* Ab = As + (BUF) * G_AS + (wm * 64 + fr) * GLD + fq * 8; const u16* Bb = Bs + (BUF) * G_BS + (wn * 64 + fr) * GLD + fq * 8; \
        _Pragma("unroll") for (int ks = 0; ks < 2; ++ks) { bf16x8 af[4], bfr[4]; \
            _Pragma("unroll") for (int m = 0; m < 4; ++m) af[m] = *(const bf16x8*)(Ab + m * 16 * GLD + ks * 32); \
            _Pragma("unroll") for (int n = 0; n < 4; ++n) bfr[n] = *(const bf16x8*)(Bb + n * 16 * GLD + ks * 32); \
            _Pragma("unroll") for (int m = 0; m < 4; ++m) _Pragma("unroll") for (int n = 0; n < 4; ++n) \
                acc[m][n] = TR ? __builtin_amdgcn_mfma_f32_16x16x32_bf16(bfr[n], af[m], acc[m][n], 0, 0, 0) : __builtin_amdgcn_mfma_f32_16x16x32_bf16(af[m], bfr[n], acc[m][n], 0, 0, 0); } }
    G_LOAD(ra, rb, 0)
    if (nk > 1) G_LOAD(ra2, rb2, 1)
    G_STORE(ra, rb, 0)
    if (nk > 2) G_LOAD(ra, rb, 2)
    __syncthreads();
#pragma unroll 1
    for (int kt = 0; kt < nk; kt += 2) {
        G_COMPUTE(0)
        if (kt + 1 < nk) G_STORE(ra2, rb2, 1)
        if (kt + 3 < nk) G_LOAD(ra2, rb2, kt + 3)
        __syncthreads();
        if (kt + 1 < nk) {
            G_COMPUTE(1)
            if (kt + 2 < nk) G_STORE(ra, rb, 0)
            if (kt + 4 < nk) G_LOAD(ra, rb, kt + 4)
            __syncthreads();
        }
    }
#undef G_LOAD
#undef G_STORE
#undef G_COMPUTE
}


namespace g8 {
#define G8_LAS __attribute__((address_space(3)))
constexpr int BM = 256, BK = 64, HALF = 128, HTB = HALF * BK * 2;
__device__ __forceinline__ int lds_byte(int r, int c) { const int st = (r >> 4) * 2 + (c >> 5), rr = r & 15, cc = c & 31, ob = rr * 64 + cc * 2; return st * 1024 + (ob ^ (((ob >> 9) & 1) << 5)); }
__device__ __forceinline__ void stage_rc(int b, int& R, int& C) { const int st = b / 1024, sb = b % 1024, swz = sb ^ (((sb >> 9) & 1) << 5); R = (st >> 1) * 16 + swz / 64; C = (st & 1) * 32 + (swz % 64) / 2; }
__device__ __forceinline__ int perm32(int rho) { const int n = rho >> 4, i = rho & 15; return 8 * (i >> 2) + 4 * n + (i & 3); }
struct Unit { const char* a; const char* b; int pm, pn, aux; };

template <bool PERM, bool GATHER, class Sched, class Epi>
__device__ __forceinline__ void gemm(G8_LAS unsigned char* lds, const int K, const int lda, const int ldb, const int* __restrict__ rowidx, const Sched& S, const Epi& E) {
    const int tid = tid_opaque(), wid = __builtin_amdgcn_readfirstlane(tid >> 6), lane = tid & 63, wr = wid >> 2, wc = wid & 3, fr = lane & 15, fq = lane >> 4;
    const int nt = K / BK;
    unsigned voffA[2], voffB[2];
#pragma unroll
    for (int i = 0; i < 2; ++i) { int R, C; stage_rc(tid * 16 + i * 8192, R, C); const int Rb = PERM ? ((R & ~31) + perm32(R & 31)) : R;
        voffA[i] = (unsigned)(R * lda + C) * 2u; voffB[i] = (unsigned)(Rb * ldb + C) * 2u; }
    const size_t kstep = (size_t)(BK * 2);
    const size_t hstepA = (size_t)HALF * lda * 2, hstepB = (size_t)HALF * ldb * 2;
    const unsigned ldsw = (unsigned)wid * 1024u;
    const int aoff = lds_byte(wr * 64 + fr, fq * 8), boff = lds_byte(wc * 32 + fr, fq * 8);
#define G8_SA(b, h) (((b) * 2 + (h)) * HTB)
#define G8_SB(b, h) ((4 + (b) * 2 + (h)) * HTB)
#define G8_STAGE(bufoff, gbase, voff) do { _Pragma("unroll") for (int _i = 0; _i < 2; ++_i) \
        __builtin_amdgcn_global_load_lds((const unsigned*)((const char*)(gbase) + (voff)[_i]), (G8_LAS unsigned*)(lds + (bufoff) + ldsw + _i * 8192), 16, 0, 0); } while (0)
#define G8_STAGE_A(bufoff, gbase, h, sel) do { if (GATHER) { _Pragma("unroll") for (int _i = 0; _i < 2; ++_i) \
        __builtin_amdgcn_global_load_lds((const unsigned*)((const char*)(gbase) + ((sel) ? goN[h][_i] : goC[h][_i])), (G8_LAS unsigned*)(lds + (bufoff) + ldsw + _i * 8192), 16, 0, 0); } \
        else G8_STAGE(bufoff, (gbase) + (h) * hstepA, voffA); } while (0)
#define G8_LDA(dst, b, h) do { _Pragma("unroll") for (int m = 0; m < 4; ++m) _Pragma("unroll") for (int k = 0; k < 2; ++k) dst[m][k] = *(const G8_LAS bf16x8*)(lds + G8_SA(b, h) + aoff + m * 2048 + k * 1024); } while (0)
#define G8_LDB(dst, b, h) do { _Pragma("unroll") for (int n = 0; n < 2; ++n) _Pragma("unroll") for (int k = 0; k < 2; ++k) dst[n][k] = *(const G8_LAS bf16x8*)(lds + G8_SB(b, h) + boff + n * 2048 + k * 1024); } while (0)
#define G8_MMA(ai, bj, At, Bt) do { __builtin_amdgcn_s_setprio(1); _Pragma("unroll") for (int m = 0; m < 4; ++m) _Pragma("unroll") for (int n = 0; n < 2; ++n) _Pragma("unroll") for (int k = 0; k < 2; ++k) \
        acc[ai][bj][m][n] = __builtin_amdgcn_mfma_f32_16x16x32_bf16(Bt[n][k], At[m][k], acc[ai][bj][m][n], 0, 0, 0); __builtin_amdgcn_s_setprio(0); } while (0)
#define G8_WAIT_V(n) asm volatile("s_waitcnt vmcnt(" #n ")" ::: "memory")
#define G8_WAIT_L(n) asm volatile("s_waitcnt lgkmcnt(" #n ")" ::: "memory")
#define G8_BAR __builtin_amdgcn_s_barrier()
#define G8_SCHED __builtin_amdgcn_sched_barrier(0)
    Unit cur, nxt; int ui = 0;
    if (!S(0, cur)) return;
    unsigned goC[2][2], goN[2][2];
#define G8_GOFF(go, u) do { if (GATHER) { const int tq_ = tid_opaque(); int ri_[2][2]; \
        _Pragma("unroll") for (int _i = 0; _i < 2; ++_i) { int R_, C_; stage_rc(tq_ * 16 + _i * 8192, R_, C_); \
            _Pragma("unroll") for (int h = 0; h < 2; ++h) ri_[h][_i] = rowidx[(u).aux + h * HALF + R_]; } \
        asm volatile("" : "+v"(ri_[0][0]), "+v"(ri_[0][1]), "+v"(ri_[1][0]), "+v"(ri_[1][1]));     \
        _Pragma("unroll") for (int _i = 0; _i < 2; ++_i) { int R_, C_; stage_rc(tq_ * 16 + _i * 8192, R_, C_); \
            _Pragma("unroll") for (int h = 0; h < 2; ++h) (go)[h][_i] = (unsigned)(ri_[h][_i] * lda + C_) * 2u; } } } while (0)
    G8_GOFF(goC, cur);
    f32x4 acc[2][2][4][2];
#pragma unroll
    for (int a = 0; a < 2; ++a)
#pragma unroll
        for (int b = 0; b < 2; ++b)
#pragma unroll
            for (int m = 0; m < 4; ++m)
#pragma unroll
                for (int n = 0; n < 2; ++n) acc[a][b][m][n] = f32x4{0.f, 0.f, 0.f, 0.f};
    bf16x8 At[4][2], B0[2][2], B1[2][2];
    const char* cA = cur.a; const char* cB = cur.b;
    G8_STAGE(G8_SB(0, 0), cB, voffB); G8_STAGE_A(G8_SA(0, 0), cA, 0, false); G8_STAGE(G8_SB(0, 1), cB + hstepB, voffB); G8_STAGE_A(G8_SA(0, 1), cA, 1, false);
    if (wr == 1) G8_BAR;
    G8_WAIT_V(4); G8_BAR;
    G8_STAGE(G8_SB(1, 0), cB + kstep, voffB); G8_STAGE_A(G8_SA(1, 0), cA + kstep, 0, false); G8_STAGE(G8_SB(1, 1), cB + hstepB + kstep, voffB);
    G8_WAIT_V(6); G8_BAR;
    for (;;) {
        const bool has_next = S(ui + 1, nxt);
        const char* nA = has_next ? nxt.a : cA; const char* nB = has_next ? nxt.b : cB;
        if (has_next) G8_GOFF(goN, nxt);
        else { _Pragma("unroll") for (int h = 0; h < 2; ++h) _Pragma("unroll") for (int _i = 0; _i < 2; ++_i) goN[h][_i] = goC[h][_i]; }
#pragma unroll 1
        for (int t = 0; t < nt; t += 2) {
            const bool last = (t == nt - 2);
            const char* a1 = cA + (size_t)(t + 1) * kstep;
            const char* a2 = last ? nA : cA + (size_t)(t + 2) * kstep; const char* b2 = last ? nB : cB + (size_t)(t + 2) * kstep;
            const char* a3 = a2 + kstep; const char* b3 = b2 + kstep;
            G8_LDB(B0, 0, 0); G8_SCHED; G8_LDA(At, 0, 0); G8_STAGE_A(G8_SA(1, 1), a1, 1, false);
            G8_WAIT_L(8); G8_BAR; G8_WAIT_L(0); G8_MMA(0, 0, At, B0); G8_BAR; G8_SCHED;
            G8_LDB(B1, 0, 1); G8_STAGE(G8_SB(0, 0), b2, voffB);
            G8_BAR; G8_WAIT_L(0); G8_MMA(0, 1, At, B1); G8_BAR;
            G8_LDA(At, 0, 1); G8_STAGE_A(G8_SA(0, 0), a2, 0, last);
            G8_BAR; G8_WAIT_L(0); G8_MMA(1, 0, At, B0); G8_BAR; G8_SCHED;
            G8_STAGE(G8_SB(0, 1), b2 + hstepB, voffB);
            G8_WAIT_V(6); G8_BAR; G8_MMA(1, 1, At, B1); G8_BAR;
            G8_LDB(B0, 1, 0); G8_SCHED; G8_LDA(At, 1, 0); G8_STAGE_A(G8_SA(0, 1), a2, 1, last);
            G8_WAIT_L(8); G8_BAR; G8_WAIT_L(0); G8_MMA(0, 0, At, B0); G8_BAR; G8_SCHED;
            G8_LDB(B1, 1, 1); G8_STAGE(G8_SB(1, 0), b3, voffB);
            G8_BAR; G8_WAIT_L(0); G8_MMA(0, 1, At, B1); G8_BAR;
            G8_LDA(At, 1, 1); G8_STAGE_A(G8_SA(1, 0), a3, 0, last);
            G8_BAR; G8_WAIT_L(0); G8_MMA(1, 0, At, B0); G8_BAR; G8_SCHED;
            G8_STAGE(G8_SB(1, 1), b3 + hstepB, voffB);
            G8_WAIT_V(6); G8_BAR; G8_MMA(1, 1, At, B1); G8_BAR;
        }
        E(acc, cur, wr, wc, fr, fq);
        if (!has_next) break;
#pragma unroll
        for (int a = 0; a < 2; ++a)
#pragma unroll
            for (int b = 0; b < 2; ++b)
#pragma unroll
                for (int m = 0; m < 4; ++m)
#pragma unroll
                    for (int n = 0; n < 2; ++n) acc[a][b][m][n] = f32x4{0.f, 0.f, 0.f, 0.f};
        cur = nxt; cA = nA; cB = nB; ++ui;
#pragma unroll
        for (int h = 0; h < 2; ++h)
#pragma unroll
            for (int _i = 0; _i < 2; ++_i) goC[h][_i] = goN[h][_i];
    }
    G8_WAIT_V(0);
    if (wr == 0) G8_BAR;
    G8_BAR;
#undef G8_SA
#undef G8_SB
#undef G8_STAGE
#undef G8_STAGE_A
#undef G8_LDA
#undef G8_LDB
#undef G8_MMA
#undef G8_WAIT_V
#undef G8_WAIT_L
#undef G8_BAR
#undef G8_SCHED
#undef G8_GOFF
}
}


struct SKTile { const u16* A; int lda; const u16* B; int ldb; int nk; };
template <bool TR, class Dec, class Epi>
__device__ __forceinline__ void gemm_smallk_loop(u16* smem, int ntiles, const Dec& dec, const Epi& epi) {
    const int tid = tid_opaque(), lane = tid & 63, wid = tid >> 6;
    const int wm = wid >> 1, wn = wid & 1, fr = lane & 15, fq = lane >> 4;
    u16* As = smem; u16* Bs = smem + 2 * G_AS;
    const int arow = tid >> 3, akc = (tid & 7) * 8;
    uint4 p0, p1, p2, p3, q0, q1, s0, s1, s2, s3, u0, u1;
    s0 = s1 = s2 = s3 = u0 = u1 = make_uint4(0u, 0u, 0u, 0u);
#define SK_LD(T, KO, A0, A1, A2, A3, B0, B1) { const u16* pa_ = (T).A + (size_t)arow * (T).lda + (KO) + akc; const u16* pb_ = (T).B + (size_t)arow * (T).ldb + (KO) + akc; \
        A0 = *(const uint4*)pa_; A1 = *(const uint4*)(pa_ + (size_t)64 * (T).lda); A2 = *(const uint4*)(pa_ + (size_t)128 * (T).lda); A3 = *(const uint4*)(pa_ + (size_t)192 * (T).lda); \
        B0 = *(const uint4*)pb_; B1 = *(const uint4*)(pb_ + (size_t)64 * (T).ldb); }
#define SK_ST(AS, BS, A0, A1, A2, A3, B0, B1) { *(uint4*)((AS) + arow * GLD + akc) = A0; *(uint4*)((AS) + (arow + 64) * GLD + akc) = A1; *(uint4*)((AS) + (arow + 128) * GLD + akc) = A2; \
        *(uint4*)((AS) + (arow + 192) * GLD + akc) = A3; *(uint4*)((BS) + arow * GLD + akc) = B0; *(uint4*)((BS) + (arow + 64) * GLD + akc) = B1; }
    if ((int)blockIdx.x >= ntiles) return;
    {
        const SKTile c0 = dec(blockIdx.x);
        SK_LD(c0, 0, p0, p1, p2, p3, q0, q1)
        if (c0.nk > 1) SK_LD(c0, 64, s0, s1, s2, s3, u0, u1)
    }
#pragma unroll 1
    for (int id = blockIdx.x; id < ntiles; id += gridDim.x) {
        const SKTile cur = dec(id);
        const int nk = cur.nk;
        SK_ST(As, Bs, p0, p1, p2, p3, q0, q1)
        if (nk > 1) SK_ST(As + G_AS, Bs + G_BS, s0, s1, s2, s3, u0, u1)
        __syncthreads();
        const int nid = id + gridDim.x;
        if (nid < ntiles) {
            const SKTile nxt = dec(nid);
            SK_LD(nxt, 0, p0, p1, p2, p3, q0, q1)
            if (nxt.nk > 1) SK_LD(nxt, 64, s0, s1, s2, s3, u0, u1)
        }
        f32x4 acc[4][4];
#pragma unroll
        for (int m = 0; m < 4; ++m)
#pragma unroll
            for (int n = 0; n < 4; ++n) acc[m][n] = f32x4{0.f, 0.f, 0.f, 0.f};
#pragma unroll 1
        for (int kt = 0; kt < nk; ++kt) {
            const u16* Ab = As + kt * G_AS + (wm * 64 + fr) * GLD + fq * 8; const u16* Bb = Bs + kt * G_BS + (wn * 64 + fr) * GLD + fq * 8;
#pragma unroll
            for (int ks = 0; ks < 2; ++ks) {
                bf16x8 af[4], bfr[4];
#pragma unroll
                for (int m = 0; m < 4; ++m) af[m] = *(const bf16x8*)(Ab + m * 16 * GLD + ks * 32);
#pragma unroll
                for (int n = 0; n < 4; ++n) bfr[n] = *(const bf16x8*)(Bb + n * 16 * GLD + ks * 32);
#pragma unroll
                for (int m = 0; m < 4; ++m)
#pragma unroll
                    for (int n = 0; n < 4; ++n)
                        acc[m][n] = TR ? __builtin_amdgcn_mfma_f32_16x16x32_bf16(bfr[n], af[m], acc[m][n], 0, 0, 0) : __builtin_amdgcn_mfma_f32_16x16x32_bf16(af[m], bfr[n], acc[m][n], 0, 0, 0);
            }
        }
        epi(id, acc);
        __syncthreads();
    }
#undef SK_LD
#undef SK_ST
}

struct RowLoad {
    const u16* base; size_t ld;
    __device__ __forceinline__ uint4 operator()(int, int row, int k) const { return *(const uint4*)(base + (size_t)row * ld + k); }
};

#define EPI_LOOP(...) \
    { const int tid_ = tid_opaque(); const int lane_ = tid_ & 63, wid_ = tid_ >> 6; const int wm_ = wid_ >> 1, wn_ = wid_ & 1, fr_ = lane_ & 15, fq_ = lane_ >> 4; \
      _Pragma("unroll") for (int m = 0; m < 4; ++m) _Pragma("unroll") for (int n = 0; n < 4; ++n) _Pragma("unroll") for (int j = 0; j < 4; ++j) { \
          const int r = wm_ * 64 + m * 16 + fq_ * 4 + j; const int c = wn_ * 64 + n * 16 + fr_; const float v = acc[m][n][j]; __VA_ARGS__ } }

#define EPI_T(...) \
    { const int tid_ = tid_opaque(); const int lane_ = tid_ & 63, wid_ = tid_ >> 6; const int wm_ = wid_ >> 1, wn_ = wid_ & 1, fr_ = lane_ & 15, fq_ = lane_ >> 4; \
      _Pragma("unroll") for (int m = 0; m < 4; ++m) _Pragma("unroll") for (int n = 0; n < 4; ++n) { \
          const int r = wm_ * 64 + m * 16 + fr_; const int c0 = wn_ * 64 + n * 16 + fq_ * 4; const f32x4 v = acc[m][n]; __VA_ARGS__ } }
__device__ __forceinline__ uint2 pack4(const f32x4 v) { return make_uint2(pack2(v[0], v[1]), pack2(v[2], v[3])); }

__device__ __forceinline__ void conv_wave(const float* __restrict__ src, int K, int N, int f0, u16* __restrict__ dst, int ldd, int mapkind, int lane, float* tile) {
    const float* s = src + f0 + lane;
    for (int k0 = 0; k0 < K; k0 += 64) {
#pragma unroll 16
        for (int r = 0; r < 64; ++r) tile[r * 65 + lane] = __builtin_nontemporal_load(&s[(size_t)(k0 + r) * N]);
        asm volatile("s_waitcnt lgkmcnt(0)" ::: "memory");
#pragma unroll 2
        for (int c = 0; c < 8; ++c) {
            const int id = c * 64 + lane, fl = id >> 3, kc = id & 7;
            float v[8];
#pragma unroll
            for (int e = 0; e < 8; ++e) v[e] = tile[(kc * 8 + e) * 65 + fl];
            const int f = f0 + fl;
            int r = f;
            if (mapkind != 0) r = ((f >> 7) * 256) + (f & 127) + (mapkind == 2 ? 128 : 0);
            uint4 o; o.x = pack2(v[0], v[1]); o.y = pack2(v[2], v[3]); o.z = pack2(v[4], v[5]); o.w = pack2(v[6], v[7]);
            *(uint4*)(dst + (size_t)r * ldd + k0 + kc * 8) = o;
        }
        asm volatile("s_waitcnt lgkmcnt(0)" ::: "memory");
    }
}

__device__ __forceinline__ void phase_prologue_a(const PP p, char* smem) {
    const int t = tid_opaque(), lane = t & 63, wid = t >> 6;
    float* cs = (float*)smem;
    float* red = cs + 2048;
    for (int i = t; i < 2048; i += NTHR) { const float c = p.in(1)[i]; cs[i] = c / (1.0f + __expf(-c)); }
    __syncthreads();
    float* ada = (float*)(p.ws() + OFF_ADA);
    for (int item = blockIdx.x; item < 192; item += gridDim.x) {
        const int l = item / 48, cg = item % 48, cl = t & 127, kc = t >> 7;
        const int col = cg * 128 + cl;
        const float* w = p.in(2) + (size_t)l * 1024 * 6144 + col;
        float a0 = 0.f, a1 = 0.f;
#pragma unroll 8
        for (int k = kc * 256; k < kc * 256 + 256; ++k) { const float wv = w[(size_t)k * 6144]; a0 += cs[k] * wv; a1 += cs[1024 + k] * wv; }
        red[(kc * 128 + cl) * 2 + 0] = a0; red[(kc * 128 + cl) * 2 + 1] = a1;
        __syncthreads();
        if (t < 256) {
            const int b = t >> 7, c2 = t & 127;
            float s = 0.f;
            for (int q = 0; q < 4; ++q) s += red[(q * 128 + c2) * 2 + b];
            ada[(size_t)(l * 2 + b) * 6144 + cg * 128 + c2] = s + p.in(3)[(size_t)l * 6144 + cg * 128 + c2];
        }
        __syncthreads();
    }
    const int gw = blockIdx.x * 8 + wid, gstride = gridDim.x * 8;
    float* tile = (float*)smem + wid * (64 * 65);
    u16* WGU = (u16*)(p.ws() + OFF_WGU); u16* WD = (u16*)(p.ws() + OFF_WD);
    for (int w = gw; w < 256; w += gstride) {
        u16* d = WGU + (size_t)(w >> 1) * 1536 * 1024 + (size_t)(5 * 256 + (w & 1) * 128 + 64) * 1024;
        for (int q = lane; q < 64 * 1024 / 8; q += 64) *(uint4*)(d + (size_t)q * 8) = make_uint4(0u, 0u, 0u, 0u);
    }
    for (int w = gw; w < 5340; w += gstride) {
        if (w < 1408) { const int j = w / 11, g = w % 11; conv_wave(p.in(8) + (size_t)j * 1024 * 704, 1024, 704, g * 64, WGU + (size_t)j * 1536 * 1024, 1024, 1, lane, tile); }
        else if (w < 2816) { const int w2 = w - 1408; const int j = w2 / 11, g = w2 % 11; conv_wave(p.in(9) + (size_t)j * 1024 * 704, 1024, 704, g * 64, WGU + (size_t)j * 1536 * 1024, 1024, 2, lane, tile); }
        else if (w < 4864) { const int w2 = w - 2816; const int j = w2 >> 4, g = w2 & 15; conv_wave(p.in(10) + (size_t)j * 704 * 1024, 704, 1024, g * 64, WD + (size_t)j * 1024 * 704, 704, 0, lane, tile); }
        else {
            int w2 = w - 4864;
            if (w2 < 108) { const int j = w2 / 54, g = w2 % 54; conv_wave(p.in(11) + (size_t)j * 1024 * ABP, 1024, ABP, g * 64, (u16*)(p.ws() + OFF_WINE) + (size_t)j * 3584 * 1024, 1024, 0, lane, tile); continue; }
            w2 -= 108;
            if (w2 < 32) { const int j = w2 >> 4, g = w2 & 15; conv_wave(p.in(12) + (size_t)j * 1024 * 1024, 1024, 1024, g * 64, (u16*)(p.ws() + OFF_WOUTE) + (size_t)j * 1024 * 1024, 1024, 0, lane, tile); continue; }
            w2 -= 32;
            if (w2 < 96) { const int j = w2 / 48, g = w2 % 48; conv_wave(p.in(25) + (size_t)j * 1024 * 3072, 1024, 3072, g * 64, (u16*)(p.ws() + OFF_WINH) + (size_t)j * 3072 * 1024, 1024, 0, lane, tile); continue; }
            w2 -= 96;
            if (w2 < 32) { const int j = w2 >> 4, g = w2 & 15; conv_wave(p.in(37) + (size_t)j * 1024 * 1024, 1024, 1024, g * 64, (u16*)(p.ws() + OFF_WOUTH) + (size_t)j * 1024 * 1024, 1024, 0, lane, tile); continue; }
            w2 -= 32;
            if (w2 < 32) { const int j = w2 >> 3, g = w2 & 7; conv_wave(p.in(16) + (size_t)j * 64 * 512, 64, 512, g * 64, (u16*)(p.ws() + OFF_WUP) + (size_t)j * 512 * 64, 64, 0, lane, tile); continue; }
            w2 -= 32;
            if (w2 < 32) { const int j = w2 >> 3, g = w2 & 7; conv_wave(p.in(18) + (size_t)j * 64 * 512, 64, 512, g * 64, (u16*)(p.ws() + OFF_AUP) + (size_t)j * 512 * 64, 64, 0, lane, tile); continue; }
            w2 -= 32;
            if (w2 < 16) { const int j = w2 >> 3, g = w2 & 7; conv_wave(p.in(19) + (size_t)j * 128 * 512, 128, 512, g * 64, (u16*)(p.ws() + OFF_GUP) + (size_t)j * 512 * 128, 128, 0, lane, tile); continue; }
            w2 -= 16;
            { const int j = w2 >> 6, g = w2 & 63; conv_wave(p.in(35) + (size_t)j * 64 * 4096, 64, 4096, g * 64, (u16*)(p.ws() + OFF_W4T) + (size_t)j * 4096 * 64, 64, 0, lane, tile); }
        }
    }
}

__device__ __forceinline__ void phase_prologue_b(const PP p) {
    const float* ada = (const float*)(p.ws() + OFF_ADA);
    const float4* xin = (const float4*)p.in(0);
    uint2* xo = (uint2*)((u16*)p.out() + (size_t)T_ * 1024);
    uint2* hb = (uint2*)(p.ws() + OFF_HBUF);
    const int gsz = gridDim.x * NTHR;
    const int t0_ = tid_opaque();
    const int idx0 = blockIdx.x * NTHR + t0_, c4 = (idx0 & 255) * 4;
    const float4 sh0 = *(const float4*)(ada + c4), sc0 = *(const float4*)(ada + 1024 + c4);
    const float4 sh1 = *(const float4*)(ada + 6144 + c4), sc1 = *(const float4*)(ada + 6144 + 1024 + c4);
#pragma unroll 1
    for (int base = idx0; base < T_ * 256; base += 8 * gsz) {
        float4 v[8];
#pragma unroll
        for (int j = 0; j < 8; ++j) { const int idx = min(base + j * gsz, T_ * 256 - 1); v[j] = xin[idx]; }
        __builtin_amdgcn_sched_barrier(0);
#pragma unroll
        for (int j = 0; j < 8; ++j) {
            const int idx = base + j * gsz;
            if (idx < T_ * 256) {
                const bool b1 = (idx >> 8) >= L_;
                const float4 sh = b1 ? sh1 : sh0, sc = b1 ? sc1 : sc0;
                xo[idx] = make_uint2(pack2(v[j].x, v[j].y), pack2(v[j].z, v[j].w));
                uint2 o;
                o.x = pack2(v[j].x * (1.f + sc.x) + sh.x, v[j].y * (1.f + sc.y) + sh.y);
                o.y = pack2(v[j].z * (1.f + sc.z) + sh.z, v[j].w * (1.f + sc.w) + sh.w);
                hb[idx] = o;
            }
        }
    }
}


__device__ __forceinline__ bool xcd_deal(int i, int U, int& id) {
    int G = gridDim.x; asm volatile("" : "+s"(G));
    int bx = blockIdx.x; asm volatile("" : "+s"(bx));
    if (G & 7) { id = bx + i * G; return id < U; }
    const int x = bx & 7, r = bx >> 3, nper = G >> 3;
    const int q = U >> 3, rem = U & 7;
    const int cnt = q + (x < rem ? 1 : 0), start = x * q + min(x, rem);
    const int j = r + i * nper;
    id = start + j;
    return j < cnt;
}
struct SchedGrid {
    const char* A; const char* B; int nunits, npn; size_t astep, bstep; int npm_cm = 0;
    __device__ __forceinline__ bool operator()(int i, g8::Unit& u) const {
        int id; if (!xcd_deal(i, nunits, id)) return false;
        if (npm_cm > 0) { u.pn = id / npm_cm; u.pm = id - u.pn * npm_cm; }
        else { u.pm = id / npn; u.pn = id - u.pm * npn; } u.a = A + (size_t)u.pm * astep; u.b = B + (size_t)u.pn * bstep; u.aux = 0; return true;
    }
};
struct EpiBf16Rows {
    u16* O; size_t ld; int ncols;
    __device__ __forceinline__ void operator()(const f32x4 (&acc)[2][2][4][2], const g8::Unit& u, int wr, int wc, int fr, int fq) const {
#pragma unroll
        for (int ai = 0; ai < 2; ++ai)
#pragma unroll
            for (int m = 0; m < 4; ++m) {
                const size_t row = (size_t)u.pm * 256 + ai * 128 + wr * 64 + m * 16 + fr;
#pragma unroll
                for (int bj = 0; bj < 2; ++bj) {
                    const int col = u.pn * 256 + bj * 128 + wc * 32 + fq * 8;
                    if (col < ncols) {
                        const f32x4 v0 = acc[ai][bj][m][0], v1 = acc[ai][bj][m][1];
                        *(uint4*)(O + row * ld + col) = make_uint4(pack2(v0[0], v0[1]), pack2(v0[2], v0[3]), pack2(v1[0], v1[1]), pack2(v1[2], v1[3]));
                    }
                }
            }
    }
};
__device__ __forceinline__ void phase_g1(const PP p, char* smem, int i) {
    SchedGrid S; S.A = p.ws() + OFF_HBUF; S.B = p.ws() + OFF_WINE + (size_t)i * 3584 * 1024 * 2; S.nunits = 128 * 14; S.npn = 14;
    S.astep = (size_t)256 * 1024 * 2; S.bstep = (size_t)256 * 1024 * 2;
    EpiBf16Rows E; E.O = (u16*)(p.ws() + OFF_P); E.ld = ABP; E.ncols = ABP;
    g8::gemm<true, false>((G8_LAS unsigned char*)smem, 1024, 1024, 1024, nullptr, S, E);
}

__device__ __forceinline__ void na_tr3(unsigned a0, unsigned a1, unsigned a2, uint2& r0, uint2& r1, uint2& r2) {
    asm volatile("ds_read_b64_tr_b16 %0, %3\n\tds_read_b64_tr_b16 %1, %4\n\tds_read_b64_tr_b16 %2, %5\n\ts_waitcnt lgkmcnt(0)"
                 : "=&v"(r0), "=&v"(r1), "=&v"(r2) : "v"(a0), "v"(a1), "v"(a2) : "memory");
}
__device__ __forceinline__ void phase_na(const PP p, char* smem, int i) {
    const int t_outer = tid_opaque(); int t = t_outer; const int lane = t & 63, h = t >> 6, fr = lane & 15, g = lane >> 4;
    const u16* pp = (const u16*)(p.ws() + OFF_P);
    u16* mix = (u16*)(p.ws() + OFF_MIX);
    u16* Ks = (u16*)smem;
    u16* Vs = Ks + 48 * 520;
    float* rpb = (float*)(smem + 2 * 48 * 520 * 2);
    __syncthreads();
    for (int idx = t; idx < 8 * 15 * 31; idx += NTHR) rpb[idx] = p.in(13)[(size_t)i * 3720 + idx];
    { unsigned z_ = 0u; asm volatile("" : "+v"(z_));
      for (int idx = t; idx < 2 * 8 * 65; idx += NTHR) { const int m = idx / 520, rr = (idx % 520) / 65, cch = idx % 65; *(uint4*)((m ? Vs : Ks) + (40 + rr) * 520 + cch * 8) = make_uint4(z_, z_, z_, z_); } }
    const unsigned vs_addr = (unsigned)(size_t)Vs;
    for (int k_ = 0, item = 0; xcd_deal(k_, 1024, item); ++k_) {
        const int b = item >> 9, gi = (item >> 1) & 255, hr = item & 1;
        const int kb = hr * 24;
        const int rs = min(max(gi - 4, 0), 248);
        bf16x8 qb[2][2];
        int jq[2], cs[2];
#pragma unroll
        for (int nt = 0; nt < 2; ++nt) {
            jq[nt] = hr * 32 + 16 * nt + fr; cs[nt] = min(max(jq[nt] - 8, 0), 48);
            const u16* qrow = pp + ((size_t)b * L_ + gi * 64 + jq[nt]) * ABP + h * 64 + 8 * g;
            qb[nt][0] = *(const bf16x8*)qrow; qb[nt][1] = *(const bf16x8*)(qrow + 32);
        }
        f32x4 oacc[4][2];
#pragma unroll
        for (int dt = 0; dt < 4; ++dt)
#pragma unroll
            for (int nt = 0; nt < 2; ++nt) oacc[dt][nt] = f32x4{0.f, 0.f, 0.f, 0.f};
        float m_run[2] = {-1e30f, -1e30f}, l_run[2] = {0.f, 0.f};
        uint4 g0, g1, g2, g3, g4, g5, g6, g7, g8, g9;
#define NA_SRC(X, RR) (pp + ((size_t)b * L_ + (rs + (RR)) * 64 + kb + (((t + NTHR * (X)) - ((t + NTHR * (X)) >= 2560 ? 2560 : 0)) >> 6)) * ABP + 512 + ((t + NTHR * (X)) >= 2560 ? 512 : 0) + ((t + NTHR * (X)) & 63) * 8)
#define NA_DST(X) (((t + NTHR * (X)) >= 2560 ? Vs : Ks) + (((t + NTHR * (X)) - ((t + NTHR * (X)) >= 2560 ? 2560 : 0)) >> 6) * 520 + ((t + NTHR * (X)) & 63) * 8)
#define NA_LOAD(RR) { g0 = *(const uint4*)NA_SRC(0, RR); g1 = *(const uint4*)NA_SRC(1, RR); g2 = *(const uint4*)NA_SRC(2, RR); g3 = *(const uint4*)NA_SRC(3, RR); g4 = *(const uint4*)NA_SRC(4, RR); \
                      g5 = *(const uint4*)NA_SRC(5, RR); g6 = *(const uint4*)NA_SRC(6, RR); g7 = *(const uint4*)NA_SRC(7, RR); g8 = *(const uint4*)NA_SRC(8, RR); g9 = *(const uint4*)NA_SRC(9, RR); }
        NA_LOAD(0)
#pragma unroll 1
        for (int r = 0; r < 8; ++r) {
            t = t_outer; asm volatile("" : "+v"(t));
            __syncthreads();
            *(uint4*)NA_DST(0) = g0; *(uint4*)NA_DST(1) = g1; *(uint4*)NA_DST(2) = g2; *(uint4*)NA_DST(3) = g3; *(uint4*)NA_DST(4) = g4;
            *(uint4*)NA_DST(5) = g5; *(uint4*)NA_DST(6) = g6; *(uint4*)NA_DST(7) = g7; *(uint4*)NA_DST(8) = g8; *(uint4*)NA_DST(9) = g9;
            __syncthreads();
            if (r + 1 < 8) NA_LOAD(r + 1)
            f32x4 st[3][2];
#pragma unroll
            for (int mt = 0; mt < 3; ++mt) {
                st[mt][0] = f32x4{0.f, 0.f, 0.f, 0.f}; st[mt][1] = f32x4{0.f, 0.f, 0.f, 0.f};
#pragma unroll
                for (int s = 0; s < 2; ++s) {
                    const bf16x8 ka = *(const bf16x8*)(Ks + (16 * mt + fr) * 520 + h * 64 + 32 * s + 8 * g);
                    st[mt][0] = __builtin_amdgcn_mfma_f32_16x16x32_bf16(ka, qb[0][s], st[mt][0], 0, 0, 0);
                    st[mt][1] = __builtin_amdgcn_mfma_f32_16x16x32_bf16(ka, qb[1][s], st[mt][1], 0, 0, 0);
                }
            }
            const float* brow = rpb + (h * 15 + (rs + r - gi + 7)) * 31;
            bf16x8 pb[2][2];
#pragma unroll
            for (int nt = 0; nt < 2; ++nt) {
                float mx = -1e30f;
#pragma unroll
                for (int mt = 0; mt < 3; ++mt)
#pragma unroll
                    for (int jj = 0; jj < 4; ++jj) {
                        const int kc = kb + 16 * mt + 4 * g + jj;
                        const bool valid = (kc >= cs[nt]) && (kc < cs[nt] + 16) && (16 * mt + 4 * g + jj < 40);
                        const int bi = min(max(kc - jq[nt] + 15, 0), 30);
                        const float sv = valid ? (st[mt][nt][jj] * 0.125f + brow[bi]) : -1e30f;
                        st[mt][nt][jj] = sv; mx = fmaxf(mx, sv);
                    }
                mx = fmaxf(mx, __shfl_xor(mx, 16)); mx = fmaxf(mx, __shfl_xor(mx, 32));
                const float m_new = fmaxf(m_run[nt], mx);
                const float sc = __expf(m_run[nt] - m_new);
                m_run[nt] = m_new;
                float psum = 0.f;
#pragma unroll
                for (int mt = 0; mt < 3; ++mt)
#pragma unroll
                    for (int jj = 0; jj < 4; ++jj) { const float sv = st[mt][nt][jj]; const float pr = (sv > -1e29f) ? __expf(sv - m_new) : 0.f; st[mt][nt][jj] = pr; psum += pr; }
                psum += __shfl_xor(psum, 16); psum += __shfl_xor(psum, 32);
                l_run[nt] = l_run[nt] * sc + psum;
#pragma unroll
                for (int dt = 0; dt < 4; ++dt) oacc[dt][nt] *= sc;
                union { bf16x8 v; unsigned u[4]; } c0, c1;
                c0.u[0] = pack2(st[0][nt][0], st[0][nt][1]); c0.u[1] = pack2(st[0][nt][2], st[0][nt][3]);
                c0.u[2] = pack2(st[1][nt][0], st[1][nt][1]); c0.u[3] = pack2(st[1][nt][2], st[1][nt][3]);
                c1.u[0] = pack2(st[2][nt][0], st[2][nt][1]); c1.u[1] = pack2(st[2][nt][2], st[2][nt][3]); c1.u[2] = 0u; c1.u[3] = 0u;
                pb[nt][0] = c0.v; pb[nt][1] = c1.v;
            }
            {
                const int q4 = fr >> 2, p4 = fr & 3;
#pragma unroll
                for (int dt = 0; dt < 4; ++dt) {
                    const unsigned base = vs_addr + (unsigned)(((4 * g + q4) * 520 + h * 64 + 16 * dt + 4 * p4) * 2);
                    uint2 r0, r1, r2;
                    na_tr3(base, base + 16 * 520 * 2, base + 32 * 520 * 2, r0, r1, r2);
                    union { bf16x8 v; unsigned u[4]; } a0, a1;
                    a0.u[0] = r0.x; a0.u[1] = r0.y; a0.u[2] = r1.x; a0.u[3] = r1.y;
                    a1.u[0] = r2.x; a1.u[1] = r2.y; a1.u[2] = 0u; a1.u[3] = 0u;
#pragma unroll
                    for (int nt = 0; nt < 2; ++nt) {
                        oacc[dt][nt] = __builtin_amdgcn_mfma_f32_16x16x32_bf16(a0.v, pb[nt][0], oacc[dt][nt], 0, 0, 0);
                        oacc[dt][nt] = __builtin_amdgcn_mfma_f32_16x16x32_bf16(a1.v, pb[nt][1], oacc[dt][nt], 0, 0, 0);
                    }
                }
            }
        }
#undef NA_LOAD
#undef NA_SRC
#undef NA_DST
#pragma unroll
        for (int nt = 0; nt < 2; ++nt) {
            const float inv = 1.0f / l_run[nt];
            u16* orow = mix + ((size_t)b * L_ + gi * 64 + jq[nt]) * 1024 + h * 64 + 4 * g;
#pragma unroll
            for (int dt = 0; dt < 4; ++dt)
                *(uint2*)(orow + 16 * dt) = make_uint2(pack2(oacc[dt][nt][0] * inv, oacc[dt][nt][1] * inv), pack2(oacc[dt][nt][2] * inv, oacc[dt][nt][3] * inv));
        }
    }
}

__device__ __forceinline__ void phase_rwprep(const PP p, int i) {
    const int t = tid_opaque(); const int lane = t & 63, wid = t >> 6;
    const u16* pp = (const u16*)(p.ws() + OFF_P);
    const float* mu = p.in(14) + (size_t)i * 2 * 1920;
    const float* kkw = p.in(20) + (size_t)i * 512;
    u16* R = (u16*)(p.ws() + RW_R); u16* V = (u16*)(p.ws() + RW_V); u16* KK = (u16*)(p.ws() + RW_KK);
    u16* KP = (u16*)(p.ws() + O_KP); u16* AWD = (u16*)(p.ws() + O_AWD); u16* AAD = (u16*)(p.ws() + O_AAD); u16* AGD = (u16*)(p.ws() + O_AGD);
    const int nw = gridDim.x * 8, per = (T_ + nw - 1) / nw;
    const int tok0 = (blockIdx.x * 8 + wid) * per, tok1 = min(tok0 + per, T_);
    if (tok0 >= tok1) return;
    float m0[30], m1[30];
#pragma unroll
    for (int ii = 0; ii < 30; ++ii) { m0[ii] = mu[lane + 64 * ii]; m1[ii] = mu[1920 + lane + 64 * ii]; }
    u16 rp[30], rc[30], rn[30];
    {
        const u16* cur = pp + (size_t)tok0 * ABP + 1536;
        const bool hasp = (tok0 & (L_ - 1)) > 0;
#pragma unroll
        for (int ii = 0; ii < 30; ++ii) { rc[ii] = cur[lane + 64 * ii]; rp[ii] = hasp ? cur[lane + 64 * ii - ABP] : (u16)0; }
    }
#pragma unroll 1
    for (int tok = tok0; tok < tok1; ++tok) {
        const int l = tok & (L_ - 1);
        const bool hasn = l < L_ - 1, hasp = l > 0;
        const u16* cur = pp + (size_t)tok * ABP + 1536;
        if (tok + 1 < T_) {
#pragma unroll
            for (int ii = 0; ii < 30; ++ii) rn[ii] = cur[lane + 64 * ii + ABP];
        }
#pragma unroll
        for (int ii = 0; ii < 30; ++ii) {
            const int col = lane + 64 * ii;
            const float c = bf2f(rc[ii]);
            const float pv = hasp ? bf2f(rp[ii]) : 0.f;
            const float nv = hasn ? bf2f(rn[ii]) : 0.f;
            const float x = c + m0[ii] * (pv - c) + m1[ii] * (nv - c);
            if (ii < 8) R[(size_t)tok * 512 + col] = f2bf(x);
            else if (ii < 16) {
                const int kc = col - 512;
                KP[(size_t)tok * 512 + kc] = f2bf(x);
                const float kv = x * kkw[kc];
                const float ss = wave_sum(kv * kv);
                KK[(size_t)tok * 512 + kc] = f2bf(kv * rsqrtf(ss + 1e-12f));
            }
            else if (ii < 24) V[(size_t)tok * 512 + col - 1024] = f2bf(x);
            else if (ii < 26) AWD[(size_t)tok * 128 + col - 1536] = f2bf(tanhf(x));
            else if (ii < 28) AAD[(size_t)tok * 128 + col - 1664] = f2bf(x);
            else AGD[(size_t)tok * 128 + col - 1792] = f2bf(sigmoidf_(x));
        }
#pragma unroll
        for (int ii = 0; ii < 30; ++ii) { rp[ii] = rc[ii]; rc[ii] = rn[ii]; }
    }
}

__device__ __forceinline__ void phase_lora(const PP p, char* smem, int i) {
    const u16* AWD = (const u16*)(p.ws() + O_AWD); const u16* AAD = (const u16*)(p.ws() + O_AAD); const u16* AGD = (const u16*)(p.ws() + O_AGD);
    const u16* KP = (const u16*)(p.ws() + O_KP); const u16* KK = (const u16*)(p.ws() + RW_KK);
    __half* Wb = (__half*)(p.ws() + RW_W); u16* KD = (u16*)(p.ws() + RW_KD); u16* BQ = (u16*)(p.ws() + RW_BQ); u16* G = (u16*)(p.ws() + RW_G);
    const u16* WUPp = (const u16*)(p.ws() + OFF_WUP); const u16* AUPp = (const u16*)(p.ws() + OFF_AUP); const u16* GUPp = (const u16*)(p.ws() + OFF_GUP);
    const float* w0b = p.in(15) + (size_t)i * 1024; const float* a0b = p.in(17) + (size_t)i * 1024; const float* ka = p.in(21) + (size_t)i * 512;
    auto dec = [&](int id) __attribute__((always_inline)) {
        const int sub = id >> 9, rem = id & 511, tm = rem >> 2, tn = rem & 3;
        SKTile tl;
        if (sub < 2)      { tl.A = AWD + (size_t)tm * 256 * 128 + sub * 64; tl.lda = 128; tl.B = WUPp + ((size_t)(i * 2 + sub) * 512 + tn * 128) * 64; tl.ldb = 64; tl.nk = 1; }
        else if (sub < 4) { tl.A = AAD + (size_t)tm * 256 * 128 + (sub - 2) * 64; tl.lda = 128; tl.B = AUPp + ((size_t)(i * 2 + sub - 2) * 512 + tn * 128) * 64; tl.ldb = 64; tl.nk = 1; }
        else              { tl.A = AGD + (size_t)tm * 256 * 128; tl.lda = 128; tl.B = GUPp + ((size_t)i * 512 + tn * 128) * 128; tl.ldb = 128; tl.nk = 2; }
        return tl;
    };
    auto epi = [&](int id, f32x4 (&acc)[4][4]) __attribute__((always_inline)) {
        const int sub = id >> 9, rem = id & 511, tm = rem >> 2, tn = rem & 3;
        const int tid_ = tid_opaque(); const int lane_ = tid_ & 63, wid_ = tid_ >> 6; const int wm_ = wid_ >> 1, wn_ = wid_ & 1, fr_ = lane_ & 15, fq_ = lane_ >> 4;
        if (sub < 2) {
            const int d = sub; const float* w0 = w0b + d * 512;
            float4 w0v[4];
#pragma unroll
            for (int n = 0; n < 4; ++n) w0v[n] = *(const float4*)(w0 + tn * 128 + wn_ * 64 + n * 16 + fq_ * 4);
            __builtin_amdgcn_sched_barrier(0);
#pragma unroll
            for (int m = 0; m < 4; ++m)
#pragma unroll
                for (int n = 0; n < 4; ++n) {
                    const int col = tn * 128 + wn_ * 64 + n * 16 + fq_ * 4; const size_t tok = (size_t)tm * 256 + wm_ * 64 + m * 16 + fr_; const f32x4 v = acc[m][n];
                    const __half2 h0 = __floats2half2_rn(__expf(-0.606531f * sigmoidf_(w0v[n].x + v[0])), __expf(-0.606531f * sigmoidf_(w0v[n].y + v[1])));
                    const __half2 h1 = __floats2half2_rn(__expf(-0.606531f * sigmoidf_(w0v[n].z + v[2])), __expf(-0.606531f * sigmoidf_(w0v[n].w + v[3])));
                    uint2 o; o.x = *(const unsigned*)&h0; o.y = *(const unsigned*)&h1;
                    *(uint2*)(Wb + (tok * 2 + d) * 512 + col) = o;
                }
        } else if (sub < 4) {
            const int d = sub - 2; const float* a0 = a0b + d * 512;
            float4 a0v[4], kav[4];
#pragma unroll
            for (int n = 0; n < 4; ++n) { const int col = tn * 128 + wn_ * 64 + n * 16 + fq_ * 4; a0v[n] = *(const float4*)(a0 + col); kav[n] = *(const float4*)(ka + col); }
#pragma unroll
            for (int m = 0; m < 4; ++m) {
                const size_t tok = (size_t)tm * 256 + wm_ * 64 + m * 16 + fr_;
                uint2 kpu[4], kku[4];
#pragma unroll
                for (int n = 0; n < 4; ++n) { const int col = tn * 128 + wn_ * 64 + n * 16 + fq_ * 4; kpu[n] = *(const uint2*)(KP + tok * 512 + col); kku[n] = *(const uint2*)(KK + tok * 512 + col); }
                __builtin_amdgcn_sched_barrier(0);
#pragma unroll
                for (int n = 0; n < 4; ++n) {
                    const int col = tn * 128 + wn_ * 64 + n * 16 + fq_ * 4; const f32x4 v = acc[m][n];
                    const float i0 = sigmoidf_(a0v[n].x + v[0]), i1 = sigmoidf_(a0v[n].y + v[1]), i2 = sigmoidf_(a0v[n].z + v[2]), i3 = sigmoidf_(a0v[n].w + v[3]);
                    uint2 okd, obq;
                    okd.x = pack2(lo2f(kpu[n].x) * (1.0f + (i0 - 1.0f) * kav[n].x), hi2f(kpu[n].x) * (1.0f + (i1 - 1.0f) * kav[n].y));
                    okd.y = pack2(lo2f(kpu[n].y) * (1.0f + (i2 - 1.0f) * kav[n].z), hi2f(kpu[n].y) * (1.0f + (i3 - 1.0f) * kav[n].w));
                    obq.x = pack2(lo2f(kku[n].x) * i0, hi2f(kku[n].x) * i1); obq.y = pack2(lo2f(kku[n].y) * i2, hi2f(kku[n].y) * i3);
                    *(uint2*)(KD + (tok * 2 + d) * 512 + col) = okd; *(uint2*)(BQ + (tok * 2 + d) * 512 + col) = obq;
                }
            }
        } else {
            EPI_T( *(uint2*)(G + ((size_t)tm * 256 + r) * 512 + tn * 128 + c0) = pack4(v); )
        }
    };
    gemm_smallk_loop<true>((u16*)smem, 2560, dec, epi);
}

constexpr size_t SC_PM = OFF_P;
constexpr size_t SC_OM = OFF_P + ((size_t)64 << 20);
constexpr size_t SC_QM = OFF_P + ((size_t)128 << 20);
constexpr size_t SC_OL = OFF_HBUF;
constexpr size_t SC_PG = OFF_P + ((size_t)192 << 20);
constexpr size_t SC_QG = SC_PG + ((size_t)4 << 20);
__device__ __forceinline__ int kpos(int kp) { const int kk = kp & 31; return (kp & 32) + ((kk & 15) >> 2) * 8 + (kk >> 4) * 4 + (kk & 3); }
__device__ __forceinline__ f32x4 mm64(const u16* A, const u16* Bt, int m, int n, int fr, int fq, f32x4 acc) {
#pragma unroll
    for (int s2 = 0; s2 < 2; ++s2) {
        const bf16x8 af = *(const bf16x8*)(A + (m * 16 + fr) * 72 + s2 * 32 + fq * 8);
        const bf16x8 bf = *(const bf16x8*)(Bt + (n * 16 + fr) * 72 + s2 * 32 + fq * 8);
        acc = __builtin_amdgcn_mfma_f32_16x16x32_bf16(af, bf, acc, 0, 0, 0);
    }
    return acc;
}
__device__ __forceinline__ void mm64x4(const u16* A, const u16* Bt, int m, int fr, int fq, f32x4 (&acc)[4]) {
    bf16x8 af[2], bf[4][2];
#pragma unroll
    for (int s2 = 0; s2 < 2; ++s2) af[s2] = *(const bf16x8*)(A + (m * 16 + fr) * 72 + s2 * 32 + fq * 8);
#pragma unroll
    for (int n = 0; n < 4; ++n)
#pragma unroll
        for (int s2 = 0; s2 < 2; ++s2) bf[n][s2] = *(const bf16x8*)(Bt + (n * 16 + fr) * 72 + s2 * 32 + fq * 8);
    __builtin_amdgcn_sched_barrier(0);
#pragma unroll
    for (int s2 = 0; s2 < 2; ++s2)
#pragma unroll
        for (int n = 0; n < 4; ++n) acc[n] = __builtin_amdgcn_mfma_f32_16x16x32_bf16(af[s2], bf[n][s2], acc[n], 0, 0, 0);
}
__device__ __forceinline__ float dpp_xor1(float v) { return __int_as_float(__builtin_amdgcn_update_dpp(0, __float_as_int(v), 0xB1, 0xf, 0xf, false)); }
__device__ __forceinline__ float dpp_xor2(float v) { return __int_as_float(__builtin_amdgcn_update_dpp(0, __float_as_int(v), 0x4E, 0xf, 0xf, false)); }
__device__ __forceinline__ float dpp_hmir(float v) { return __int_as_float(__builtin_amdgcn_update_dpp(0, __float_as_int(v), 0x141, 0xf, 0xf, false)); }
__device__ __forceinline__ void unpack8(const uint4 u, float (&o)[8]) {
    o[0] = lo2f(u.x); o[1] = hi2f(u.x); o[2] = lo2f(u.y); o[3] = hi2f(u.y); o[4] = lo2f(u.z); o[5] = hi2f(u.z); o[6] = lo2f(u.w); o[7] = hi2f(u.w);
}
__device__ __forceinline__ void phase_scanA(const PP p, char* smem) {
    const int t0 = tid_opaque();
    u16* M = (u16*)smem;
#define MX(idx) (M + (idx) * 4608)
    float* ABF = (float*)(smem + 13 * 9216);
    u16* M13 = (u16*)ABF; u16* M14 = M13 + 4608;
    float* GC = (float*)(smem + 138240);
    float* SEG = GC + 64;
    const __half* Wb = (const __half*)(p.ws() + RW_W);
    const u16* KK = (const u16*)(p.ws() + RW_KK); const u16* BQ = (const u16*)(p.ws() + RW_BQ); const u16* KD = (const u16*)(p.ws() + RW_KD);
    const u16* R = (const u16*)(p.ws() + RW_R); const u16* V = (const u16*)(p.ws() + RW_V);
    u16* PM = (u16*)(p.ws() + SC_PM); u16* OM = (u16*)(p.ws() + SC_OM); u16* QM = (u16*)(p.ws() + SC_QM); u16* OL = (u16*)(p.ws() + SC_OL);
    uint4 wraw, ukk, ubq, ukd, ur, uv;
#define SA_LOAD(ITEM) { const int ch_ = (ITEM) >> 8, ck_ = (ITEM) & 255; const int d_ = ch_ >> 4, b_ = (ch_ >> 3) & 1, h_ = ch_ & 7; \
        const int li_ = t0 >> 3, lk_ = (t0 & 7) * 8; const int tt_ = d_ ? (L_ - 1 - (ck_ * 64 + li_)) : (ck_ * 64 + li_); const size_t tk_ = (size_t)b_ * L_ + tt_; \
        const size_t g1_ = tk_ * 512 + h_ * 64 + lk_, g2_ = (tk_ * 2 + d_) * 512 + h_ * 64 + lk_; \
        wraw = *(const uint4*)(Wb + g2_); ukk = *(const uint4*)(KK + g1_); ubq = *(const uint4*)(BQ + g2_); ukd = *(const uint4*)(KD + g2_); ur = *(const uint4*)(R + g1_); uv = *(const uint4*)(V + g1_); }
    if ((int)blockIdx.x < 8192) SA_LOAD(blockIdx.x)
#pragma unroll 1
    for (int item = blockIdx.x; item < 8192; item += gridDim.x) {
        const int chain = item >> 8, chunk = item & 255;
        const int d = chain >> 4, b = (chain >> 3) & 1, h = chain & 7;
        int t = t0; asm volatile("" : "+v"(t));
        const int lane = t & 63, wid = t >> 6, fr = lane & 15, fq = lane >> 4;
        const int li = t >> 3, lk0 = (t & 7) * 8;
        __syncthreads();
        {
            const __half2* hp = (const __half2*)&wraw;
            const float2 w0 = __half22float2(hp[0]), w1 = __half22float2(hp[1]), w2 = __half22float2(hp[2]), w3 = __half22float2(hp[3]);
            *(float4*)(ABF + li * 72 + lk0) = make_float4(w0.x, w0.y, w1.x, w1.y);
            *(float4*)(ABF + li * 72 + lk0 + 4) = make_float4(w2.x, w2.y, w3.x, w3.y);
        }
        __syncthreads();
        {
            const int k = t & 63, seg = t >> 6;
            float pr = 1.f;
#pragma unroll
            for (int x = 0; x < 8; ++x) { pr *= ABF[(seg * 8 + x) * 72 + k]; ABF[(seg * 8 + x) * 72 + k] = pr; }
            SEG[seg * 64 + k] = pr;
            __syncthreads();
            float pre = 1.f;
#pragma unroll
            for (int s2 = 0; s2 < 7; ++s2) if (s2 < seg) pre *= SEG[s2 * 64 + k];
#pragma unroll
            for (int x = 0; x < 8; ++x) ABF[(seg * 8 + x) * 72 + k] *= pre;
            if (seg == 7) GC[k] = ABF[63 * 72 + k];
        }
        __syncthreads();
        {
            float G[8], Gm[8], fa[8], fb[8], fk[8], frr[8];
            *(float4*)&G[0] = *(const float4*)(ABF + li * 72 + lk0); *(float4*)&G[4] = *(const float4*)(ABF + li * 72 + lk0 + 4);
            if (li > 0) { *(float4*)&Gm[0] = *(const float4*)(ABF + (li - 1) * 72 + lk0); *(float4*)&Gm[4] = *(const float4*)(ABF + (li - 1) * 72 + lk0 + 4); }
            else {
#pragma unroll
                for (int e = 0; e < 8; ++e) Gm[e] = 1.f;
            }
            unpack8(ukk, fa); unpack8(ubq, fb); unpack8(ukd, fk); unpack8(ur, frr);
            unsigned pa[4], pb[4], pk[4], prr[4];
#pragma unroll
            for (int e = 0; e < 8; e += 2) {
                const float r0 = __builtin_amdgcn_rcpf(G[e]), r1 = __builtin_amdgcn_rcpf(G[e + 1]);
                pa[e >> 1] = pack2(-fa[e] * Gm[e], -fa[e + 1] * Gm[e + 1]);
                pb[e >> 1] = pack2(fb[e] * r0, fb[e + 1] * r1);
                pk[e >> 1] = pack2(fk[e] * r0, fk[e + 1] * r1);
                prr[e >> 1] = pack2(frr[e] * G[e], frr[e + 1] * G[e + 1]);
            }
            *(uint4*)(MX(0) + li * 72 + lk0) = make_uint4(pa[0], pa[1], pa[2], pa[3]);
            *(uint4*)(MX(2) + li * 72 + lk0) = make_uint4(pb[0], pb[1], pb[2], pb[3]);
            *(uint4*)(MX(4) + li * 72 + lk0) = make_uint4(pk[0], pk[1], pk[2], pk[3]);
            *(uint4*)(MX(6) + li * 72 + lk0) = make_uint4(prr[0], prr[1], prr[2], prr[3]);
            *(uint4*)(MX(8) + li * 72 + lk0) = uv;
        }
        __syncthreads();
        {
            const int k = t & 63, i0 = (t >> 6) * 8;
#pragma unroll
            for (int mtx = 0; mtx < 4; ++mtx) {
                const u16* src = (mtx == 0) ? MX(0) : (mtx == 1) ? MX(2) : (mtx == 2) ? MX(4) : MX(8);
                u16* dst = (mtx == 0) ? MX(1) : (mtx == 1) ? MX(3) : (mtx == 2) ? MX(5) : MX(7);
                unsigned w[4];
#pragma unroll
                for (int e = 0; e < 4; ++e) w[e] = (unsigned)src[(i0 + 2 * e) * 72 + k] | ((unsigned)src[(i0 + 2 * e + 1) * 72 + k] << 16);
                *(uint4*)(dst + k * 72 + i0) = make_uint4(w[0], w[1], w[2], w[3]);
            }
        }
        if (item + (int)gridDim.x < 8192) SA_LOAD(item + gridDim.x)
        __syncthreads();
#pragma unroll
        for (int x = 0; x < 2; ++x) {
            const int pm = wid * 2 + x, prod = pm >> 2, m = pm & 3;
            const u16* A = (prod < 2) ? MX(0) : MX(6);
            const u16* Bt = (prod & 1) ? MX(4) : MX(2);
            f32x4 acc4[4] = {f32x4{0.f, 0.f, 0.f, 0.f}, f32x4{0.f, 0.f, 0.f, 0.f}, f32x4{0.f, 0.f, 0.f, 0.f}, f32x4{0.f, 0.f, 0.f, 0.f}};
            mm64x4(A, Bt, m, fr, fq, acc4);
#pragma unroll
            for (int n = 0; n < 4; ++n) {
                const f32x4 acc = acc4[n];
#pragma unroll
                for (int j = 0; j < 4; ++j) {
                    const int i = 16 * m + 4 * fq + j, jc = 16 * n + fr;
                    const bool keep = (prod < 2) ? (jc < i) : (jc <= i);
                    const float val = keep ? acc[j] : 0.f;
                    if (prod == 0) ABF[i * 72 + jc] = val;
                    else MX(7 + prod)[i * 72 + jc] = f2bf(val);
                }
            }
        }
        __syncthreads();
        {
            const int c = 8 * wid + (lane >> 3), jg = lane & 7;
            float Tl[8];
#pragma unroll
            for (int e = 0; e < 8; ++e) Tl[e] = 0.f;
            float4 ra[8][2];
#pragma unroll
            for (int ii = 0; ii < 8; ++ii) { ra[ii][0] = *(const float4*)(ABF + ii * 72 + 8 * jg); ra[ii][1] = *(const float4*)(ABF + ii * 72 + 8 * jg + 4); }
#pragma unroll
            for (int ib = 0; ib < 8; ++ib) {
                float4 rn[8][2];
#pragma unroll
                for (int ii = 0; ii < 8; ++ii) {
                    const int i2 = (ib < 7) ? (8 * (ib + 1) + ii) : ii;
                    rn[ii][0] = *(const float4*)(ABF + i2 * 72 + 8 * jg); rn[ii][1] = *(const float4*)(ABF + i2 * 72 + 8 * jg + 4);
                }
                __builtin_amdgcn_sched_barrier(0);
#pragma unroll
                for (int ii = 0; ii < 8; ++ii) {
                    const int i = 8 * ib + ii;
                    const float4 a0 = ra[ii][0], a1 = ra[ii][1];
                    const float av[8] = {a0.x, a0.y, a0.z, a0.w, a1.x, a1.y, a1.z, a1.w};
                    const int es = (i + 7) & 7;
                    float p7 = (c == i && jg == 0) ? 1.f : 0.f;
#pragma unroll
                    for (int e = 0; e < 8; ++e) if (e != es) p7 += av[e] * Tl[e];
                    float part = p7 + av[es] * Tl[es];
                    part += dpp_xor1(part); part += dpp_xor2(part); part += dpp_hmir(part);
                    Tl[i & 7] = (jg == (i >> 3)) ? part : Tl[i & 7];
                }
                __builtin_amdgcn_sched_barrier(0);
#pragma unroll
                for (int ii = 0; ii < 8; ++ii) { ra[ii][0] = rn[ii][0]; ra[ii][1] = rn[ii][1]; }
            }
#pragma unroll
            for (int e = 0; e < 8; ++e) MX(11)[(8 * jg + e) * 72 + c] = f2bf(Tl[e]);
#pragma unroll
            for (int x = 0; x < 2; ++x) {
                const int id = wid * 2 + x, m = id >> 2, n = id & 3;
                const f32x4 acc = mm64(MX(8), MX(7), m, n, fr, fq, f32x4{0.f, 0.f, 0.f, 0.f});
                uint2 o; o.x = pack2(acc[0], acc[1]); o.y = pack2(acc[2], acc[3]);
                *(uint2*)(MX(12) + (16 * n + fr) * 72 + 16 * m + 4 * fq) = o;
            }
        }
        __syncthreads();
        {
            const int prod = wid >> 2, m = wid & 3;
            const u16* Bt = prod ? MX(1) : MX(12);
            u16* dst = prod ? M14 : M13;
            f32x4 acc4[4] = {f32x4{0.f, 0.f, 0.f, 0.f}, f32x4{0.f, 0.f, 0.f, 0.f}, f32x4{0.f, 0.f, 0.f, 0.f}, f32x4{0.f, 0.f, 0.f, 0.f}};
            mm64x4(MX(11), Bt, m, fr, fq, acc4);
#pragma unroll
            for (int n = 0; n < 4; ++n) {
                const f32x4 acc = acc4[n];
                uint2 o; o.x = pack2(acc[0], acc[1]); o.y = pack2(acc[2], acc[3]);
                *(uint2*)(dst + (16 * n + fr) * 72 + 16 * m + 4 * fq) = o;
            }
        }
        __syncthreads();
        {
            const int mat = wid >> 1;
            u16* SA = MX(8); u16* SB = MX(1);
#pragma unroll
            for (int mm = 0; mm < 2; ++mm) {
                const int m = (wid & 1) * 2 + mm;
                f32x4 acc4[4] = {f32x4{0.f, 0.f, 0.f, 0.f}, f32x4{0.f, 0.f, 0.f, 0.f}, f32x4{0.f, 0.f, 0.f, 0.f}, f32x4{0.f, 0.f, 0.f, 0.f}};
                if (mat == 0) {
                    mm64x4(MX(9), M14, m, fr, fq, acc4);
#pragma unroll
                    for (int n = 0; n < 4; ++n)
#pragma unroll
                        for (int j = 0; j < 4; ++j) {
                            const int i = 16 * m + 4 * fq + j, kp = 16 * n + fr;
                            SA[i * 64 + kpos(kp)] = f2bf(acc4[n][j] + bf2f(MX(6)[i * 72 + kp]));
                        }
                } else if (mat == 1) {
                    mm64x4(MX(9), M13, m, fr, fq, acc4);
                    mm64x4(MX(10), MX(7), m, fr, fq, acc4);
#pragma unroll
                    for (int n = 0; n < 4; ++n) {
                        uint2 o; o.x = pack2(acc4[n][0], acc4[n][1]); o.y = pack2(acc4[n][2], acc4[n][3]);
                        *(uint2*)(OL + (((size_t)item * 4 + n) * 4 + m) * 256 + lane * 4) = o;
                    }
                } else if (mat == 2) {
                    mm64x4(MX(3), M14, m, fr, fq, acc4);
#pragma unroll
                    for (int n = 0; n < 4; ++n)
#pragma unroll
                        for (int j = 0; j < 4; ++j) {
                            const int k = 16 * m + 4 * fq + j, kp = 16 * n + fr;
                            SB[k * 64 + kpos(kp)] = f2bf((acc4[n][j] + ((k == kp) ? 1.f : 0.f)) * GC[k]);
                        }
                } else {
                    mm64x4(MX(3), M13, m, fr, fq, acc4);
                    mm64x4(MX(5), MX(7), m, fr, fq, acc4);
                    const int k0 = 16 * m + 4 * fq;
#pragma unroll
                    for (int n = 0; n < 4; ++n) {
                        uint2 o; o.x = pack2(acc4[n][0] * GC[k0], acc4[n][1] * GC[k0 + 1]); o.y = pack2(acc4[n][2] * GC[k0 + 2], acc4[n][3] * GC[k0 + 3]);
                        *(uint2*)(QM + (((size_t)item * 4 + n) * 4 + m) * 256 + lane * 4) = o;
                    }
                }
            }
            __syncthreads();
            *(uint4*)(OM + (size_t)item * 4096 + t * 8) = *(const uint4*)(SA + t * 8);
            *(uint4*)(PM + (size_t)item * 4096 + t * 8) = *(const uint4*)(SB + t * 8);
        }
    }
#undef MX
#undef SA_LOAD
}

struct StepRegs { bf16x8 pa[4][2]; uint2 qf[4]; };
__device__ __forceinline__ void sb_load(StepRegs& r, const u16* Pm, const u16* Qf, int fr, int fq, int lane) {
#pragma unroll
    for (int m = 0; m < 4; ++m) {
#pragma unroll
        for (int s2 = 0; s2 < 2; ++s2) r.pa[m][s2] = *(const bf16x8*)(Pm + (16 * m + fr) * 64 + 32 * s2 + 8 * fq);
        r.qf[m] = *(const uint2*)(Qf + m * 256 + lane * 4);
    }
}
__device__ __forceinline__ void sb_apply(const StepRegs& r, const bf16x8 (&sb)[2], f32x4 (&acc)[4]) {
#pragma unroll
    for (int m = 0; m < 4; ++m) acc[m] = f32x4{lo2f(r.qf[m].x), hi2f(r.qf[m].x), lo2f(r.qf[m].y), hi2f(r.qf[m].y)};
#pragma unroll
    for (int s2 = 0; s2 < 2; ++s2)
#pragma unroll
        for (int m = 0; m < 4; ++m) acc[m] = __builtin_amdgcn_mfma_f32_16x16x32_bf16(r.pa[m][s2], sb[s2], acc[m], 0, 0, 0);
}
__device__ __forceinline__ void sb_pack(const f32x4 (&acc)[4], bf16x8 (&sb)[2]) {
#pragma unroll
    for (int s2 = 0; s2 < 2; ++s2) {
        union { bf16x8 v; unsigned u[4]; } cv;
        cv.u[0] = pack2(acc[2 * s2][0], acc[2 * s2][1]); cv.u[1] = pack2(acc[2 * s2][2], acc[2 * s2][3]);
        cv.u[2] = pack2(acc[2 * s2 + 1][0], acc[2 * s2 + 1][1]); cv.u[3] = pack2(acc[2 * s2 + 1][2], acc[2 * s2 + 1][3]);
        sb[s2] = cv.v;
    }
}

__device__ __forceinline__ void phase_scanB1(const PP p) {
    const int t = tid_opaque(), lane = t & 63, wid = t >> 6, fr = lane & 15, fq = lane >> 4;
    const u16* PM = (const u16*)(p.ws() + SC_PM); const u16* QM = (const u16*)(p.ws() + SC_QM);
    u16* PG = (u16*)(p.ws() + SC_PG); u16* QG = (u16*)(p.ws() + SC_QG);
    const int ng = wid & 3;
    for (int seq = blockIdx.x * 2 + (wid >> 2); seq < 512; seq += gridDim.x * 2) {
        const int chain = seq >> 4, grp = seq & 15;
        const size_t item0 = (size_t)chain * 256 + grp * 16;
        bf16x8 pb[2], qb[2];
#pragma unroll
        for (int s2 = 0; s2 < 2; ++s2)
#pragma unroll
            for (int e = 0; e < 8; ++e) {
                const int kact = 32 * s2 + ((e < 4) ? (4 * fq + e) : (16 + 4 * fq + e - 4));
                pb[s2][e] = (kact == 16 * ng + fr) ? (short)0x3F80 : (short)0;
                qb[s2][e] = 0;
            }
        StepRegs ra, rb;
        sb_load(ra, PM + item0 * 4096, QM + ((item0 * 4 + ng) * 4) * 256, fr, fq, lane);
        sb_load(rb, PM + (item0 + 1) * 4096, QM + (((item0 + 1) * 4 + ng) * 4) * 256, fr, fq, lane);
#pragma unroll 1
        for (int c = 0; c < 16; c += 2) {
            f32x4 accP[4], accQ[4];
            {
                StepRegs z = ra;
#pragma unroll
                for (int m = 0; m < 4; ++m) z.qf[m] = make_uint2(0u, 0u);
                sb_apply(z, pb, accP); sb_apply(ra, qb, accQ);
                const size_t nx = item0 + ((c + 2 < 16) ? (c + 2) : c);
                sb_load(ra, PM + nx * 4096, QM + ((nx * 4 + ng) * 4) * 256, fr, fq, lane);
                sb_pack(accP, pb); sb_pack(accQ, qb);
            }
            {
                StepRegs z = rb;
#pragma unroll
                for (int m = 0; m < 4; ++m) z.qf[m] = make_uint2(0u, 0u);
                sb_apply(z, pb, accP); sb_apply(rb, qb, accQ);
                const size_t nx = item0 + ((c + 3 < 16) ? (c + 3) : (c + 1));
                sb_load(rb, PM + nx * 4096, QM + ((nx * 4 + ng) * 4) * 256, fr, fq, lane);
                if (c + 2 < 16) { sb_pack(accP, pb); sb_pack(accQ, qb); }
            }
            if (c + 2 >= 16) {
#pragma unroll
                for (int m = 0; m < 4; ++m) {
#pragma unroll
                    for (int j = 0; j < 4; ++j) PG[(size_t)seq * 4096 + (16 * m + 4 * fq + j) * 64 + kpos(16 * ng + fr)] = f2bf(accP[m][j]);
                    uint2 o; o.x = pack2(accQ[m][0], accQ[m][1]); o.y = pack2(accQ[m][2], accQ[m][3]);
                    *(uint2*)(QG + (((size_t)seq * 4 + ng) * 4 + m) * 256 + lane * 4) = o;
                }
            }
        }
    }
}

__device__ __forceinline__ void phase_scanB2(const PP p) {
    const int t = tid_opaque(), lane = t & 63, wid = t >> 6, fr = lane & 15, fq = lane >> 4;
    const u16* PM = (const u16*)(p.ws() + SC_PM); const u16* OM = (const u16*)(p.ws() + SC_OM);
    const u16* QM = (const u16*)(p.ws() + SC_QM); const u16* OL = (const u16*)(p.ws() + SC_OL);
    const u16* PG = (const u16*)(p.ws() + SC_PG); const u16* QG = (const u16*)(p.ws() + SC_QG);
    const int ng = wid & 3;
    for (int seq = blockIdx.x * 2 + (wid >> 2); seq < 512; seq += gridDim.x * 2) {
        const int chain = seq >> 4, grp = seq & 15;
        const int d = chain >> 4, b = (chain >> 3) & 1, h = chain & 7;
        float* O = (float*)(p.ws() + (d ? O_OB : O_OF));
        bf16x8 sb[2];
#pragma unroll
        for (int s2 = 0; s2 < 2; ++s2)
#pragma unroll
            for (int e = 0; e < 8; ++e) sb[s2][e] = 0;
#pragma unroll 1
        for (int g = 0; g < grp; ++g) {
            const size_t sq = (size_t)chain * 16 + g;
            StepRegs r; f32x4 acc[4];
            sb_load(r, PG + sq * 4096, QG + ((sq * 4 + ng) * 4) * 256, fr, fq, lane);
            sb_apply(r, sb, acc); sb_pack(acc, sb);
        }
        const size_t item0 = (size_t)chain * 256 + grp * 16;
        StepRegs sa, sa2, so;
        sb_load(sa, PM + item0 * 4096, QM + ((item0 * 4 + ng) * 4) * 256, fr, fq, lane);
        sb_load(so, OM + item0 * 4096, OL + ((item0 * 4 + ng) * 4) * 256, fr, fq, lane);
        sb_load(sa2, PM + (item0 + 1) * 4096, QM + (((item0 + 1) * 4 + ng) * 4) * 256, fr, fq, lane);
#pragma unroll 1
        for (int c = 0; c < 16; c += 2) {
#pragma unroll
            for (int u = 0; u < 2; ++u) {
                f32x4 accS[4], accO[4];
                StepRegs& ra = u ? sa2 : sa;
                sb_apply(so, sb, accO);
                {
                    const size_t nx = item0 + ((c + u + 1 < 16) ? (c + u + 1) : (c + u));
                    sb_load(so, OM + nx * 4096, OL + ((nx * 4 + ng) * 4) * 256, fr, fq, lane);
                }
                sb_apply(ra, sb, accS);
                {
                    const size_t nx = item0 + ((c + u + 2 < 16) ? (c + u + 2) : (c + u));
                    sb_load(ra, PM + nx * 4096, QM + ((nx * 4 + ng) * 4) * 256, fr, fq, lane);
                }
                const int cc = grp * 16 + c + u;
#pragma unroll
                for (int m = 0; m < 4; ++m)
#pragma unroll
                    for (int j = 0; j < 4; ++j) {
                        const int i = 16 * m + 4 * fq + j;
                        const int tt = d ? (L_ - 1 - (cc * 64 + i)) : (cc * 64 + i);
                        O[((size_t)b * L_ + tt) * 512 + h * 64 + 16 * ng + fr] = accO[m][j];
                    }
                sb_pack(accS, sb);
            }
        }
    }
}

__device__ __forceinline__ void phase_combine(const PP p, int i) {
    const int t = tid_opaque(); const int lane = t & 63, wid = t >> 6;
    const float* OF = (const float*)(p.ws() + O_OF); const float* OB = (const float*)(p.ws() + O_OB);
    const u16* R = (const u16*)(p.ws() + RW_R); const u16* V = (const u16*)(p.ws() + RW_V); const u16* KD = (const u16*)(p.ws() + RW_KD);
    const u16* G = (const u16*)(p.ws() + RW_G);
    const float* gngp = p.in(23) + (size_t)i * 512; const float* gnbp = p.in(24) + (size_t)i * 512; const float* rkp = p.in(22) + (size_t)i * 512;
    u16* mix = (u16*)(p.ws() + OFF_MIX);
    float gng[8], gnb[8], rk[8];
#pragma unroll
    for (int ii = 0; ii < 8; ++ii) { gng[ii] = gngp[lane + 64 * ii]; gnb[ii] = gnbp[lane + 64 * ii]; rk[ii] = rkp[lane + 64 * ii]; }
    const int tstride = gridDim.x * 8;
    int tok = blockIdx.x * 8 + wid;
    float of[8], ob[8]; u16 rr[8], k0[8], k1[8], vv[8], gg[8];
#define CB_LOAD(TK) { _Pragma("unroll") for (int ii = 0; ii < 8; ++ii) { const size_t g1 = (size_t)(TK) * 512 + lane + 64 * ii; \
        of[ii] = OF[g1]; ob[ii] = OB[g1]; rr[ii] = R[g1]; vv[ii] = V[g1]; gg[ii] = G[g1]; \
        k0[ii] = KD[((size_t)(TK) * 2) * 512 + lane + 64 * ii]; k1[ii] = KD[((size_t)(TK) * 2 + 1) * 512 + lane + 64 * ii]; } }
    if (tok < T_) CB_LOAD(tok)
#pragma unroll 1
    for (; tok < T_; tok += tstride) {
        float o[8], rf[8], ks[8], vf[8], gf[8];
#pragma unroll
        for (int ii = 0; ii < 8; ++ii) { o[ii] = of[ii] + ob[ii]; rf[ii] = bf2f(rr[ii]); ks[ii] = bf2f(k0[ii]) + bf2f(k1[ii]); vf[ii] = bf2f(vv[ii]); gf[ii] = bf2f(gg[ii]); }
        if (tok + tstride < T_) CB_LOAD(tok + tstride)
#pragma unroll
        for (int ii = 0; ii < 8; ++ii) {
            const int col = lane + 64 * ii;
            const float mean = wave_sum(o[ii]) * (1.0f / 64.0f);
            const float dv = o[ii] - mean;
            const float var = wave_sum(dv * dv) * (1.0f / 64.0f);
            const float nrm = dv * rsqrtf(var + 64e-5f) * gng[ii] + gnb[ii];
            const float bonus = wave_sum(rf[ii] * ks[ii] * rk[ii]);
            mix[(size_t)tok * 1024 + 512 + col] = f2bf((nrm + bonus * vf[ii]) * gf[ii]);
        }
    }
#undef CB_LOAD
}

struct EpiResid {
    u16* xo; const float* ada;
    __device__ __forceinline__ void operator()(const f32x4 (&acc)[2][2][4][2], const g8::Unit& u, int wr, int wc, int fr, int fq) const {
        const float* g1 = ada + (u.pm >> 6) * 6144 + 2048;
        float4 gv[2][2];
#pragma unroll
        for (int bj = 0; bj < 2; ++bj)
#pragma unroll
            for (int n = 0; n < 2; ++n) gv[bj][n] = *(const float4*)(g1 + u.pn * 256 + bj * 128 + wc * 32 + n * 16 + fq * 4);
#pragma unroll
        for (int ai = 0; ai < 2; ++ai) {
            uint2 xq[4][2][2];
#pragma unroll
            for (int m = 0; m < 4; ++m) {
                const size_t row = (size_t)u.pm * 256 + ai * 128 + wr * 64 + m * 16 + fr;
#pragma unroll
                for (int bj = 0; bj < 2; ++bj)
#pragma unroll
                    for (int n = 0; n < 2; ++n) xq[m][bj][n] = *(const uint2*)(xo + row * 1024 + u.pn * 256 + bj * 128 + wc * 32 + n * 16 + fq * 4);
            }
            __builtin_amdgcn_sched_barrier(0);
#pragma unroll
            for (int m = 0; m < 4; ++m) {
                const size_t row = (size_t)u.pm * 256 + ai * 128 + wr * 64 + m * 16 + fr;
#pragma unroll
                for (int bj = 0; bj < 2; ++bj)
#pragma unroll
                    for (int n = 0; n < 2; ++n) {
                        const int col = u.pn * 256 + bj * 128 + wc * 32 + n * 16 + fq * 4;
                        const f32x4 v = acc[ai][bj][m][n];
                        const float4 xv = up4(xq[m][bj][n]); const float4 g = gv[bj][n];
                        *(uint2*)(xo + row * 1024 + col) = make_uint2(pack2(ALPHA_F * xv.x + g.x * v[0], ALPHA_F * xv.y + g.y * v[1]), pack2(ALPHA_F * xv.z + g.z * v[2], ALPHA_F * xv.w + g.w * v[3]));
                    }
            }
        }
    }
};
__device__ __forceinline__ void phase_gout(const PP p, char* smem, const u16* A, const u16* B, int layer) {
    SchedGrid S; S.A = (const char*)A; S.B = (const char*)B; S.nunits = 128 * 4; S.npn = 4; S.astep = (size_t)256 * 1024 * 2; S.bstep = (size_t)256 * 1024 * 2;
    EpiResid E; E.xo = (u16*)p.out() + (size_t)T_ * 1024; E.ada = (const float*)(p.ws() + OFF_ADA) + (size_t)layer * 2 * 6144;
    g8::gemm<false, false>((G8_LAS unsigned char*)smem, 1024, 1024, 1024, nullptr, S, E);
}

__device__ __forceinline__ void phase_lna(const PP p, char* smem, int layer) {
    const int t = tid_opaque(), lane = t & 63, wid = t >> 6, fr = lane & 15, q = lane >> 4;
    u16* WH = (u16*)smem;
    u16* WL = WH + 32 * 1032;
    float* uv = (float*)(smem + 2 * 32 * 1032 * 2);
    float* part = uv + 64;
    int* cntl = (int*)(part + 16 * 64);
    float* prm = (float*)(cntl + 32);
    const float* ada = (const float*)(p.ws() + OFF_ADA) + (size_t)layer * 2 * 6144;
    const float* lng = p.in(4) + (size_t)(layer * 2) * 1024; const float* lnb = p.in(5) + (size_t)(layer * 2) * 1024;
    const u16* XB = (const u16*)p.out() + (size_t)T_ * 1024;
    u16* X1 = (u16*)(p.ws() + OFF_MIX);
    u16* hb = (u16*)(p.ws() + OFF_HBUF);
    int* toke = (int*)(p.ws() + OFF_TOKE); float* tokg = (float*)(p.ws() + OFF_TOKG); int* cnt = (int*)(p.ws() + OFF_CNT);
    int built_b = -1;
    for (int g = blockIdx.x; g < 256; g += gridDim.x) {
        const int b = g >> 7;
        const float* shp = ada + b * 6144 + 3072; const float* scp = ada + b * 6144 + 4096;
        __syncthreads();
        if (b != built_b) {
            built_b = b;
            {
                float gc[2], bc[2], s1[2], sh[2];
#pragma unroll
                for (int k = 0; k < 2; ++k) { const int c = t + 512 * k; gc[k] = lng[c]; bc[k] = lnb[c]; s1[k] = scp[c]; sh[k] = shp[c]; }
                __builtin_amdgcn_sched_barrier(0);
#pragma unroll
                for (int k = 0; k < 2; ++k) { const int c = t + 512 * k; const float m1 = 1.0f + s1[k]; prm[c] = gc[k]; prm[1024 + c] = bc[k]; prm[2048 + c] = gc[k] * m1; prm[3072 + c] = bc[k] * m1 + sh[k]; }
            }
            __syncthreads();
            const int e = t & 31;
            float su = 0.f, sv = 0.f;
#pragma unroll 1
            for (int k16 = 0; k16 < 4; ++k16) {
                float rwv[16];
#pragma unroll
                for (int j = 0; j < 16; ++j) rwv[j] = p.in(6)[t + 512 * (16 * k16 + j)];
                __builtin_amdgcn_sched_barrier(0);
#pragma unroll
                for (int j = 0; j < 16; ++j) {
                    const int idx = t + 512 * (16 * k16 + j), c = idx >> 5;
                    const float w = rwv[j] * prm[2048 + c];
                    const u16 hi = f2bf(w); const u16 lo = f2bf(w - bf2f(hi));
                    WH[e * 1032 + c] = hi; WL[e * 1032 + c] = lo;
                    su += w; sv += prm[3072 + c] * rwv[j];
                }
            }
            part[(t >> 5) * 64 + e] = su; part[(t >> 5) * 64 + 32 + e] = sv;
            __syncthreads();
            if (t < 64) { float s = 0.f; for (int k = 0; k < 16; ++k) s += part[k * 64 + t]; uv[t] = s + ((t >= 32) ? p.in(7)[t - 32] : 0.f); }
        }
        if (t < 32) cntl[t] = 0;
        __syncthreads();
        const int tok = g * 128 + wid * 16 + fr;
        const u16* xrow = XB + (size_t)tok * 1024 + 8 * q;
        f32x4 acc0 = f32x4{0.f, 0.f, 0.f, 0.f}, acc1 = f32x4{0.f, 0.f, 0.f, 0.f};
        float sm = 0.f, sq = 0.f;
        {
#pragma unroll 1
            for (int s8 = 0; s8 < 4; ++s8) {
                uint4 xs[8];
#pragma unroll
                for (int j = 0; j < 8; ++j) xs[j] = *(const uint4*)(xrow + 32 * (8 * s8 + j));
                __builtin_amdgcn_sched_barrier(0);
#pragma unroll
                for (int j = 0; j < 8; ++j) {
                    const int s = 8 * s8 + j;
                    const uint4 xu = xs[j];
                    union { uint4 u; bf16x8 v; } xa; xa.u = xu;
                    const float x0 = lo2f(xu.x), x1 = hi2f(xu.x), x2 = lo2f(xu.y), x3 = hi2f(xu.y), x4 = lo2f(xu.z), x5 = hi2f(xu.z), x6 = lo2f(xu.w), x7 = hi2f(xu.w);
                    sm += ((x0 + x1) + (x2 + x3)) + ((x4 + x5) + (x6 + x7));
                    sq += ((x0 * x0 + x1 * x1) + (x2 * x2 + x3 * x3)) + ((x4 * x4 + x5 * x5) + (x6 * x6 + x7 * x7));
                    const bf16x8 wh0 = *(const bf16x8*)(WH + fr * 1032 + 32 * s + 8 * q), wl0 = *(const bf16x8*)(WL + fr * 1032 + 32 * s + 8 * q);
                    const bf16x8 wh1 = *(const bf16x8*)(WH + (16 + fr) * 1032 + 32 * s + 8 * q), wl1 = *(const bf16x8*)(WL + (16 + fr) * 1032 + 32 * s + 8 * q);
                    acc0 = __builtin_amdgcn_mfma_f32_16x16x32_bf16(xa.v, wh0, acc0, 0, 0, 0); acc0 = __builtin_amdgcn_mfma_f32_16x16x32_bf16(xa.v, wl0, acc0, 0, 0, 0);
                    acc1 = __builtin_amdgcn_mfma_f32_16x16x32_bf16(xa.v, wh1, acc1, 0, 0, 0); acc1 = __builtin_amdgcn_mfma_f32_16x16x32_bf16(xa.v, wl1, acc1, 0, 0, 0);
                }
            }
        }
        sm += __shfl_xor(sm, 16); sm += __shfl_xor(sm, 32); sq += __shfl_xor(sq, 16); sq += __shfl_xor(sq, 32);
        const float mean = sm * (1.0f / 1024.0f);
        const float rstd = rsqrtf(fmaxf(sq * (1.0f / 1024.0f) - mean * mean, 0.f) + 1e-5f);
        {
            const float u0 = uv[fr], u1 = uv[16 + fr], v0 = uv[32 + fr], v1 = uv[48 + fr];
            float p0[4], p1[4];
#pragma unroll
            for (int j = 0; j < 4; ++j) {
                const float mj = __shfl(mean, 4 * q + j), rj = __shfl(rstd, 4 * q + j);
                const float l0 = rj * (acc0[j] - mj * u0) + v0, l1 = rj * (acc1[j] - mj * u1) + v1;
                float mx = fmaxf(l0, l1);
                mx = fmaxf(mx, __shfl_xor(mx, 1)); mx = fmaxf(mx, __shfl_xor(mx, 2)); mx = fmaxf(mx, __shfl_xor(mx, 4)); mx = fmaxf(mx, __shfl_xor(mx, 8));
                p0[j] = __expf(l0 - mx); p1[j] = __expf(l1 - mx);
            }
            const int qb = lane & ~3;
#pragma unroll
            for (int j = 0; j < 4; ++j) {
                int i1[2], i2[2]; float w1[2], w2[2];
#pragma unroll
                for (int nt = 0; nt < 2; ++nt) {
                    const float pv = nt ? p1[j] : p0[j];
                    const float q0 = __shfl(pv, qb), q1 = __shfl(pv, qb + 1), q2 = __shfl(pv, qb + 2), q3 = __shfl(pv, qb + 3);
                    int a1 = 0; float b1 = q0;
                    if (q1 > b1) { b1 = q1; a1 = 1; } if (q2 > b1) { b1 = q2; a1 = 2; } if (q3 > b1) { b1 = q3; a1 = 3; }
                    int a2 = -1; float b2 = -1.f;
                    if (a1 != 0 && q0 > b2) { b2 = q0; a2 = 0; } if (a1 != 1 && q1 > b2) { b2 = q1; a2 = 1; }
                    if (a1 != 2 && q2 > b2) { b2 = q2; a2 = 2; } if (a1 != 3 && q3 > b2) { b2 = q3; a2 = 3; }
                    i1[nt] = a1; i2[nt] = a2; w1[nt] = b1; w2[nt] = b2;
                }
                float score = w1[0] + w2[0]; int gsel = fr >> 2;
                { const float s1 = w1[1] + w2[1]; if (s1 > score) { score = s1; gsel = 4 + (fr >> 2); } }
#pragma unroll
                for (int o = 4; o <= 8; o <<= 1) {
                    const float os = __shfl_xor(score, o); const int og = __shfl_xor(gsel, o);
                    if (os > score || (os == score && og < gsel)) { score = os; gsel = og; }
                }
                const int src = 16 * q + (gsel & 3) * 4, hsel = gsel >> 2;
                const int si1 = hsel ? __shfl(i1[1], src) : __shfl(i1[0], src), si2 = hsel ? __shfl(i2[1], src) : __shfl(i2[0], src);
                const float sv1 = hsel ? __shfl(w1[1], src) : __shfl(w1[0], src), sv2 = hsel ? __shfl(w2[1], src) : __shfl(w2[0], src);
                if (fr == 0) {
                    const int tk = g * 128 + wid * 16 + 4 * q + j;
                    const int e1 = gsel * 4 + si1, e2 = gsel * 4 + si2;
                    const float den = 1.0f / (sv1 + sv2);
                    toke[tk * 2] = e1; toke[tk * 2 + 1] = e2;
                    tokg[tk * 2] = sv1 * den; tokg[tk * 2 + 1] = sv2 * den;
                    atomicAdd(&cntl[e1], 1); atomicAdd(&cntl[e2], 1);
                }
            }
        }
        {
            u16* x1row = X1 + (size_t)tok * 1024 + 8 * q; u16* hrow = hb + (size_t)tok * 1024 + 8 * q;
            const float mr = -mean * rstd;
#pragma unroll 1
            for (int s8 = 0; s8 < 4; ++s8) {
                uint4 xs[8];
#pragma unroll
                for (int j = 0; j < 8; ++j) xs[j] = *(const uint4*)(xrow + 32 * (8 * s8 + j));
                __builtin_amdgcn_sched_barrier(0);
#pragma unroll
                for (int j = 0; j < 8; ++j) {
                    const int s = 8 * s8 + j, c0 = 32 * s + 8 * q;
                    const uint4 xu = xs[j];
                    const float xv[8] = {lo2f(xu.x), hi2f(xu.x), lo2f(xu.y), hi2f(xu.y), lo2f(xu.z), hi2f(xu.z), lo2f(xu.w), hi2f(xu.w)};
                    const float4 g0 = *(const float4*)(prm + c0), g1 = *(const float4*)(prm + c0 + 4), b0 = *(const float4*)(prm + 1024 + c0), b1 = *(const float4*)(prm + 1024 + c0 + 4);
                    const float4 G0 = *(const float4*)(prm + 2048 + c0), G1 = *(const float4*)(prm + 2048 + c0 + 4), B0 = *(const float4*)(prm + 3072 + c0), B1 = *(const float4*)(prm + 3072 + c0 + 4);
                    const float gv[8] = {g0.x, g0.y, g0.z, g0.w, g1.x, g1.y, g1.z, g1.w}, bv[8] = {b0.x, b0.y, b0.z, b0.w, b1.x, b1.y, b1.z, b1.w};
                    const float Gv[8] = {G0.x, G0.y, G0.z, G0.w, G1.x, G1.y, G1.z, G1.w}, Bv[8] = {B0.x, B0.y, B0.z, B0.w, B1.x, B1.y, B1.z, B1.w};
                    float y[8], hh[8];
#pragma unroll
                    for (int e = 0; e < 8; ++e) { const float z = xv[e] * rstd + mr; y[e] = z * gv[e] + bv[e]; hh[e] = z * Gv[e] + Bv[e]; }
                    *(uint4*)(x1row + 32 * s) = make_uint4(pack2(y[0], y[1]), pack2(y[2], y[3]), pack2(y[4], y[5]), pack2(y[6], y[7]));
                    *(uint4*)(hrow + 32 * s) = make_uint4(pack2(hh[0], hh[1]), pack2(hh[2], hh[3]), pack2(hh[4], hh[5]), pack2(hh[6], hh[7]));
                }
            }
        }
        __syncthreads();
        if (t < 32) cnt[g * 32 + t] = cntl[t];
    }
}

__device__ __forceinline__ void phase_scatter(const PP p, char* smem) {
    const int t = tid_opaque();
    int* part = (int*)smem;
    int* tot = part + 512; int* pstart = tot + 32; int* tstart = pstart + 32; int* base = tstart + 33; int* cursor = base + 32;
    const int* cnt = (const int*)(p.ws() + OFF_CNT);
    const int* toke = (const int*)(p.ws() + OFF_TOKE);
    int* toks = (int*)(p.ws() + OFF_TOKS); int* sltk = (int*)(p.ws() + OFF_SLTK); int* meta = (int*)(p.ws() + OFF_META);
    __syncthreads();
    { const int e = t & 31, pt = t >> 5; int s = 0;
      int cv0[16];
#pragma unroll
      for (int g = 0; g < 16; ++g) cv0[g] = cnt[(pt * 16 + g) * 32 + e];
#pragma unroll
      for (int g = 0; g < 16; g += 4) asm volatile("" : "+v"(cv0[g]), "+v"(cv0[g + 1]), "+v"(cv0[g + 2]), "+v"(cv0[g + 3]));
#pragma unroll
      for (int g = 0; g < 16; ++g) s += cv0[g];
      part[pt * 32 + e] = s; }
    __syncthreads();
    if (t < 32) { int s = 0; for (int q = 0; q < 16; ++q) s += part[q * 32 + t]; tot[t] = s; }
    __syncthreads();
    if (t == 0) { int ps = 0, ts = 0; for (int e = 0; e < 32; ++e) { pstart[e] = ps; tstart[e] = ts; const int nt = (tot[e] + 255) >> 8; ps += nt * 256; ts += nt; } tstart[32] = ts; }
    __syncthreads();
    for (int g = blockIdx.x; g < 256; g += gridDim.x) {
        if (t < 32) {
            int bsum = pstart[t];
            for (int q = 0; q < (g >> 4); ++q) bsum += part[q * 32 + t];
            int cv[15];
#pragma unroll
            for (int q = 0; q < 15; ++q) { const int gq = (g & ~15) + q; cv[q] = (gq < g) ? cnt[gq * 32 + t] : 0; }
#pragma unroll
            for (int q = 0; q < 15; ++q) bsum += cv[q];
            base[t] = bsum; cursor[t] = 0;
        }
        __syncthreads();
        if (t < 256) {
            const int tok = g * 128 + (t >> 1);
            const int e = toke[tok * 2 + (t & 1)];
            const int pos = atomicAdd(&cursor[e], 1);
            const int slot = base[e] + pos;
            sltk[slot] = tok; toks[tok * 2 + (t & 1)] = slot;
        }
        __syncthreads();
        if (g == 0) {
            if (t < 32) { meta[t] = tot[t]; meta[32 + t] = pstart[t]; }
            if (t < 33) meta[64 + t] = tstart[t];
            if (t < 32) { const int e0 = pstart[t] + tot[t], e1 = pstart[t] + (((tot[t] + 255) >> 8) << 8); int z_ = 0; asm volatile("" : "+v"(z_)); for (int s = e0; s < e1; ++s) sltk[s] = z_; }
        }
    }
}

constexpr int HLD = 768;
struct SchedMoe {
    const int* lm; const char* A; const char* B; int nct; size_t bexp, bct, astep; int ntot; int layer;
    __device__ __forceinline__ bool operator()(int i, g8::Unit& u) const {
        int id; if (!xcd_deal(i, ntot, id)) return false;
        const int rt = id / nct, ct = id - rt * nct;
        const int ln_ = (int)(threadIdx.x & 63u);
        const int e = __popcll(__ballot(ln_ >= 1 && ln_ < 32 && lm[64 + (ln_ & 31)] <= rt));
        const int slot0 = lm[32 + e] + (rt - lm[64 + e]) * 256;
        u.pm = rt; u.pn = ct; u.aux = slot0;
        u.a = A + (size_t)slot0 * astep;
        u.b = B + (size_t)(layer * 32 + e) * bexp + (size_t)ct * bct;
        return true;
    }
};
struct EpiSwiGLU {
    u16* H;
    __device__ __forceinline__ void operator()(const f32x4 (&acc)[2][2][4][2], const g8::Unit& u, int wr, int wc, int fr, int fq) const {
#pragma unroll
        for (int ai = 0; ai < 2; ++ai)
#pragma unroll
            for (int m = 0; m < 4; ++m) {
                const size_t row = (size_t)u.aux + ai * 128 + wr * 64 + m * 16 + fr;
                unsigned w[4];
#pragma unroll
                for (int n = 0; n < 2; ++n) {
                    float hv[4];
#pragma unroll
                    for (int j = 0; j < 4; ++j) { const float gv = acc[ai][0][m][n][j], uv = acc[ai][1][m][n][j]; hv[j] = gv * __builtin_amdgcn_rcpf(1.0f + __expf(-gv)) * uv; }
                    w[2 * n] = pack2(hv[0], hv[1]); w[2 * n + 1] = pack2(hv[2], hv[3]);
                }
                *(uint4*)(H + row * HLD + u.pn * 128 + wc * 32 + fq * 8) = make_uint4(w[0], w[1], w[2], w[3]);
                __builtin_amdgcn_sched_barrier(0);
            }
    }
};
__device__ __forceinline__ void phase_moe1(const PP p, char* smem, int layer) {
    int* lm = (int*)(smem + 132096);
    const int* meta = (const int*)(p.ws() + OFF_META);
    __syncthreads();
    { const int t_ = tid_opaque(); if (t_ < 97) lm[t_] = meta[t_]; }
    __syncthreads();
    SchedMoe S; S.lm = lm; S.A = p.ws() + OFF_HBUF; S.B = p.ws() + OFF_WGU; S.nct = 6; S.bexp = (size_t)1536 * 1024 * 2; S.bct = (size_t)256 * 1024 * 2; S.astep = 0;
    S.ntot = lm[64 + 32] * 6; S.layer = layer;
    EpiSwiGLU E; E.H = (u16*)(p.ws() + MOE_H);
    g8::gemm<true, true>((G8_LAS unsigned char*)smem, 1024, 1024, 1024, (const int*)(p.ws() + OFF_SLTK), S, E);
}

struct EpiBf16Slots {
    u16* Y;
    __device__ __forceinline__ void operator()(const f32x4 (&acc)[2][2][4][2], const g8::Unit& u, int wr, int wc, int fr, int fq) const {
#pragma unroll
        for (int ai = 0; ai < 2; ++ai)
#pragma unroll
            for (int m = 0; m < 4; ++m) {
                const size_t row = (size_t)u.aux + ai * 128 + wr * 64 + m * 16 + fr;
#pragma unroll
                for (int bj = 0; bj < 2; ++bj) {
                    const f32x4 v0 = acc[ai][bj][m][0], v1 = acc[ai][bj][m][1];
                    *(uint4*)(Y + row * 1024 + u.pn * 256 + bj * 128 + wc * 32 + fq * 8) = make_uint4(pack2(v0[0], v0[1]), pack2(v0[2], v0[3]), pack2(v1[0], v1[1]), pack2(v1[2], v1[3]));
                }
            }
    }
};
__device__ __forceinline__ void phase_moe2(const PP p, char* smem, int layer) {
    int* lm = (int*)(smem + 132096);
    const int* meta = (const int*)(p.ws() + OFF_META);
    __syncthreads();
    { const int t_ = tid_opaque(); if (t_ < 97) lm[t_] = meta[t_]; }
    __syncthreads();
    SchedMoe S; S.lm = lm; S.A = p.ws() + MOE_H; S.B = p.ws() + OFF_WD; S.nct = 4; S.bexp = (size_t)1024 * FF * 2; S.bct = (size_t)256 * FF * 2; S.astep = (size_t)HLD * 2;
    S.ntot = lm[64 + 32] * 4; S.layer = layer;
    EpiBf16Slots E; E.Y = (u16*)(p.ws() + MOE_Y);
    g8::gemm<true, false>((G8_LAS unsigned char*)smem, 768, HLD, FF, nullptr, S, E);
}

__device__ __forceinline__ void phase_lnb(const PP p, int layer) {
    const int t = tid_opaque(); const int lane = t & 63, wid = t >> 6;
    const float* ada = (const float*)(p.ws() + OFF_ADA) + (size_t)layer * 2 * 6144;
    const float* adan = (const float*)(p.ws() + OFF_ADA) + (size_t)(layer + 1) * 2 * 6144;
    const float* lng = p.in(4) + (size_t)(layer * 2 + 1) * 1024; const float* lnb = p.in(5) + (size_t)(layer * 2 + 1) * 1024;
    const u16* Y = (const u16*)(p.ws() + MOE_Y);
    const int* toks = (const int*)(p.ws() + OFF_TOKS); const float* tokg = (const float*)(p.ws() + OFF_TOKG);
    u16* hb = (u16*)(p.ws() + OFF_HBUF);
    const u16* X1 = (const u16*)(p.ws() + OFF_MIX);
    const int tstride = gridDim.x * 8;
    int tok = blockIdx.x * 8 + wid;
    int ns0 = 0, ns1 = 0; float ng0 = 0.f, ng1 = 0.f;
    float4 nx[4]; uint2 nya[4], nyb[4];
    float cg0 = 0.f, cg1 = 0.f;
    float4 pg[4], pb[4], pG2[4], pB2[4], pga[4]; int cur_b = -1;
#pragma unroll
    for (int q4 = 0; q4 < 4; ++q4) { pg[q4] = *(const float4*)(lng + 4 * lane + 256 * q4); pb[q4] = *(const float4*)(lnb + 4 * lane + 256 * q4); pG2[q4] = pg[q4]; pB2[q4] = pb[q4]; pga[q4] = pg[q4]; }
    if (tok < T_) {
        const int s0 = toks[tok * 2], s1 = toks[tok * 2 + 1]; cg0 = tokg[tok * 2]; cg1 = tokg[tok * 2 + 1];
#pragma unroll
        for (int q4 = 0; q4 < 4; ++q4) {
            const int c0 = 4 * lane + 256 * q4;
            nx[q4] = up4(*(const uint2*)(X1 + (size_t)tok * 1024 + c0));
            nya[q4] = *(const uint2*)(Y + (size_t)s0 * 1024 + c0); nyb[q4] = *(const uint2*)(Y + (size_t)s1 * 1024 + c0);
        }
        if (tok + tstride < T_) { ns0 = toks[(tok + tstride) * 2]; ns1 = toks[(tok + tstride) * 2 + 1]; ng0 = tokg[(tok + tstride) * 2]; ng1 = tokg[(tok + tstride) * 2 + 1]; }
    }
#pragma unroll 1
    for (; tok < T_; tok += tstride) {
        const int b = tok >> 14;
        if (b != cur_b) {
            cur_b = b;
#pragma unroll
            for (int q4 = 0; q4 < 4; ++q4) {
                const int c0 = 4 * lane + 256 * q4;
                pga[q4] = *(const float4*)(ada + b * 6144 + 5120 + c0);
                if (layer < 3) {
                    const float4 sh = *(const float4*)(adan + b * 6144 + c0), sc = *(const float4*)(adan + b * 6144 + 1024 + c0);
                    pG2[q4] = make_float4(pg[q4].x * (1.f + sc.x), pg[q4].y * (1.f + sc.y), pg[q4].z * (1.f + sc.z), pg[q4].w * (1.f + sc.w));
                    pB2[q4] = make_float4(pb[q4].x * (1.f + sc.x) + sh.x, pb[q4].y * (1.f + sc.y) + sh.y, pb[q4].z * (1.f + sc.z) + sh.z, pb[q4].w * (1.f + sc.w) + sh.w);
                }
            }
        }
        const float g0 = cg0, g1 = cg1;
        float* xr = p.out() + (size_t)tok * 1024;
        u16* xbr = (u16*)p.out() + (size_t)T_ * 1024 + (size_t)tok * 1024;
        float v[16];
#pragma unroll
        for (int q4 = 0; q4 < 4; ++q4) {
            const int c0 = 4 * lane + 256 * q4;
            const float4 x = nx[q4];
            const uint2 ya = nya[q4], yb = nyb[q4];
            const float4 gg = pga[q4];
            v[q4 * 4 + 0] = ALPHA_F * x.x + gg.x * (g0 * lo2f(ya.x) + g1 * lo2f(yb.x));
            v[q4 * 4 + 1] = ALPHA_F * x.y + gg.y * (g0 * hi2f(ya.x) + g1 * hi2f(yb.x));
            v[q4 * 4 + 2] = ALPHA_F * x.z + gg.z * (g0 * lo2f(ya.y) + g1 * lo2f(yb.y));
            v[q4 * 4 + 3] = ALPHA_F * x.w + gg.w * (g0 * hi2f(ya.y) + g1 * hi2f(yb.y));
        }
        {
            const int tn = tok + tstride;
            if (tn < T_) {
                cg0 = ng0; cg1 = ng1;
#pragma unroll
                for (int q4 = 0; q4 < 4; ++q4) {
                    const int c0 = 4 * lane + 256 * q4;
                    nx[q4] = up4(*(const uint2*)(X1 + (size_t)tn * 1024 + c0));
                    nya[q4] = *(const uint2*)(Y + (size_t)ns0 * 1024 + c0); nyb[q4] = *(const uint2*)(Y + (size_t)ns1 * 1024 + c0);
                }
                const int t2 = tn + tstride;
                if (t2 < T_) { ns0 = toks[t2 * 2]; ns1 = toks[t2 * 2 + 1]; ng0 = tokg[t2 * 2]; ng1 = tokg[t2 * 2 + 1]; }
            }
        }
        float sm = 0.f;
#pragma unroll
        for (int e = 0; e < 16; ++e) sm += v[e];
        const float mean = wave_sum(sm) * (1.0f / 1024.0f);
        float sq = 0.f;
#pragma unroll
        for (int e = 0; e < 16; ++e) { v[e] -= mean; sq += v[e] * v[e]; }
        const float rstd = rsqrtf(wave_sum(sq) * (1.0f / 1024.0f) + 1e-5f);
#pragma unroll
        for (int q4 = 0; q4 < 4; ++q4) {
            const int c0 = 4 * lane + 256 * q4;
            const float4 gg = pg[q4], bb = pb[q4];
            const float z0 = v[q4 * 4 + 0] * rstd, z1 = v[q4 * 4 + 1] * rstd, z2 = v[q4 * 4 + 2] * rstd, z3 = v[q4 * 4 + 3] * rstd;
            float4 y;
            y.x = z0 * gg.x + bb.x; y.y = z1 * gg.y + bb.y; y.z = z2 * gg.z + bb.z; y.w = z3 * gg.w + bb.w;
            if (layer == 3) *(float4*)(xr + c0) = y;
            if (layer < 3) {
                *(uint2*)(xbr + c0) = make_uint2(pack2(y.x, y.y), pack2(y.z, y.w));
                const float4 G2 = pG2[q4], B2 = pB2[q4];
                uint2 o; o.x = pack2(z0 * G2.x + B2.x, z1 * G2.y + B2.y); o.y = pack2(z2 * G2.z + B2.z, z3 * G2.w + B2.w);
                *(uint2*)(hb + (size_t)tok * 1024 + c0) = o;
            }
        }
    }
}

__device__ __forceinline__ void phase_hdn(const PP p, int i) {
    const int t = tid_opaque(); const int lane = t & 63, wid = t >> 6;
    const float* w1 = p.in(28) + (size_t)i * 33 * 64; const float* w2 = p.in(30) + (size_t)i * 4096; const float* w3 = p.in(32) + (size_t)i * 4096;
    const float b1 = p.in(29)[i * 64 + lane], b2 = p.in(31)[i * 64 + lane], b3 = p.in(33)[i * 64 + lane], frq = p.in(34)[i * 64 + lane];
    float W1c[33], W2c[64], W3c[64];
#pragma unroll
    for (int q = 0; q < 33; ++q) W1c[q] = w1[q * 64 + lane];
#pragma unroll
    for (int q = 0; q < 64; ++q) { W2c[q] = w2[q * 64 + lane]; W3c[q] = w3[q * 64 + lane]; }
    u16* hdn = (u16*)(p.ws() + OFF_HDN) + (size_t)i * L_ * 64;
    const float two_pi_over_L = (float)(6.283185307179586 / 16384.0);
    for (int l = blockIdx.x * 8 + wid; l < L_; l += gridDim.x * 8) {
        float zv = 0.f;
        if (lane == 0) zv = (float)l / (float)(L_ - 1);
        else if (lane <= 32) {
            const int bnd = (lane - 1) & 15;
            const float fb = 1e-4f + (float)bnd * ((15.0f - 1e-4f) / 15.0f);
            const float ang = (two_pi_over_L * (float)l) * fb;
            zv = (lane <= 16) ? cosf(ang) : -sinf(ang);
        }
        float pre = b1;
#pragma unroll
        for (int q = 0; q < 33; ++q) pre += __int_as_float(__builtin_amdgcn_readlane(__float_as_int(zv), q)) * W1c[q];
        float hcur = sinf(frq * pre);
        pre = b2;
#pragma unroll
        for (int q = 0; q < 64; ++q) pre += __int_as_float(__builtin_amdgcn_readlane(__float_as_int(hcur), q)) * W2c[q];
        hcur = sinf(frq * pre);
        pre = b3;
#pragma unroll
        for (int q = 0; q < 64; ++q) pre += __int_as_float(__builtin_amdgcn_readlane(__float_as_int(hcur), q)) * W3c[q];
        hcur = sinf(frq * pre);
        hdn[(size_t)l * 64 + lane] = f2bf(hcur);
    }
}

struct EpiUT {
    u16* UT;
    __device__ __forceinline__ void operator()(const f32x4 (&acc)[2][2][4][2], const g8::Unit& u, int wr, int wc, int fr, int fq) const {
#pragma unroll
        for (int ai = 0; ai < 2; ++ai)
#pragma unroll
            for (int m = 0; m < 4; ++m) {
                const int ch = u.pm * 256 + ai * 128 + wr * 64 + m * 16 + fr;
#pragma unroll
                for (int bj = 0; bj < 2; ++bj) {
                    const int tk = u.pn * 256 + bj * 128 + wc * 32 + fq * 8;
                    const int b = tk >> 14, t0 = tk & (L_ - 1);
                    const f32x4 v0 = acc[ai][bj][m][0], v1 = acc[ai][bj][m][1];
                    *(uint4*)(UT + ((size_t)(b * 3072 + ch)) * L_ + t0) = make_uint4(pack2(v0[0], v0[1]), pack2(v0[2], v0[3]), pack2(v1[0], v1[1]), pack2(v1[2], v1[3]));
                }
            }
    }
};
__device__ __forceinline__ void phase_g3(const PP p, char* smem, int i) {
    SchedGrid S; S.A = p.ws() + OFF_WINH + (size_t)i * 3072 * 1024 * 2; S.B = p.ws() + OFF_HBUF; S.nunits = 12 * 128; S.npn = 128;
    S.astep = (size_t)256 * 1024 * 2; S.bstep = (size_t)256 * 1024 * 2;
    EpiUT E; E.UT = (u16*)(p.ws() + HY_UT);
    g8::gemm<true, false>((G8_LAS unsigned char*)smem, 1024, 1024, 1024, nullptr, S, E);
}

__device__ __forceinline__ void phase_taps(const PP p, char* smem, int i) {
    const u16* A = (const u16*)(p.ws() + OFF_W4T) + (size_t)i * 4096 * 64;
    const u16* B = (const u16*)(p.ws() + OFF_HDN) + (size_t)i * L_ * 64;
    float* taps = (float*)(p.ws() + HY_TAPS);
    auto dec = [&](int id) __attribute__((always_inline)) { SKTile tl; tl.A = A + (size_t)(id >> 7) * 256 * 64; tl.lda = 64; tl.B = B + (size_t)(id & 127) * 128 * 64; tl.ldb = 64; tl.nk = 1; return tl; };
    auto epi = [&](int id, f32x4 (&acc)[4][4]) __attribute__((always_inline)) {
        const int tm = id >> 7, tn = id & 127;
        EPI_LOOP( const int row = tm * 256 + r, col = tn * 128 + c; const int ch = row & 1023;
                  const float ad = 3.070113457325394f + (float)ch * (12.280453829301576f / 1023.0f);
                  const float tl = (float)col * (1.0f / (float)(L_ - 1));
                  const float tv = v * __expf(-tl * ad);
                  if (row & 1024) { taps[(size_t)row * L_ + ((L_ - col) & (L_ - 1))] = (col == 0) ? 0.f : tv; } else taps[(size_t)row * L_ + col] = tv; )
    };
    gemm_smallk_loop<false>((u16*)smem, 16 * 128, dec, epi);
}

__device__ __forceinline__ float2 cmul(float2 a, float2 b) { return make_float2(a.x * b.x - a.y * b.y, a.x * b.y + a.y * b.x); }
__device__ __forceinline__ void fft_fwd(float2* X) {
    const int t = threadIdx.x;
#pragma unroll 1
    for (int s = 0; s < 7; ++s) {
        const int lq = 12 - 2 * s, q = 1 << lq;
        const float invM = 1.0f / (float)(q << 2);
        __syncthreads();
        const bool shared_tw = (lq <= 9);
        float2 w1c = make_float2(1.f, 0.f), w2c = w1c, w3c = w1c;
        if (shared_tw) { const float rv = (float)(t & (q - 1)) * invM; w1c = make_float2(__builtin_amdgcn_cosf(rv), -__builtin_amdgcn_sinf(rv)); w2c = cmul(w1c, w1c); w3c = cmul(w2c, w1c); }
#pragma unroll 1
        for (int hb = 0; hb < 4; ++hb) {
            float2 a[2][4]; int bs[2];
#pragma unroll
            for (int u = 0; u < 2; ++u) {
                const int g = t + 512 * (hb * 2 + u), blk = g >> lq, j = g & (q - 1);
                bs[u] = (blk << (lq + 2)) + j;
                a[u][0] = X[bs[u]]; a[u][1] = X[bs[u] + q]; a[u][2] = X[bs[u] + 2 * q]; a[u][3] = X[bs[u] + 3 * q];
            }
#pragma unroll
            for (int u = 0; u < 2; ++u) {
                float2 w1 = w1c, w2 = w2c, w3 = w3c;
                if (!shared_tw) {
                    const int j = bs[u] & (q - 1);
                    const float rev = (float)j * invM;
                    w1 = make_float2(__builtin_amdgcn_cosf(rev), -__builtin_amdgcn_sinf(rev));
                    w2 = cmul(w1, w1); w3 = cmul(w2, w1);
                }
                const float2 a0 = a[u][0], a1 = a[u][1], a2 = a[u][2], a3 = a[u][3];
                const float2 b0 = make_float2(a0.x + a2.x, a0.y + a2.y), b1 = make_float2(a0.x - a2.x, a0.y - a2.y);
                const float2 b2 = make_float2(a1.x + a3.x, a1.y + a3.y), b3 = make_float2(a1.x - a3.x, a1.y - a3.y);
                const float2 y0 = make_float2(b0.x + b2.x, b0.y + b2.y), y2 = make_float2(b0.x - b2.x, b0.y - b2.y);
                const float2 y1 = make_float2(b1.x + b3.y, b1.y - b3.x), y3 = make_float2(b1.x - b3.y, b1.y + b3.x);
                X[bs[u]] = y0; X[bs[u] + q] = cmul(y1, w1); X[bs[u] + 2 * q] = cmul(y2, w2); X[bs[u] + 3 * q] = cmul(y3, w3);
                __builtin_amdgcn_sched_barrier(0);
            }
        }
    }
    __syncthreads();
}
__device__ __forceinline__ void fft_inv(float2* X) {
    const int t = threadIdx.x;
#pragma unroll 1
    for (int s = 6; s >= 0; --s) {
        const int lq = 12 - 2 * s, q = 1 << lq;
        const float invM = 1.0f / (float)(q << 2);
        __syncthreads();
        const bool shared_tw = (lq <= 9);
        float2 w1c = make_float2(1.f, 0.f), w2c = w1c, w3c = w1c;
        if (shared_tw) { const float rv = (float)(t & (q - 1)) * invM; w1c = make_float2(__builtin_amdgcn_cosf(rv), __builtin_amdgcn_sinf(rv)); w2c = cmul(w1c, w1c); w3c = cmul(w2c, w1c); }
#pragma unroll 1
        for (int hb = 0; hb < 4; ++hb) {
            float2 a[2][4]; int bs[2];
#pragma unroll
            for (int u = 0; u < 2; ++u) {
                const int g = t + 512 * (hb * 2 + u), blk = g >> lq, j = g & (q - 1);
                bs[u] = (blk << (lq + 2)) + j;
                a[u][0] = X[bs[u]]; a[u][1] = X[bs[u] + q]; a[u][2] = X[bs[u] + 2 * q]; a[u][3] = X[bs[u] + 3 * q];
            }
#pragma unroll
            for (int u = 0; u < 2; ++u) {
                float2 w1 = w1c, w2 = w2c, w3 = w3c;
                if (!shared_tw) {
                    const int j = bs[u] & (q - 1);
                    const float rev = (float)j * invM;
                    w1 = make_float2(__builtin_amdgcn_cosf(rev), __builtin_amdgcn_sinf(rev));
                    w2 = cmul(w1, w1); w3 = cmul(w2, w1);
                }
                const float2 c0 = a[u][0], c1 = cmul(a[u][1], w1), c2 = cmul(a[u][2], w2), c3 = cmul(a[u][3], w3);
                const float2 e0 = make_float2(c0.x + c2.x, c0.y + c2.y), e1 = make_float2(c0.x - c2.x, c0.y - c2.y);
                const float2 e2 = make_float2(c1.x + c3.x, c1.y + c3.y), e3 = make_float2(c1.x - c3.x, c1.y - c3.y);
                X[bs[u]] = make_float2(e0.x + e2.x, e0.y + e2.y);
                X[bs[u] + q] = make_float2(e1.x - e3.y, e1.y + e3.x);
                X[bs[u] + 2 * q] = make_float2(e0.x - e2.x, e0.y - e2.y);
                X[bs[u] + 3 * q] = make_float2(e1.x + e3.y, e1.y - e3.x);
                __builtin_amdgcn_sched_barrier(0);
            }
        }
    }
    __syncthreads();
}
__device__ __forceinline__ void cv8(const uint4 u, const u16 pv, const u16 nv, int n0, float w0, float w1, float w2, float cb, float (&out)[8]) {
    float v[10];
    v[0] = (n0 > 0) ? bf2f(pv) : 0.f;
    v[1] = lo2f(u.x); v[2] = hi2f(u.x); v[3] = lo2f(u.y); v[4] = hi2f(u.y); v[5] = lo2f(u.z); v[6] = hi2f(u.z); v[7] = lo2f(u.w); v[8] = hi2f(u.w);
    v[9] = (n0 + 8 < L_) ? bf2f(nv) : 0.f;
#pragma unroll
    for (int e = 0; e < 8; ++e) out[e] = w0 * v[e] + w1 * v[e + 1] + w2 * v[e + 2] + cb;
}

constexpr int HLD2 = 136;
__device__ __forceinline__ bf16x8 neg8(bf16x8 v) { union { bf16x8 v; unsigned u[4]; } c; c.v = v; c.u[0] ^= 0x80008000u; c.u[1] ^= 0x80008000u; c.u[2] ^= 0x80008000u; c.u[3] ^= 0x80008000u; return c.v; }
template <int MODE>
__device__ __forceinline__ void cmm128(const u16* A0, const u16* A1, const u16* B0, const u16* B1, int wid, int fr, int fq, f32x4 (&accr)[8], f32x4 (&acci)[8]) {
#pragma unroll
    for (int nt = 0; nt < 8; ++nt) { accr[nt] = f32x4{0.f, 0.f, 0.f, 0.f}; acci[nt] = f32x4{0.f, 0.f, 0.f, 0.f}; }
    const u16* a0p = A0 + (16 * wid + fr) * HLD2 + 8 * fq; const u16* a1p = A1 + (16 * wid + fr) * HLD2 + 8 * fq;
    const u16* b0p = B0 + fr * HLD2 + 8 * fq; const u16* b1p = B1 + fr * HLD2 + 8 * fq;
    bf16x8 a0 = *(const bf16x8*)a0p, a1 = *(const bf16x8*)a1p;
    bf16x8 b0 = *(const bf16x8*)b0p, b1 = *(const bf16x8*)b1p;
#pragma unroll 1
    for (int s = 0; s < 4; ++s) {
        const bf16x8 na = neg8(MODE == 1 ? a0 : a1);
        bf16x8 a0n = a0, a1n = a1;
#pragma unroll
        for (int nt = 0; nt < 8; ++nt) {
            bf16x8 b0n, b1n;
            if (nt < 7) { b0n = *(const bf16x8*)(b0p + (nt + 1) * 16 * HLD2 + 32 * s); b1n = *(const bf16x8*)(b1p + (nt + 1) * 16 * HLD2 + 32 * s); }
            else        { b0n = *(const bf16x8*)(b0p + 32 * (s + 1)); b1n = *(const bf16x8*)(b1p + 32 * (s + 1)); }
            if (nt == 3) { a0n = *(const bf16x8*)(a0p + 32 * (s + 1)); a1n = *(const bf16x8*)(a1p + 32 * (s + 1)); }
            __builtin_amdgcn_sched_barrier(0);
            accr[nt] = __builtin_amdgcn_mfma_f32_16x16x32_bf16(a0, b0, accr[nt], 0, 0, 0);
            acci[nt] = __builtin_amdgcn_mfma_f32_16x16x32_bf16(MODE == 1 ? na : a0, b1, acci[nt], 0, 0, 0);
            accr[nt] = __builtin_amdgcn_mfma_f32_16x16x32_bf16(MODE == 0 ? na : a1, b1, accr[nt], 0, 0, 0);
            acci[nt] = __builtin_amdgcn_mfma_f32_16x16x32_bf16(MODE == 2 ? na : a1, b0, acci[nt], 0, 0, 0);
            __builtin_amdgcn_sched_barrier(0);
            b0 = b0n; b1 = b1n;
        }
        a0 = a0n; a1 = a1n;
    }
}
template <int TW>
__device__ __forceinline__ void store_T128(const f32x4 (&accr)[8], const f32x4 (&acci)[8], u16* PR, u16* PI, int wid, int fr, int fq) {
    const int R0 = 16 * wid + 4 * fq;
#pragma unroll
    for (int nt = 0; nt < 8; ++nt) {
        const int col = 16 * nt + fr;
        float re[4], im[4];
#pragma unroll
        for (int j = 0; j < 4; ++j) {
            const float xr = accr[nt][j], xi = acci[nt][j];
            if (TW == 0) { re[j] = xr; im[j] = xi; }
            else {
                const float rev = (float)((R0 + j) * col) * (1.0f / 16384.0f);
                const float cs = __builtin_amdgcn_cosf(rev), sn = __builtin_amdgcn_sinf(rev);
                if (TW == 1) { re[j] = xr * cs + xi * sn; im[j] = xi * cs - xr * sn; }
                else         { re[j] = xr * cs - xi * sn; im[j] = xi * cs + xr * sn; }
            }
        }
        *(uint2*)(PR + col * HLD2 + R0) = make_uint2(pack2(re[0], re[1]), pack2(re[2], re[3]));
        *(uint2*)(PI + col * HLD2 + R0) = make_uint2(pack2(im[0], im[1]), pack2(im[2], im[3]));
        __builtin_amdgcn_sched_barrier(0);
    }
}
__device__ __forceinline__ void fft128_fwd(const u16* FC, const u16* FS, u16* DR, u16* DI, int wid, int fr, int fq, f32x4 (&accr)[8], f32x4 (&acci)[8]) {
    __syncthreads();
    cmm128<1>(DR, DI, FC, FS, wid, fr, fq, accr, acci);
    __syncthreads();
    store_T128<1>(accr, acci, DR, DI, wid, fr, fq);
    __syncthreads();
    cmm128<2>(FC, FS, DR, DI, wid, fr, fq, accr, acci);
}
__device__ __forceinline__ void fft128_inv(const u16* FC, const u16* FS, u16* DR, u16* DI, int wid, int fr, int fq, f32x4 (&accr)[8], f32x4 (&acci)[8]) {
    __syncthreads();
    store_T128<0>(accr, acci, DR, DI, wid, fr, fq);
    __syncthreads();
    cmm128<0>(DR, DI, FC, FS, wid, fr, fq, accr, acci);
    __syncthreads();
    store_T128<2>(accr, acci, DR, DI, wid, fr, fq);
    __syncthreads();
    cmm128<0>(FC, FS, DR, DI, wid, fr, fq, accr, acci);
}

__device__ __forceinline__ void phase_hyena(const PP p, char* smem, int i) {
    const int t_outer = tid_opaque();
    int t = t_outer; int lane = t & 63, wid = t >> 6, fr = lane & 15, fq = lane >> 4;
    u16* FC = (u16*)smem; u16* FS = FC + 128 * HLD2; u16* DR = FS + 128 * HLD2; u16* DI = DR + 128 * HLD2;
    unsigned* TT = (unsigned*)DR;
    float* red = (float*)(smem + 4 * 128 * HLD2 * 2);
    const float* taps = (const float*)(p.ws() + HY_TAPS);
    const u16* UT = (const u16*)(p.ws() + HY_UT);
    u16* Y2T = (u16*)(p.ws() + HY_Y2T);
    unsigned* zT = (unsigned*)(p.ws() + HY_Y1) + (size_t)blockIdx.x * 65536;
    float4* AS = (float4*)(p.ws() + HY_SPEC) + (size_t)blockIdx.x * 8192;
    const float* cw = p.in(26) + (size_t)i * 3 * 3072; const float* cbp = p.in(27) + (size_t)i * 3072;
    const float invN = 1.0f / 32768.0f;
    __syncthreads();
    for (int e = t; e < 128 * 128; e += NTHR) {
        const int u = e >> 7, v = e & 127;
        const float rev = (float)((u * v) & 127) * (1.0f / 128.0f);
        FC[u * HLD2 + v] = f2bf(__builtin_amdgcn_cosf(rev)); FS[u * HLD2 + v] = f2bf(__builtin_amdgcn_sinf(rev));
    }
#pragma unroll 1
    for (int c = blockIdx.x; c < 1024; c += gridDim.x) {
#pragma unroll 1
        for (int arr = 0; arr < 3; ++arr) {
            const int ch = (arr == 0) ? (2048 + c) : ((arr == 1) ? c : (1024 + c));
            const float w0 = cw[ch], w1 = cw[3072 + ch], w2 = cw[6144 + ch], wb = cbp[ch];
            const u16* u0 = UT + (size_t)(0 * 3072 + ch) * L_; const u16* u1 = UT + (size_t)(1 * 3072 + ch) * L_;
            __syncthreads();
            {
                uint4 ua[4], ub[4]; unsigned pa[4], na[4], pb2[4], nb2[4];
#pragma unroll
                for (int g4 = 0; g4 < 4; ++g4) {
                    const int n0 = 8 * (t + 512 * g4), np = max(n0 - 1, 0), nn = min(n0 + 8, L_ - 1);
                    ua[g4] = *(const uint4*)(u0 + n0); ub[g4] = *(const uint4*)(u1 + n0);
                    pa[g4] = u0[np]; na[g4] = u0[nn]; pb2[g4] = u1[np]; nb2[g4] = u1[nn];
                }
                __builtin_amdgcn_sched_barrier(0);
#pragma unroll
                for (int g4 = 0; g4 < 4; ++g4) asm volatile("" : "+v"(pa[g4]), "+v"(na[g4]), "+v"(pb2[g4]), "+v"(nb2[g4]));
#pragma unroll
                for (int g4 = 0; g4 < 4; ++g4) {
                    const int n0 = 8 * (t + 512 * g4);
                    float a[8], b[8];
                    cv8(ua[g4], (u16)pa[g4], (u16)na[g4], n0, w0, w1, w2, wb, a); cv8(ub[g4], (u16)pb2[g4], (u16)nb2[g4], n0, w0, w1, w2, wb, b);
                    unsigned* d = TT + (n0 >> 7) * 132 + (n0 & 127);
                    *(uint4*)d = make_uint4(pack2(a[0], b[0]), pack2(a[1], b[1]), pack2(a[2], b[2]), pack2(a[3], b[3]));
                    *(uint4*)(d + 4) = make_uint4(pack2(a[4], b[4]), pack2(a[5], b[5]), pack2(a[6], b[6]), pack2(a[7], b[7]));
                }
            }
            __syncthreads();
#pragma unroll
            for (int k = 0; k < 4; ++k) {
                const int task = t + 512 * k, b = task & 127, a0 = (task >> 7) * 8;
                unsigned v[8];
#pragma unroll
                for (int e = 0; e < 8; ++e) v[e] = TT[(a0 + e) * 132 + b];
                unsigned* d = zT + arr * 16384 + b * 128 + a0;
                *(uint4*)d = make_uint4(v[0], v[1], v[2], v[3]); *(uint4*)(d + 4) = make_uint4(v[4], v[5], v[6], v[7]);
            }
        }
#pragma unroll 1
        for (int o = 0; o < 2; ++o) {
            const float* tf = taps + (size_t)(o * 2048 + c) * L_;
            const float* tg = taps + (size_t)(o * 2048 + 1024 + c) * L_;
            const float skip = p.in(36)[(size_t)(i * 2 + o) * 1024 + c];
            const unsigned* gT = zT + (1 + o) * 16384;
            float ssum = 0.f;
            {
                float4 fa[8], ga[8];
#pragma unroll
                for (int g4 = 0; g4 < 8; ++g4) { const int n0 = 4 * (t + 512 * g4); fa[g4] = *(const float4*)(tf + n0); ga[g4] = *(const float4*)(tg + n0); }
                __builtin_amdgcn_sched_barrier(0);
#pragma unroll
                for (int g4 = 0; g4 < 8; ++g4)
                    ssum += fabsf(fa[g4].x) + fabsf(fa[g4].y) + fabsf(fa[g4].z) + fabsf(fa[g4].w) + fabsf(ga[g4].x) + fabsf(ga[g4].y) + fabsf(ga[g4].z) + fabsf(ga[g4].w);
            }
            ssum = wave_sum(ssum);
            __syncthreads();
            if (lane == 0) red[wid] = ssum;
            __syncthreads();
            float tot = 0.f;
#pragma unroll
            for (int q = 0; q < 8; ++q) tot += red[q];
            const float inv = 1.0f / (tot + 1e-6f);
#pragma unroll 1
            for (int half = 0; half < 2; ++half) {
                t = t_outer; asm volatile("" : "+v"(t)); lane = t & 63; wid = t >> 6; fr = lane & 15; fq = lane >> 4;
                f32x4 accr[8], acci[8];
                __syncthreads();
                {
                    float fv[4][8], gv[4][8];
#pragma unroll
                    for (int k = 0; k < 4; ++k) {
                        const int task = t + 512 * k, b = task & 127, a0 = (task >> 7) * 8;
#pragma unroll
                        for (int e = 0; e < 8; ++e) { const int n = 128 * (a0 + e) + b; fv[k][e] = tf[n]; gv[k][e] = tg[n]; }
                    }
                    if (half == 0) {
#pragma unroll
                        for (int k = 0; k < 4; ++k) {
                            const int task = t + 512 * k, b = task & 127, a0 = (task >> 7) * 8;
                            float xr[8];
#pragma unroll
                            for (int e = 0; e < 8; ++e) xr[e] = (fv[k][e] + gv[k][e]) * inv;
                            *(uint4*)(DR + b * HLD2 + a0) = make_uint4(pack2(xr[0], xr[1]), pack2(xr[2], xr[3]), pack2(xr[4], xr[5]), pack2(xr[6], xr[7]));
                            *(uint4*)(DI + b * HLD2 + a0) = make_uint4(0u, 0u, 0u, 0u);
                        }
                    } else {
#pragma unroll
                        for (int k = 0; k < 4; ++k) {
                            const int task = t + 512 * k, b = task & 127, a0 = (task >> 7) * 8;
                            float xr[8], xi[8];
#pragma unroll
                            for (int e = 0; e < 8; ++e) {
                                const int n = 128 * (a0 + e) + b;
                                const float rev = (float)n * invN, dd = (fv[k][e] - gv[k][e]) * inv;
                                xr[e] = dd * __builtin_amdgcn_cosf(rev); xi[e] = -dd * __builtin_amdgcn_sinf(rev);
                            }
                            *(uint4*)(DR + b * HLD2 + a0) = make_uint4(pack2(xr[0], xr[1]), pack2(xr[2], xr[3]), pack2(xr[4], xr[5]), pack2(xr[6], xr[7]));
                            *(uint4*)(DI + b * HLD2 + a0) = make_uint4(pack2(xi[0], xi[1]), pack2(xi[2], xi[3]), pack2(xi[4], xi[5]), pack2(xi[6], xi[7]));
                        }
                    }
                }
                fft128_fwd(FC, FS, DR, DI, wid, fr, fq, accr, acci);
                unsigned Fr[32];
#pragma unroll
                for (int nt = 0; nt < 8; ++nt)
#pragma unroll
                    for (int j = 0; j < 4; ++j) Fr[nt * 4 + j] = pack2(accr[nt][j], acci[nt][j]);
                t = t_outer; asm volatile("" : "+v"(t)); lane = t & 63; wid = t >> 6; fr = lane & 15; fq = lane >> 4;
                __syncthreads();
                {
                    uint4 zq[4][2];
#pragma unroll
                    for (int k = 0; k < 4; ++k) {
                        const int task = t + 512 * k, b = task & 127, a0 = (task >> 7) * 8;
                        zq[k][0] = *(const uint4*)(zT + b * 128 + a0); zq[k][1] = *(const uint4*)(zT + b * 128 + a0 + 4);
                    }
                    if (half == 0) {
#pragma unroll
                        for (int k = 0; k < 4; ++k) {
                            const int task = t + 512 * k, b = task & 127, a0 = (task >> 7) * 8;
                            const unsigned zz[8] = {zq[k][0].x, zq[k][0].y, zq[k][0].z, zq[k][0].w, zq[k][1].x, zq[k][1].y, zq[k][1].z, zq[k][1].w};
                            *(uint4*)(DR + b * HLD2 + a0) = make_uint4((zz[0] & 0xffffu) | (zz[1] << 16), (zz[2] & 0xffffu) | (zz[3] << 16), (zz[4] & 0xffffu) | (zz[5] << 16), (zz[6] & 0xffffu) | (zz[7] << 16));
                            *(uint4*)(DI + b * HLD2 + a0) = make_uint4((zz[0] >> 16) | (zz[1] & 0xffff0000u), (zz[2] >> 16) | (zz[3] & 0xffff0000u), (zz[4] >> 16) | (zz[5] & 0xffff0000u), (zz[6] >> 16) | (zz[7] & 0xffff0000u));
                        }
                    } else {
#pragma unroll
                        for (int k = 0; k < 4; ++k) {
                            const int task = t + 512 * k, b = task & 127, a0 = (task >> 7) * 8;
                            const unsigned zz[8] = {zq[k][0].x, zq[k][0].y, zq[k][0].z, zq[k][0].w, zq[k][1].x, zq[k][1].y, zq[k][1].z, zq[k][1].w};
                            float xr[8], xi[8];
#pragma unroll
                            for (int e = 0; e < 8; ++e) {
                                const float zr = lo2f(zz[e]), zi = hi2f(zz[e]);
                                const float rev = (float)(128 * (a0 + e) + b) * invN; const float cs = __builtin_amdgcn_cosf(rev), sn = __builtin_amdgcn_sinf(rev);
                                xr[e] = zr * cs + zi * sn; xi[e] = zi * cs - zr * sn;
                            }
                            *(uint4*)(DR + b * HLD2 + a0) = make_uint4(pack2(xr[0], xr[1]), pack2(xr[2], xr[3]), pack2(xr[4], xr[5]), pack2(xr[6], xr[7]));
                            *(uint4*)(DI + b * HLD2 + a0) = make_uint4(pack2(xi[0], xi[1]), pack2(xi[2], xi[3]), pack2(xi[4], xi[5]), pack2(xi[6], xi[7]));
                        }
                    }
                }
                fft128_fwd(FC, FS, DR, DI, wid, fr, fq, accr, acci);
                t = t_outer; asm volatile("" : "+v"(t)); lane = t & 63; wid = t >> 6; fr = lane & 15; fq = lane >> 4;
#pragma unroll
                for (int nt = 0; nt < 8; ++nt)
#pragma unroll
                    for (int j = 0; j < 4; ++j) {
                        const float fr_ = lo2f(Fr[nt * 4 + j]), fi_ = hi2f(Fr[nt * 4 + j]);
                        const float xr = accr[nt][j], xi = acci[nt][j];
                        accr[nt][j] = xr * fr_ - xi * fi_; acci[nt][j] = xr * fi_ + xi * fr_;
                    }
                fft128_inv(FC, FS, DR, DI, wid, fr, fq, accr, acci);
                if (half == 0) {
#pragma unroll
                    for (int nt = 0; nt < 8; ++nt) {
                        AS[((wid * 8 + nt) * 64 + lane) * 2 + 0] = make_float4(accr[nt][0], accr[nt][1], accr[nt][2], accr[nt][3]);
                        AS[((wid * 8 + nt) * 64 + lane) * 2 + 1] = make_float4(acci[nt][0], acci[nt][1], acci[nt][2], acci[nt][3]);
                    }
                } else {
                    t = t_outer; asm volatile("" : "+v"(t)); lane = t & 63; wid = t >> 6; fr = lane & 15; fq = lane >> 4;
                    const int a0 = 16 * wid + 4 * fq;
#pragma unroll
                    for (int nb = 0; nb < 2; ++nb) {
                        float4 ar4[4], ai4[4]; uint4 zq4[4], gq4[4];
#pragma unroll
                        for (int k = 0; k < 4; ++k) {
                            const int nt = 4 * nb + k, b = 16 * nt + fr;
                            ar4[k] = AS[((wid * 8 + nt) * 64 + lane) * 2 + 0]; ai4[k] = AS[((wid * 8 + nt) * 64 + lane) * 2 + 1];
                            zq4[k] = *(const uint4*)(zT + b * 128 + a0); gq4[k] = *(const uint4*)(gT + b * 128 + a0);
                        }
                        __builtin_amdgcn_sched_barrier(0);
#pragma unroll
                        for (int k = 0; k < 4; ++k) {
                            const int nt = 4 * nb + k, b = 16 * nt + fr;
                            const float are[4] = {ar4[k].x, ar4[k].y, ar4[k].z, ar4[k].w}, aim[4] = {ai4[k].x, ai4[k].y, ai4[k].z, ai4[k].w};
                            const unsigned zz[4] = {zq4[k].x, zq4[k].y, zq4[k].z, zq4[k].w}, gg[4] = {gq4[k].x, gq4[k].y, gq4[k].z, gq4[k].w};
                            unsigned yo[4];
#pragma unroll
                            for (int j = 0; j < 4; ++j) {
                                const int n = 128 * (a0 + j) + b;
                                const float rev = (float)n * invN; const float cs = __builtin_amdgcn_cosf(rev), sn = __builtin_amdgcn_sinf(rev);
                                const float br = accr[nt][j] * cs - acci[nt][j] * sn, bi = acci[nt][j] * cs + accr[nt][j] * sn;
                                const float yr = ((are[j] + br) * invN + lo2f(zz[j]) * skip) * lo2f(gg[j]);
                                const float yi = ((aim[j] + bi) * invN + hi2f(zz[j]) * skip) * hi2f(gg[j]);
                                yo[j] = pack2(yr, yi);
                                if (o == 1) { Y2T[(size_t)(0 * 1024 + c) * L_ + n] = f2bf(yr); Y2T[(size_t)(1 * 1024 + c) * L_ + n] = f2bf(yi); }
                            }
                            if (o == 0) *(uint4*)(zT + b * 128 + a0) = make_uint4(yo[0], yo[1], yo[2], yo[3]);
                        }
                    }
                }
            }
        }
    }
}

__device__ __forceinline__ void phase_transpose(const PP p, char* smem) {
    const int t = tid_opaque();
    u16* tile = (u16*)smem;
    const u16* Y2T = (const u16*)(p.ws() + HY_Y2T);
    u16* Y2 = (u16*)(p.ws() + HY_Y2);
    const int r = t >> 3, ch = t & 7;
    for (int base = blockIdx.x * 8; base < 8192; base += gridDim.x * 8) {
        uint4 u[8];
#pragma unroll
        for (int k = 0; k < 8; ++k) {
            const int id = base + k, b = id >> 12, c0 = ((id >> 8) & 15) * 64, n0 = (id & 255) * 64;
            u[k] = *(const uint4*)(Y2T + ((size_t)(b * 1024 + c0 + r)) * L_ + n0 + ch * 8);
        }
        __syncthreads();
#pragma unroll
        for (int k = 0; k < 8; ++k) {
            u16* d = tile + k * (64 * 66) + r * 66 + ch * 8;
            d[0] = (u16)(u[k].x & 0xffff); d[1] = (u16)(u[k].x >> 16); d[2] = (u16)(u[k].y & 0xffff); d[3] = (u16)(u[k].y >> 16);
            d[4] = (u16)(u[k].z & 0xffff); d[5] = (u16)(u[k].z >> 16); d[6] = (u16)(u[k].w & 0xffff); d[7] = (u16)(u[k].w >> 16);
        }
        __syncthreads();
#pragma unroll
        for (int k = 0; k < 8; ++k) {
            const int id = base + k, b = id >> 12, c0 = ((id >> 8) & 15) * 64, n0 = (id & 255) * 64;
            const u16* tk = tile + k * (64 * 66);
            unsigned w[4];
#pragma unroll
            for (int e = 0; e < 4; ++e) w[e] = (unsigned)tk[(ch * 8 + 2 * e) * 66 + r] | ((unsigned)tk[(ch * 8 + 2 * e + 1) * 66 + r] << 16);
            *(uint4*)(Y2 + ((size_t)b * L_ + n0 + r) * 1024 + c0 + ch * 8) = make_uint4(w[0], w[1], w[2], w[3]);
        }
    }
}

}

__device__ __forceinline__ PP pq(KP kp) { asm volatile("" : "+s"(kp)); PP r; r.k = kp; return r; }
__global__ void __launch_bounds__(512, 2) fwd_kernel(P p_unused) {
    KP kp = (KP)__builtin_amdgcn_kernarg_segment_ptr();
    extern __shared__ __attribute__((aligned(16))) char smem_raw[];
    char* smem = smem_raw + 16;
    if (threadIdx.x == 0) *(uint4*)smem_raw = make_uint4(0u, 0u, 0u, 0u);
    __syncthreads();
    (void)xcd_barrier_post((unsigned*)(pq(kp).ws() + OFF_BAR), (volatile LAS unsigned*)smem_raw);
#define GRID_BARRIER() do { XcdBarrier b_; b_.bar = (unsigned*)(pq(kp).ws() + OFF_BAR); b_.x = xb_xcc_id(); b_.st = (volatile LAS unsigned*)smem_raw; xcd_barrier(b_); } while (0)
    phase_prologue_a(pq(kp), smem);
    phase_hdn(pq(kp), 0);
    phase_hdn(pq(kp), 1);
    GRID_BARRIER();
    phase_prologue_b(pq(kp));
    GRID_BARRIER();
#pragma unroll 1
    for (int layer = 0; layer < 4; ++layer) {
        const int i = layer >> 1;
        if ((layer & 1) == 0) {
            phase_g1(pq(kp), smem, i);
            GRID_BARRIER();
            phase_na(pq(kp), smem, i);
            phase_rwprep(pq(kp), i);
            GRID_BARRIER();
            phase_lora(pq(kp), smem, i);
            GRID_BARRIER();
            phase_scanA(pq(kp), smem);
            GRID_BARRIER();
            phase_scanB1(pq(kp));
            GRID_BARRIER();
            phase_scanB2(pq(kp));
            GRID_BARRIER();
            phase_combine(pq(kp), i);
            GRID_BARRIER();
        } else {
            phase_g3(pq(kp), smem, i);
            __syncthreads();
            phase_taps(pq(kp), smem, i);
            GRID_BARRIER();
            phase_hyena(pq(kp), smem, i);
            GRID_BARRIER();
            phase_transpose(pq(kp), smem);
            GRID_BARRIER();
        }
        phase_gout(pq(kp), smem, (const u16*)(pq(kp).ws() + ((layer & 1) ? HY_Y2 : OFF_MIX)), (const u16*)(pq(kp).ws() + ((layer & 1) ? OFF_WOUTH : OFF_WOUTE)) + (size_t)i * 1024 * 1024, layer);
        GRID_BARRIER();
        phase_lna(pq(kp), smem, layer);
        GRID_BARRIER();
        phase_scatter(pq(kp), smem);
        GRID_BARRIER();
        phase_moe1(pq(kp), smem, layer);
        GRID_BARRIER();
        phase_moe2(pq(kp), smem, layer);
        GRID_BARRIER();
        phase_lnb(pq(kp), layer);
        GRID_BARRIER();
    }
}

extern "C" void kernel_launch(void* const* d_in, const int* in_sizes, int n_in,
                              void* d_out, int out_size, void* d_ws, size_t ws_size,
                              hipStream_t stream) {
    static int grid = 0;
    if (!grid) {
        int dev = 0, cus = 0, per_cu = 0;
        hipGetDevice(&dev);
        hipDeviceGetAttribute(&cus, hipDeviceAttributeMultiprocessorCount, dev);
        hipFuncSetAttribute((const void*)fwd_kernel, hipFuncAttributeMaxDynamicSharedMemorySize, LDS_BYTES);
        hipOccupancyMaxActiveBlocksPerMultiprocessor(&per_cu, fwd_kernel, NTHR, LDS_BYTES);
        if (per_cu < 1) { fprintf(stderr, "occupancy query returned %d\n", per_cu); per_cu = 1; }
        grid = cus;
    }
    if (ws_size < WS_NEED || n_in < 38) { fprintf(stderr, "workspace too small: %zu < %zu\n", ws_size, (size_t)WS_NEED); return; }
    hipMemsetAsync(d_ws, 0, XCD_BAR_WORDS * sizeof(unsigned), stream);
    P p{};
    for (int i = 0; i < 38; ++i) p.in[i] = (const float*)d_in[i];
    p.out = (float*)d_out; p.ws = (char*)d_ws;
    hipLaunchKernelGGL(fwd_kernel, dim3(grid), dim3(NTHR), LDS_BYTES, stream, p);
}
```

```cpp
#include <hip/hip_runtime.h>
#include <hip/hip_fp16.h>
#include <stdint.h>
#include <stdio.h>

#define XB_TMO      128
#define XB_XCNT(j)  (256  + 64 * (j))
#define XB_XSUB(j)  (1280 + 64 * (j))
#define XB_XGEN(j)  (2304 + 64 * (j))
#define XB_TOP      3328
#define XB_TOPGEN   3392
#define XCD_BAR_WORDS 3456
#define XB_SPIN_CAP (1u << 22)
#define LAS __attribute__((address_space(3)))

__device__ __forceinline__ unsigned xb_ld(unsigned* p)              { return __hip_atomic_load(p, __ATOMIC_RELAXED, __HIP_MEMORY_SCOPE_AGENT); }
__device__ __forceinline__ unsigned xb_add(unsigned* p, unsigned v) { return __hip_atomic_fetch_add(p, v, __ATOMIC_RELAXED, __HIP_MEMORY_SCOPE_AGENT); }
__device__ __forceinline__ unsigned xb_xcc_id() { return (unsigned)__builtin_amdgcn_s_getreg((3 << 11) | 20) & 0xFu; }
#define XB_SPIN(cond, bar) do { unsigned _sp = 0; while (cond) { __builtin_amdgcn_s_sleep(1); \
    if ((++_sp & 255u) == 0u) { if (xb_ld(&(bar)[XB_TMO])) break; if (_sp > XB_SPIN_CAP) { atomicAdd(&(bar)[XB_TMO], 1u); break; } } } } while (0)

struct XcdBarrier { unsigned* bar; unsigned x; volatile LAS unsigned* st; };

__device__ __forceinline__ XcdBarrier xcd_barrier_post(unsigned* bar, volatile LAS unsigned* st) {
    XcdBarrier b; b.bar = bar; b.x = xb_xcc_id(); b.st = st;
    if (threadIdx.x == 0) (void)xb_add(&bar[XB_XCNT(b.x)], 1u);
    return b;
}
__device__ __forceinline__ void xcd_barrier_complete(unsigned* bar, unsigned x, unsigned& nloc, unsigned& nx) {
    const unsigned G = gridDim.x * gridDim.y * gridDim.z;
    unsigned sum, cnt, mine, sp = 0u;
    for (;;) {
        sum = 0u; cnt = 0u; mine = 0u;
#pragma unroll
        for (unsigned j = 0; j < 16; ++j) { const unsigned c = xb_ld(&bar[XB_XCNT(j)]); sum += c; cnt += (c > 0u) ? 1u : 0u; mine = (j == x) ? c : mine; }
        if (sum == G) break;
        __builtin_amdgcn_s_sleep(1);
        if ((++sp & 255u) == 0u) { if (xb_ld(&bar[XB_TMO])) break; if (sp > XB_SPIN_CAP) { atomicAdd(&bar[XB_TMO], 1u); break; } }
    }
    nloc = mine > 0u ? mine : 1u; nx = cnt > 0u ? cnt : 1u;
}
__device__ __forceinline__ void xcd_barrier(const XcdBarrier& b) {
    asm volatile("s_waitcnt vmcnt(0)" ::: "memory");
    __syncthreads();
    if (threadIdx.x == 0) {
        unsigned* bar = b.bar;
        __builtin_amdgcn_s_waitcnt(0);
        unsigned nloc = b.st[0], nx = b.st[1];
        if (nloc == 0u) { xcd_barrier_complete(bar, b.x, nloc, nx); b.st[0] = nloc; b.st[1] = nx; }
        const unsigned old = xb_add(&bar[XB_XSUB(b.x)], 1u);
        const unsigned gen = old / nloc;
        if (old + 1u == (gen + 1u) * nloc) {
            __builtin_amdgcn_fence(__ATOMIC_RELEASE, "agent");
            asm volatile("s_waitcnt vmcnt(0)" ::: "memory");
            const unsigned og = xb_add(&bar[XB_TOP], 1u);
            const unsigned tg = og / nx;
            if (og + 1u == (tg + 1u) * nx) xb_add(&bar[XB_TOPGEN], 1u);
            else XB_SPIN(xb_ld(&bar[XB_TOPGEN]) == tg, bar);
            __builtin_amdgcn_fence(__ATOMIC_ACQUIRE, "agent");
            xb_add(&bar[XB_XGEN(b.x)], 1u);
            asm volatile("s_waitcnt vmcnt(0)" ::: "memory");
        } else {
            XB_SPIN(xb_ld(&bar[XB_XGEN(b.x)]) == gen, bar);
            __builtin_amdgcn_fence(__ATOMIC_ACQUIRE, "agent");
            asm volatile("s_waitcnt vmcnt(0)" ::: "memory");
        }
    }
    __syncthreads();
}

namespace {
constexpr int T_ = 32768, D_ = 1024, L_ = 16384;
constexpr int ABP = 3456;
constexpr int FF = 704;
constexpr int NSLOT = 73728;
constexpr float ALPHA_F = 1.681792830507429f;
constexpr int NTHR = 512;
constexpr int LDS_BYTES = 152 * 1024;

typedef unsigned short u16;
using bf16x8 = __attribute__((ext_vector_type(8))) short;
using f32x4  = __attribute__((ext_vector_type(4))) float;

constexpr size_t al(size_t x) { return (x + 255) & ~(size_t)255; }
constexpr size_t OFF_BAR   = 0;
constexpr size_t OFF_ADA   = al(OFF_BAR + 16384);
constexpr size_t OFF_CNT   = al(OFF_ADA + 4 * 2 * 6144 * 4);
constexpr size_t OFF_META  = al(OFF_CNT + 256 * 32 * 4);
constexpr size_t OFF_TOKE  = al(OFF_META + 4096);
constexpr size_t OFF_TOKG  = al(OFF_TOKE + (size_t)T_ * 2 * 4);
constexpr size_t OFF_TOKS  = al(OFF_TOKG + (size_t)T_ * 2 * 4);
constexpr size_t OFF_SLTK  = al(OFF_TOKS + (size_t)T_ * 2 * 4);
constexpr size_t OFF_HDN   = al(OFF_SLTK + (size_t)NSLOT * 4);
constexpr size_t OFF_WGU   = al(OFF_HDN + (size_t)2 * L_ * 64 * 2);
constexpr size_t OFF_WD    = al(OFF_WGU + (size_t)4 * 32 * 1536 * 1024 * 2);
constexpr size_t OFF_WINE  = al(OFF_WD + (size_t)4 * 32 * 1024 * 704 * 2);
constexpr size_t OFF_WOUTE = al(OFF_WINE + (size_t)2 * 3584 * 1024 * 2);
constexpr size_t OFF_WINH  = al(OFF_WOUTE + (size_t)2 * 1024 * 1024 * 2);
constexpr size_t OFF_WOUTH = al(OFF_WINH + (size_t)2 * 3072 * 1024 * 2);
constexpr size_t OFF_WUP   = al(OFF_WOUTH + (size_t)2 * 1024 * 1024 * 2);
constexpr size_t OFF_AUP   = al(OFF_WUP + (size_t)4 * 512 * 64 * 2);
constexpr size_t OFF_GUP   = al(OFF_AUP + (size_t)4 * 512 * 64 * 2);
constexpr size_t OFF_W4T   = al(OFF_GUP + (size_t)2 * 512 * 128 * 2);
constexpr size_t OFF_HBUF  = al(OFF_W4T + (size_t)2 * 4096 * 64 * 2);
constexpr size_t OFF_P     = al(OFF_HBUF + (size_t)T_ * 1024 * 2);
constexpr size_t SZ_P      = (size_t)T_ * ABP * 2;
constexpr size_t OFF_MIX   = al(OFF_P + SZ_P);
constexpr size_t OFF_RW    = al(OFF_MIX + (size_t)T_ * 1024 * 2);
constexpr size_t SZ_RW     = (size_t)320 << 20;
constexpr size_t OFF_O     = al(OFF_RW + SZ_RW);
constexpr size_t SZ_O      = (size_t)128 << 20;
constexpr size_t WS_NEED   = OFF_O + SZ_O;

constexpr size_t RW_R   = OFF_RW;
constexpr size_t RW_V   = RW_R + (size_t)T_ * 512 * 2;
constexpr size_t RW_KK  = RW_V + (size_t)T_ * 512 * 2;
constexpr size_t RW_G   = RW_KK + (size_t)T_ * 512 * 2;
constexpr size_t RW_W   = RW_G + (size_t)T_ * 512 * 2;
constexpr size_t RW_KD  = RW_W + (size_t)T_ * 1024 * 2;
constexpr size_t RW_BQ  = RW_KD + (size_t)T_ * 1024 * 2;
constexpr size_t O_OF   = OFF_O;
constexpr size_t O_OB   = OFF_O + (size_t)T_ * 512 * 4;
constexpr size_t O_KP   = OFF_O;
constexpr size_t O_AWD  = O_KP + (size_t)T_ * 512 * 2;
constexpr size_t O_AAD  = O_AWD + (size_t)T_ * 128 * 2;
constexpr size_t O_AGD  = O_AAD + (size_t)T_ * 128 * 2;
constexpr size_t MOE_H  = OFF_P;
constexpr size_t MOE_Y  = OFF_RW;
constexpr size_t HY_UT   = OFF_P;
constexpr size_t HY_TAPS = OFF_RW;
constexpr size_t HY_Y2   = OFF_RW + (size_t)4096 * L_ * 4;
constexpr size_t HY_Y2T  = OFF_MIX;
constexpr size_t HY_SPEC = OFF_O;
constexpr size_t HY_Y1   = OFF_HBUF;

struct P { const float* in[38]; float* out; char* ws; };
typedef const __attribute__((address_space(4))) P* KP;
struct PP { KP k;
    __device__ __forceinline__ const float* in(int i) const { return k->in[i]; }
    __device__ __forceinline__ char* ws() const { return k->ws; }
    __device__ __forceinline__ float* out() const { return k->out; } };

__device__ __forceinline__ int tid_opaque() { int t = threadIdx.x; asm volatile("" : "+v"(t)); return t; }
__device__ __forceinline__ float bf2f(u16 h) { return __uint_as_float(((unsigned)h) << 16); }
typedef float f32x2_t __attribute__((ext_vector_type(2)));
typedef __bf16 bf16x2_t __attribute__((ext_vector_type(2)));
__device__ __forceinline__ u16 f2bf(float f) { const __bf16 h = (__bf16)f; return __builtin_bit_cast(u16, h); }
__device__ __forceinline__ unsigned pack2(float a, float b) { const f32x2_t v = {a, b}; const bf16x2_t r = __builtin_convertvector(v, bf16x2_t); return __builtin_bit_cast(unsigned, r); }
__device__ __forceinline__ float lo2f(unsigned u) { return __uint_as_float(u << 16); }
__device__ __forceinline__ float hi2f(unsigned u) { return __uint_as_float(u & 0xffff0000u); }
__device__ __forceinline__ float4 up4(uint2 u) { return make_float4(lo2f(u.x), hi2f(u.x), lo2f(u.y), hi2f(u.y)); }
__device__ __forceinline__ float wave_sum(float v) {
#pragma unroll
    for (int o = 32; o >= 1; o >>= 1) v += __shfl_xor(v, o);
    return v;
}
__device__ __forceinline__ float wave_max(float v) {
#pragma unroll
    for (int o = 32; o >= 1; o >>= 1) v = fmaxf(v, __shfl_xor(v, o));
    return v;
}
__device__ __forceinline__ float sigmoidf_(float x) { return __builtin_amdgcn_rcpf(1.0f + __expf(-x)); }

constexpr int GLD = 72;
constexpr int G_AS = 256 * GLD;
constexpr int G_BS = 128 * GLD;

template <bool TR = false, class AL, class BL>
__device__ __forceinline__ void gemm_mainloop(u16* smem, int nk, AL aload, BL bload, f32x4 (&acc)[4][4]) {
    const int tid = tid_opaque(), lane = tid & 63, wid = tid >> 6;
    const int wm = wid >> 1, wn = wid & 1, fr = lane & 15, fq = lane >> 4;
    u16* As = smem; u16* Bs = smem + 2 * G_AS;
    const int arow = tid >> 3, akc = (tid & 7) * 8;
    uint4 ra[4], rb[2], ra2[4], rb2[2];
#pragma unroll
    for (int m = 0; m < 4; ++m)
#pragma unroll
        for (int n = 0; n < 4; ++n) acc[m][n] = f32x4{0.f, 0.f, 0.f, 0.f};
#define G_LOAD(RA, RB, KT) { _Pragma("unroll") for (int i = 0; i < 4; ++i) RA[i] = aload(i, arow + 64 * i, (KT) * 64 + akc); \
                             _Pragma("unroll") for (int i = 0; i < 2; ++i) RB[i] = bload(i, arow + 64 * i, (KT) * 64 + akc); }
#define G_STORE(RA, RB, BUF) { _Pragma("unroll") for (int i = 0; i < 4; ++i) *(uint4*)(As + (BUF) * G_AS + (arow + 64 * i) * GLD + akc) = RA[i]; \
                               _Pragma("unroll") for (int i = 0; i < 2; ++i) *(uint4*)(Bs + (BUF) * G_BS + (arow + 64 * i) * GLD + akc) = RB[i]; }
#define G_COMPUTE(BUF) { const u16* Ab = As + (BUF) * G_AS + (wm * 64 + fr) * GLD + fq * 8; const u16* Bb = Bs + (BUF) * G_BS + (wn * 64 + fr) * GLD + fq * 8; \
        _Pragma("unroll") for (int ks = 0; ks < 2; ++ks) { bf16x8 af[4], bfr[4]; \
            _Pragma("unroll") for (int m = 0; m < 4; ++m) af[m] = *(const bf16x8*)(Ab + m * 16 * GLD + ks * 32); \
            _Pragma("unroll") for (int n = 0; n < 4; ++n) bfr[n] = *(const bf16x8*)(Bb + n * 16 * GLD + ks * 32); \
            _Pragma("unroll") for (int m = 0; m < 4; ++m) _Pragma("unroll") for (int n = 0; n < 4; ++n) \
                acc[m][n] = TR ? __builtin_amdgcn_mfma_f32_16x16x32_bf16(bfr[n], af[m], acc[m][n], 0, 0, 0) : __builtin_amdgcn_mfma_f32_16x16x32_bf16(af[m], bfr[n], acc[m][n], 0, 0, 0); } }
    G_LOAD(ra, rb, 0)
    if (nk > 1) G_LOAD(ra2, rb2, 1)
    G_STORE(ra, rb, 0)
    if (nk > 2) G_LOAD(ra, rb, 2)
    __syncthreads();
#pragma unroll 1
    for (int kt = 0; kt < nk; kt += 2) {
        G_COMPUTE(0)
        if (kt + 1 < nk) G_STORE(ra2, rb2, 1)
        if (kt + 3 < nk) G_LOAD(ra2, rb2, kt + 3)
        __syncthreads();
        if (kt + 1 < nk) {
            G_COMPUTE(1)
            if (kt + 2 < nk) G_STORE(ra, rb, 0)
            if (kt + 4 < nk) G_LOAD(ra, rb, kt + 4)
            __syncthreads();
        }
    }
#undef G_LOAD
#undef G_STORE
#undef G_COMPUTE
}


namespace g8 {
#define G8_LAS __attribute__((address_space(3)))
constexpr int BM = 256, BK = 64, HALF = 128, HTB = HALF * BK * 2;
__device__ __forceinline__ int lds_byte(int r, int c) { const int st = (r >> 4) * 2 + (c >> 5), rr = r & 15, cc = c & 31, ob = rr * 64 + cc * 2; return st * 1024 + (ob ^ (((ob >> 9) & 1) << 5)); }
__device__ __forceinline__ void stage_rc(int b, int& R, int& C) { const int st = b / 1024, sb = b % 1024, swz = sb ^ (((sb >> 9) & 1) << 5); R = (st >> 1) * 16 + swz / 64; C = (st & 1) * 32 + (swz % 64) / 2; }
__device__ __forceinline__ int perm32(int rho) { const int n = rho >> 4, i = rho & 15; return 8 * (i >> 2) + 4 * n + (i & 3); }
struct Unit { const char* a; const char* b; int pm, pn, aux; };

template <bool PERM, bool GATHER, class Sched, class Epi>
__device__ __forceinline__ void gemm(G8_LAS unsigned char* lds, const int K, const int lda, const int ldb, const int* __restrict__ rowidx, const Sched& S, const Epi& E) {
    const int tid = tid_opaque(), wid = __builtin_amdgcn_readfirstlane(tid >> 6), lane = tid & 63, wr = wid >> 2, wc = wid & 3, fr = lane & 15, fq = lane >> 4;
    const int nt = K / BK;
    unsigned voffA[2], voffB[2];
#pragma unroll
    for (int i = 0; i < 2; ++i) { int R, C; stage_rc(tid * 16 + i * 8192, R, C); const int Rb = PERM ? ((R & ~31) + perm32(R & 31)) : R;
        voffA[i] = (unsigned)(R * lda + C) * 2u; voffB[i] = (unsigned)(Rb * ldb + C) * 2u; }
    const size_t kstep = (size_t)(BK * 2);
    const size_t hstepA = (size_t)HALF * lda * 2, hstepB = (size_t)HALF * ldb * 2;
    const unsigned ldsw = (unsigned)wid * 1024u;
    const int aoff = lds_byte(wr * 64 + fr, fq * 8), boff = lds_byte(wc * 32 + fr, fq * 8);
#define G8_SA(b, h) (((b) * 2 + (h)) * HTB)
#define G8_SB(b, h) ((4 + (b) * 2 + (h)) * HTB)
#define G8_STAGE(bufoff, gbase, voff) do { _Pragma("unroll") for (int _i = 0; _i < 2; ++_i) \
        __builtin_amdgcn_global_load_lds((const unsigned*)((const char*)(gbase) + (voff)[_i]), (G8_LAS unsigned*)(lds + (bufoff) + ldsw + _i * 8192), 16, 0, 0); } while (0)
#define G8_STAGE_A(bufoff, gbase, h, sel) do { if (GATHER) { _Pragma("unroll") for (int _i = 0; _i < 2; ++_i) \
        __builtin_amdgcn_global_load_lds((const unsigned*)((const char*)(gbase) + ((sel) ? goN[h][_i] : goC[h][_i])), (G8_LAS unsigned*)(lds + (bufoff) + ldsw + _i * 8192), 16, 0, 0); } \
        else G8_STAGE(bufoff, (gbase) + (h) * hstepA, voffA); } while (0)
#define G8_LDA(dst, b, h) do { _Pragma("unroll") for (int m = 0; m < 4; ++m) _Pragma("unroll") for (int k = 0; k < 2; ++k) dst[m][k] = *(const G8_LAS bf16x8*)(lds + G8_SA(b, h) + aoff + m * 2048 + k * 1024); } while (0)
#define G8_LDB(dst, b, h) do { _Pragma("unroll") for (int n = 0; n < 2; ++n) _Pragma("unroll") for (int k = 0; k < 2; ++k) dst[n][k] = *(const G8_LAS bf16x8*)(lds + G8_SB(b, h) + boff + n * 2048 + k * 1024); } while (0)
#define G8_MMA(ai, bj, At, Bt) do { __builtin_amdgcn_s_setprio(1); _Pragma("unroll") for (int m = 0; m < 4; ++m) _Pragma("unroll") for (int n = 0; n < 2; ++n) _Pragma("unroll") for (int k = 0; k < 2; ++k) \
        acc[ai][bj][m][n] = __builtin_amdgcn_mfma_f32_16x16x32_bf16(Bt[n][k], At[m][k], acc[ai][bj][m][n], 0, 0, 0); __builtin_amdgcn_s_setprio(0); } while (0)
#define G8_WAIT_V(n) asm volatile("s_waitcnt vmcnt(" #n ")" ::: "memory")
#define G8_WAIT_L(n) asm volatile("s_waitcnt lgkmcnt(" #n ")" ::: "memory")
#define G8_BAR __builtin_amdgcn_s_barrier()
#define G8_SCHED __builtin_amdgcn_sched_barrier(0)
    Unit cur, nxt; int ui = 0;
    if (!S(0, cur)) return;
    unsigned goC[2][2], goN[2][2];
#define G8_GOFF(go, u) do { if (GATHER) { const int tq_ = tid_opaque(); int ri_[2][2]; \
        _Pragma("unroll") for (int _i = 0; _i < 2; ++_i) { int R_, C_; stage_rc(tq_ * 16 + _i * 8192, R_, C_); \
            _Pragma("unroll") for (int h = 0; h < 2; ++h) ri_[h][_i] = rowidx[(u).aux + h * HALF + R_]; } \
        asm volatile("" : "+v"(ri_[0][0]), "+v"(ri_[0][1]), "+v"(ri_[1][0]), "+v"(ri_[1][1]));     \
        _Pragma("unroll") for (int _i = 0; _i < 2; ++_i) { int R_, C_; stage_rc(tq_ * 16 + _i * 8192, R_, C_); \
            _Pragma("unroll") for (int h = 0; h < 2; ++h) (go)[h][_i] = (unsigned)(ri_[h][_i] * lda + C_) * 2u; } } } while (0)
    G8_GOFF(goC, cur);
    f32x4 acc[2][2][4][2];
#pragma unroll
    for (int a = 0; a < 2; ++a)
#pragma unroll
        for (int b = 0; b < 2; ++b)
#pragma unroll
            for (int m = 0; m < 4; ++m)
#pragma unroll
                for (int n = 0; n < 2; ++n) acc[a][b][m][n] = f32x4{0.f, 0.f, 0.f, 0.f};
    bf16x8 At[4][2], B0[2][2], B1[2][2];
    const char* cA = cur.a; const char* cB = cur.b;
    G8_STAGE(G8_SB(0, 0), cB, voffB); G8_STAGE_A(G8_SA(0, 0), cA, 0, false); G8_STAGE(G8_SB(0, 1), cB + hstepB, voffB); G8_STAGE_A(G8_SA(0, 1), cA, 1, false);
    if (wr == 1) G8_BAR;
    G8_WAIT_V(4); G8_BAR;
    G8_STAGE(G8_SB(1, 0), cB + kstep, voffB); G8_STAGE_A(G8_SA(1, 0), cA + kstep, 0, false); G8_STAGE(G8_SB(1, 1), cB + hstepB + kstep, voffB);
    G8_WAIT_V(6); G8_BAR;
    for (;;) {
        const bool has_next = S(ui + 1, nxt);
        const char* nA = has_next ? nxt.a : cA; const char* nB = has_next ? nxt.b : cB;
        if (has_next) G8_GOFF(goN, nxt);
        else { _Pragma("unroll") for (int h = 0; h < 2; ++h) _Pragma("unroll") for (int _i = 0; _i < 2; ++_i) goN[h][_i] = goC[h][_i]; }
#pragma unroll 1
        for (int t = 0; t < nt; t += 2) {
            const bool last = (t == nt - 2);
            const char* a1 = cA + (size_t)(t + 1) * kstep;
            const char* a2 = last ? nA : cA + (size_t)(t + 2) * kstep; const char* b2 = last ? nB : cB + (size_t)(t + 2) * kstep;
            const char* a3 = a2 + kstep; const char* b3 = b2 + kstep;
            G8_LDB(B0, 0, 0); G8_SCHED; G8_LDA(At, 0, 0); G8_STAGE_A(G8_SA(1, 1), a1, 1, false);
            G8_WAIT_L(8); G8_BAR; G8_WAIT_L(0); G8_MMA(0, 0, At, B0); G8_BAR; G8_SCHED;
            G8_LDB(B1, 0, 1); G8_STAGE(G8_SB(0, 0), b2, voffB);
            G8_BAR; G8_WAIT_L(0); G8_MMA(0, 1, At, B1); G8_BAR;
            G8_LDA(At, 0, 1); G8_STAGE_A(G8_SA(0, 0), a2, 0, last);
            G8_BAR; G8_WAIT_L(0); G8_MMA(1, 0, At, B0); G8_BAR; G8_SCHED;
            G8_STAGE(G8_SB(0, 1), b2 + hstepB, voffB);
            G8_WAIT_V(6); G8_BAR; G8_MMA(1, 1, At, B1); G8_BAR;
            G8_LDB(B0, 1, 0); G8_SCHED; G8_LDA(At, 1, 0); G8_STAGE_A(G8_SA(0, 1), a2, 1, last);
            G8_WAIT_L(8); G8_BAR; G8_WAIT_L(0); G8_MMA(0, 0, At, B0); G8_BAR; G8_SCHED;
            G8_LDB(B1, 1, 1); G8_STAGE(G8_SB(1, 0), b3, voffB);
            G8_BAR; G8_WAIT_L(0); G8_MMA(0, 1, At, B1); G8_BAR;
            G8_LDA(At, 1, 1); G8_STAGE_A(G8_SA(1, 0), a3, 0, last);
            G8_BAR; G8_WAIT_L(0); G8_MMA(1, 0, At, B0); G8_BAR; G8_SCHED;
            G8_STAGE(G8_SB(1, 1), b3 + hstepB, voffB);
            G8_WAIT_V(6); G8_BAR; G8_MMA(1, 1, At, B1); G8_BAR;
        }
        E(acc, cur, wr, wc, fr, fq);
        if (!has_next) break;
#pragma unroll
        for (int a = 0; a < 2; ++a)
#pragma unroll
            for (int b = 0; b < 2; ++b)
#pragma unroll
                for (int m = 0; m < 4; ++m)
#pragma unroll
                    for (int n = 0; n < 2; ++n) acc[a][b][m][n] = f32x4{0.f, 0.f, 0.f, 0.f};
        cur = nxt; cA = nA; cB = nB; ++ui;
#pragma unroll
        for (int h = 0; h < 2; ++h)
#pragma unroll
            for (int _i = 0; _i < 2; ++_i) goC[h][_i] = goN[h][_i];
    }
    G8_WAIT_V(0);
    if (wr == 0) G8_BAR;
    G8_BAR;
#undef G8_SA
#undef G8_SB
#undef G8_STAGE
#undef G8_STAGE_A
#undef G8_LDA
#undef G8_LDB
#undef G8_MMA
#undef G8_WAIT_V
#undef G8_WAIT_L
#undef G8_BAR
#undef G8_SCHED
#undef G8_GOFF
}
}


struct SKTile { const u16* A; int lda; const u16* B; int ldb; int nk; };
template <bool TR, class Dec, class Epi>
__device__ __forceinline__ void gemm_smallk_loop(u16* smem, int ntiles, const Dec& dec, const Epi& epi) {
    const int tid = tid_opaque(), lane = tid & 63, wid = tid >> 6;
    const int wm = wid >> 1, wn = wid & 1, fr = lane & 15, fq = lane >> 4;
    u16* As = smem; u16* Bs = smem + 2 * G_AS;
    const int arow = tid >> 3, akc = (tid & 7) * 8;
    uint4 p0, p1, p2, p3, q0, q1, s0, s1, s2, s3, u0, u1;
    s0 = s1 = s2 = s3 = u0 = u1 = make_uint4(0u, 0u, 0u, 0u);
#define SK_LD(T, KO, A0, A1, A2, A3, B0, B1) { const u16* pa_ = (T).A + (size_t)arow * (T).lda + (KO) + akc; const u16* pb_ = (T).B + (size_t)arow * (T).ldb + (KO) + akc; \
        A0 = *(const uint4*)pa_; A1 = *(const uint4*)(pa_ + (size_t)64 * (T).lda); A2 = *(const uint4*)(pa_ + (size_t)128 * (T).lda); A3 = *(const uint4*)(pa_ + (size_t)192 * (T).lda); \
        B0 = *(const uint4*)pb_; B1 = *(const uint4*)(pb_ + (size_t)64 * (T).ldb); }
#define SK_ST(AS, BS, A0, A1, A2, A3, B0, B1) { *(uint4*)((AS) + arow * GLD + akc) = A0; *(uint4*)((AS) + (arow + 64) * GLD + akc) = A1; *(uint4*)((AS) + (arow + 128) * GLD + akc) = A2; \
        *(uint4*)((AS) + (arow + 192) * GLD + akc) = A3; *(uint4*)((BS) + arow * GLD + akc) = B0; *(uint4*)((BS) + (arow + 64) * GLD + akc) = B1; }
    if ((int)blockIdx.x >= ntiles) return;
    {
        const SKTile c0 = dec(blockIdx.x);
        SK_LD(c0, 0, p0, p1, p2, p3, q0, q1)
        if (c0.nk > 1) SK_LD(c0, 64, s0, s1, s2, s3, u0, u1)
    }
#pragma unroll 1
    for (int id = blockIdx.x; id < ntiles; id += gridDim.x) {
        const SKTile cur = dec(id);
        const int nk = cur.nk;
        SK_ST(As, Bs, p0, p1, p2, p3, q0, q1)
        if (nk > 1) SK_ST(As + G_AS, Bs + G_BS, s0, s1, s2, s3, u0, u1)
        __syncthreads();
        const int nid = id + gridDim.x;
        if (nid < ntiles) {
            const SKTile nxt = dec(nid);
            SK_LD(nxt, 0, p0, p1, p2, p3, q0, q1)
            if (nxt.nk > 1) SK_LD(nxt, 64, s0, s1, s2, s3, u0, u1)
        }
        f32x4 acc[4][4];
#pragma unroll
        for (int m = 0; m < 4; ++m)
#pragma unroll
            for (int n = 0; n < 4; ++n) acc[m][n] = f32x4{0.f, 0.f, 0.f, 0.f};
#pragma unroll 1
        for (int kt = 0; kt < nk; ++kt) {
            const u16* Ab = As + kt * G_AS + (wm * 64 + fr) * GLD + fq * 8; const u16* Bb = Bs + kt * G_BS + (wn * 64 + fr) * GLD + fq * 8;
#pragma unroll
            for (int ks = 0; ks < 2; ++ks) {
                bf16x8 af[4], bfr[4];
#pragma unroll
                for (int m = 0; m < 4; ++m) af[m] = *(const bf16x8*)(Ab + m * 16 * GLD + ks * 32);
#pragma unroll
                for (int n = 0; n < 4; ++n) bfr[n] = *(const bf16x8*)(Bb + n * 16 * GLD + ks * 32);
#pragma unroll
                for (int m = 0; m < 4; ++m)
#pragma unroll
                    for (int n = 0; n < 4; ++n)
                        acc[m][n] = TR ? __builtin_amdgcn_mfma_f32_16x16x32_bf16(bfr[n], af[m], acc[m][n], 0, 0, 0) : __builtin_amdgcn_mfma_f32_16x16x32_bf16(af[m], bfr[n], acc[m][n], 0, 0, 0);
            }
        }
        epi(id, acc);
        __syncthreads();
    }
#undef SK_LD
#undef SK_ST
}

struct RowLoad {
    const u16* base; size_t ld;
    __device__ __forceinline__ uint4 operator()(int, int row, int k) const { return *(const uint4*)(base + (size_t)row * ld + k); }
};

#define EPI_LOOP(...) \
    { const int tid_ = tid_opaque(); const int lane_ = tid_ & 63, wid_ = tid_ >> 6; const int wm_ = wid_ >> 1, wn_ = wid_ & 1, fr_ = lane_ & 15, fq_ = lane_ >> 4; \
      _Pragma("unroll") for (int m = 0; m < 4; ++m) _Pragma("unroll") for (int n = 0; n < 4; ++n) _Pragma("unroll") for (int j = 0; j < 4; ++j) { \
          const int r = wm_ * 64 + m * 16 + fq_ * 4 + j; const int c = wn_ * 64 + n * 16 + fr_; const float v = acc[m][n][j]; __VA_ARGS__ } }

#define EPI_T(...) \
    { const int tid_ = tid_opaque(); const int lane_ = tid_ & 63, wid_ = tid_ >> 6; const int wm_ = wid_ >> 1, wn_ = wid_ & 1, fr_ = lane_ & 15, fq_ = lane_ >> 4; \
      _Pragma("unroll") for (int m = 0; m < 4; ++m) _Pragma("unroll") for (int n = 0; n < 4; ++n) { \
          const int r = wm_ * 64 + m * 16 + fr_; const int c0 = wn_ * 64 + n * 16 + fq_ * 4; const f32x4 v = acc[m][n]; __VA_ARGS__ } }
__device__ __forceinline__ uint2 pack4(const f32x4 v) { return make_uint2(pack2(v[0], v[1]), pack2(v[2], v[3])); }

__device__ __forceinline__ void conv_wave(const float* __restrict__ src, int K, int N, int f0, u16* __restrict__ dst, int ldd, int mapkind, int lane, float* tile) {
    const float* s = src + f0 + lane;
    for (int k0 = 0; k0 < K; k0 += 64) {
#pragma unroll 16
        for (int r = 0; r < 64; ++r) tile[r * 65 + lane] = s[(size_t)(k0 + r) * N];
        asm volatile("s_waitcnt lgkmcnt(0)" ::: "memory");
#pragma unroll 2
        for (int c = 0; c < 8; ++c) {
            const int id = c * 64 + lane, fl = id >> 3, kc = id & 7;
            float v[8];
#pragma unroll
            for (int e = 0; e < 8; ++e) v[e] = tile[(kc * 8 + e) * 65 + fl];
            const int f = f0 + fl;
            int r = f;
            if (mapkind != 0) r = ((f >> 7) * 256) + (f & 127) + (mapkind == 2 ? 128 : 0);
            uint4 o; o.x = pack2(v[0], v[1]); o.y = pack2(v[2], v[3]); o.z = pack2(v[4], v[5]); o.w = pack2(v[6], v[7]);
            *(uint4*)(dst + (size_t)r * ldd + k0 + kc * 8) = o;
        }
        asm volatile("s_waitcnt lgkmcnt(0)" ::: "memory");
    }
}

__device__ __forceinline__ void phase_prologue_a(const PP p, char* smem) {
    const int t = tid_opaque(), lane = t & 63, wid = t >> 6;
    float* cs = (float*)smem;
    float* red = cs + 2048;
    for (int i = t; i < 2048; i += NTHR) { const float c = p.in(1)[i]; cs[i] = c / (1.0f + __expf(-c)); }
    __syncthreads();
    float* ada = (float*)(p.ws() + OFF_ADA);
    for (int item = blockIdx.x; item < 192; item += gridDim.x) {
        const int l = item / 48, cg = item % 48, cl = t & 127, kc = t >> 7;
        const int col = cg * 128 + cl;
        const float* w = p.in(2) + (size_t)l * 1024 * 6144 + col;
        float a0 = 0.f, a1 = 0.f;
#pragma unroll 8
        for (int k = kc * 256; k < kc * 256 + 256; ++k) { const float wv = w[(size_t)k * 6144]; a0 += cs[k] * wv; a1 += cs[1024 + k] * wv; }
        red[(kc * 128 + cl) * 2 + 0] = a0; red[(kc * 128 + cl) * 2 + 1] = a1;
        __syncthreads();
        if (t < 256) {
            const int b = t >> 7, c2 = t & 127;
            float s = 0.f;
            for (int q = 0; q < 4; ++q) s += red[(q * 128 + c2) * 2 + b];
            ada[(size_t)(l * 2 + b) * 6144 + cg * 128 + c2] = s + p.in(3)[(size_t)l * 6144 + cg * 128 + c2];
        }
        __syncthreads();
    }
    const int gw = blockIdx.x * 8 + wid, gstride = gridDim.x * 8;
    float* tile = (float*)smem + wid * (64 * 65);
    u16* WGU = (u16*)(p.ws() + OFF_WGU); u16* WD = (u16*)(p.ws() + OFF_WD);
    for (int w = gw; w < 256; w += gstride) {
        u16* d = WGU + (size_t)(w >> 1) * 1536 * 1024 + (size_t)(5 * 256 + (w & 1) * 128 + 64) * 1024;
        for (int q = lane; q < 64 * 1024 / 8; q += 64) *(uint4*)(d + (size_t)q * 8) = make_uint4(0u, 0u, 0u, 0u);
    }
    for (int w = gw; w < 5340; w += gstride) {
        if (w < 1408) { const int j = w / 11, g = w % 11; conv_wave(p.in(8) + (size_t)j * 1024 * 704, 1024, 704, g * 64, WGU + (size_t)j * 1536 * 1024, 1024, 1, lane, tile); }
        else if (w < 2816) { const int w2 = w - 1408; const int j = w2 / 11, g = w2 % 11; conv_wave(p.in(9) + (size_t)j * 1024 * 704, 1024, 704, g * 64, WGU + (size_t)j * 1536 * 1024, 1024, 2, lane, tile); }
        else if (w < 4864) { const int w2 = w - 2816; const int j = w2 >> 4, g = w2 & 15; conv_wave(p.in(10) + (size_t)j * 704 * 1024, 704, 1024, g * 64, WD + (size_t)j * 1024 * 704, 704, 0, lane, tile); }
        else {
            int w2 = w - 4864;
            if (w2 < 108) { const int j = w2 / 54, g = w2 % 54; conv_wave(p.in(11) + (size_t)j * 1024 * ABP, 1024, ABP, g * 64, (u16*)(p.ws() + OFF_WINE) + (size_t)j * 3584 * 1024, 1024, 0, lane, tile); continue; }
            w2 -= 108;
            if (w2 < 32) { const int j = w2 >> 4, g = w2 & 15; conv_wave(p.in(12) + (size_t)j * 1024 * 1024, 1024, 1024, g * 64, (u16*)(p.ws() + OFF_WOUTE) + (size_t)j * 1024 * 1024, 1024, 0, lane, tile); continue; }
            w2 -= 32;
            if (w2 < 96) { const int j = w2 / 48, g = w2 % 48; conv_wave(p.in(25) + (size_t)j * 1024 * 3072, 1024, 3072, g * 64, (u16*)(p.ws() + OFF_WINH) + (size_t)j * 3072 * 1024, 1024, 0, lane, tile); continue; }
            w2 -= 96;
            if (w2 < 32) { const int j = w2 >> 4, g = w2 & 15; conv_wave(p.in(37) + (size_t)j * 1024 * 1024, 1024, 1024, g * 64, (u16*)(p.ws() + OFF_WOUTH) + (size_t)j * 1024 * 1024, 1024, 0, lane, tile); continue; }
            w2 -= 32;
            if (w2 < 32) { const int j = w2 >> 3, g = w2 & 7; conv_wave(p.in(16) + (size_t)j * 64 * 512, 64, 512, g * 64, (u16*)(p.ws() + OFF_WUP) + (size_t)j * 512 * 64, 64, 0, lane, tile); continue; }
            w2 -= 32;
            if (w2 < 32) { const int j = w2 >> 3, g = w2 & 7; conv_wave(p.in(18) + (size_t)j * 64 * 512, 64, 512, g * 64, (u16*)(p.ws() + OFF_AUP) + (size_t)j * 512 * 64, 64, 0, lane, tile); continue; }
            w2 -= 32;
            if (w2 < 16) { const int j = w2 >> 3, g = w2 & 7; conv_wave(p.in(19) + (size_t)j * 128 * 512, 128, 512, g * 64, (u16*)(p.ws() + OFF_GUP) + (size_t)j * 512 * 128, 128, 0, lane, tile); continue; }
            w2 -= 16;
            { const int j = w2 >> 6, g = w2 & 63; conv_wave(p.in(35) + (size_t)j * 64 * 4096, 64, 4096, g * 64, (u16*)(p.ws() + OFF_W4T) + (size_t)j * 4096 * 64, 64, 0, lane, tile); }
        }
    }
}

__device__ __forceinline__ void phase_prologue_b(const PP p) {
    const float* ada = (const float*)(p.ws() + OFF_ADA);
    const float4* xin = (const float4*)p.in(0);
    uint2* xo = (uint2*)((u16*)p.out() + (size_t)T_ * 1024);
    uint2* hb = (uint2*)(p.ws() + OFF_HBUF);
    const int gsz = gridDim.x * NTHR;
    const int t0_ = tid_opaque();
    const int idx0 = blockIdx.x * NTHR + t0_, c4 = (idx0 & 255) * 4;
    const float4 sh0 = *(const float4*)(ada + c4), sc0 = *(const float4*)(ada + 1024 + c4);
    const float4 sh1 = *(const float4*)(ada + 6144 + c4), sc1 = *(const float4*)(ada + 6144 + 1024 + c4);
#pragma unroll 1
    for (int base = idx0; base < T_ * 256; base += 8 * gsz) {
        float4 v[8];
#pragma unroll
        for (int j = 0; j < 8; ++j) { const int idx = min(base + j * gsz, T_ * 256 - 1); v[j] = xin[idx]; }
        __builtin_amdgcn_sched_barrier(0);
#pragma unroll
        for (int j = 0; j < 8; ++j) {
            const int idx = base + j * gsz;
            if (idx < T_ * 256) {
                const bool b1 = (idx >> 8) >= L_;
                const float4 sh = b1 ? sh1 : sh0, sc = b1 ? sc1 : sc0;
                xo[idx] = make_uint2(pack2(v[j].x, v[j].y), pack2(v[j].z, v[j].w));
                uint2 o;
                o.x = pack2(v[j].x * (1.f + sc.x) + sh.x, v[j].y * (1.f + sc.y) + sh.y);
                o.y = pack2(v[j].z * (1.f + sc.z) + sh.z, v[j].w * (1.f + sc.w) + sh.w);
                hb[idx] = o;
            }
        }
    }
}


__device__ __forceinline__ bool xcd_deal(int i, int U, int& id) {
    int G = gridDim.x; asm volatile("" : "+s"(G));
    int bx = blockIdx.x; asm volatile("" : "+s"(bx));
    if (G & 7) { id = bx + i * G; return id < U; }
    const int x = bx & 7, r = bx >> 3, nper = G >> 3;
    const int q = U >> 3, rem = U & 7;
    const int cnt = q + (x < rem ? 1 : 0), start = x * q + min(x, rem);
    const int j = r + i * nper;
    id = start + j;
    return j < cnt;
}
struct SchedGrid {
    const char* A; const char* B; int nunits, npn; size_t astep, bstep; int npm_cm = 0;
    __device__ __forceinline__ bool operator()(int i, g8::Unit& u) const {
        int id; if (!xcd_deal(i, nunits, id)) return false;
        if (npm_cm > 0) { u.pn = id / npm_cm; u.pm = id - u.pn * npm_cm; }
        else { u.pm = id / npn; u.pn = id - u.pm * npn; } u.a = A + (size_t)u.pm * astep; u.b = B + (size_t)u.pn * bstep; u.aux = 0; return true;
    }
};
struct EpiBf16Rows {
    u16* O; size_t ld; int ncols;
    __device__ __forceinline__ void operator()(const f32x4 (&acc)[2][2][4][2], const g8::Unit& u, int wr, int wc, int fr, int fq) const {
#pragma unroll
        for (int ai = 0; ai < 2; ++ai)
#pragma unroll
            for (int m = 0; m < 4; ++m) {
                const size_t row = (size_t)u.pm * 256 + ai * 128 + wr * 64 + m * 16 + fr;
#pragma unroll
                for (int bj = 0; bj < 2; ++bj) {
                    const int col = u.pn * 256 + bj * 128 + wc * 32 + fq * 8;
                    if (col < ncols) {
                        const f32x4 v0 = acc[ai][bj][m][0], v1 = acc[ai][bj][m][1];
                        *(uint4*)(O + row * ld + col) = make_uint4(pack2(v0[0], v0[1]), pack2(v0[2], v0[3]), pack2(v1[0], v1[1]), pack2(v1[2], v1[3]));
                    }
                }
            }
    }
};
__device__ __forceinline__ void phase_g1(const PP p, char* smem, int i) {
    SchedGrid S; S.A = p.ws() + OFF_HBUF; S.B = p.ws() + OFF_WINE + (size_t)i * 3584 * 1024 * 2; S.nunits = 128 * 14; S.npn = 14;
    S.astep = (size_t)256 * 1024 * 2; S.bstep = (size_t)256 * 1024 * 2;
    EpiBf16Rows E; E.O = (u16*)(p.ws() + OFF_P); E.ld = ABP; E.ncols = ABP;
    g8::gemm<true, false>((G8_LAS unsigned char*)smem, 1024, 1024, 1024, nullptr, S, E);
}

__device__ __forceinline__ void na_tr3(unsigned a0, unsigned a1, unsigned a2, uint2& r0, uint2& r1, uint2& r2) {
    asm volatile("ds_read_b64_tr_b16 %0, %3\n\tds_read_b64_tr_b16 %1, %4\n\tds_read_b64_tr_b16 %2, %5\n\ts_waitcnt lgkmcnt(0)"
                 : "=&v"(r0), "=&v"(r1), "=&v"(r2) : "v"(a0), "v"(a1), "v"(a2) : "memory");
}
__device__ __forceinline__ void phase_na(const PP p, char* smem, int i) {
    const int t_outer = tid_opaque(); int t = t_outer; const int lane = t & 63, h = t >> 6, fr = lane & 15, g = lane >> 4;
    const u16* pp = (const u16*)(p.ws() + OFF_P);
    u16* mix = (u16*)(p.ws() + OFF_MIX);
    u16* Ks = (u16*)smem;
    u16* Vs = Ks + 48 * 520;
    float* rpb = (float*)(smem + 2 * 48 * 520 * 2);
    __syncthreads();
    for (int idx = t; idx < 8 * 15 * 31; idx += NTHR) rpb[idx] = p.in(13)[(size_t)i * 3720 + idx];
    { unsigned z_ = 0u; asm volatile("" : "+v"(z_));
      for (int idx = t; idx < 2 * 8 * 65; idx += NTHR) { const int m = idx / 520, rr = (idx % 520) / 65, cch = idx % 65; *(uint4*)((m ? Vs : Ks) + (40 + rr) * 520 + cch * 8) = make_uint4(z_, z_, z_, z_); } }
    const unsigned vs_addr = (unsigned)(size_t)Vs;
    for (int k_ = 0, item = 0; xcd_deal(k_, 1024, item); ++k_) {
        const int b = item >> 9, gi = (item >> 1) & 255, hr = item & 1;
        const int kb = hr * 24;
        const int rs = min(max(gi - 4, 0), 248);
        bf16x8 qb[2][2];
        int jq[2], cs[2];
#pragma unroll
        for (int nt = 0; nt < 2; ++nt) {
            jq[nt] = hr * 32 + 16 * nt + fr; cs[nt] = min(max(jq[nt] - 8, 0), 48);
            const u16* qrow = pp + ((size_t)b * L_ + gi * 64 + jq[nt]) * ABP + h * 64 + 8 * g;
            qb[nt][0] = *(const bf16x8*)qrow; qb[nt][1] = *(const bf16x8*)(qrow + 32);
        }
        f32x4 oacc[4][2];
#pragma unroll
        for (int dt = 0; dt < 4; ++dt)
#pragma unroll
            for (int nt = 0; nt < 2; ++nt) oacc[dt][nt] = f32x4{0.f, 0.f, 0.f, 0.f};
        float m_run[2] = {-1e30f, -1e30f}, l_run[2] = {0.f, 0.f};
        uint4 g0, g1, g2, g3, g4, g5, g6, g7, g8, g9;
#define NA_SRC(X, RR) (pp + ((size_t)b * L_ + (rs + (RR)) * 64 + kb + (((t + NTHR * (X)) - ((t + NTHR * (X)) >= 2560 ? 2560 : 0)) >> 6)) * ABP + 512 + ((t + NTHR * (X)) >= 2560 ? 512 : 0) + ((t + NTHR * (X)) & 63) * 8)
#define NA_DST(X) (((t + NTHR * (X)) >= 2560 ? Vs : Ks) + (((t + NTHR * (X)) - ((t + NTHR * (X)) >= 2560 ? 2560 : 0)) >> 6) * 520 + ((t + NTHR * (X)) & 63) * 8)
#define NA_LOAD(RR) { g0 = *(const uint4*)NA_SRC(0, RR); g1 = *(const uint4*)NA_SRC(1, RR); g2 = *(const uint4*)NA_SRC(2, RR); g3 = *(const uint4*)NA_SRC(3, RR); g4 = *(const uint4*)NA_SRC(4, RR); \
                      g5 = *(const uint4*)NA_SRC(5, RR); g6 = *(const uint4*)NA_SRC(6, RR); g7 = *(const uint4*)NA_SRC(7, RR); g8 = *(const uint4*)NA_SRC(8, RR); g9 = *(const uint4*)NA_SRC(9, RR); }
        NA_LOAD(0)
#pragma unroll 1
        for (int r = 0; r < 8; ++r) {
            t = t_outer; asm volatile("" : "+v"(t));
            __syncthreads();
            *(uint4*)NA_DST(0) = g0; *(uint4*)NA_DST(1) = g1; *(uint4*)NA_DST(2) = g2; *(uint4*)NA_DST(3) = g3; *(uint4*)NA_DST(4) = g4;
            *(uint4*)NA_DST(5) = g5; *(uint4*)NA_DST(6) = g6; *(uint4*)NA_DST(7) = g7; *(uint4*)NA_DST(8) = g8; *(uint4*)NA_DST(9) = g9;
            __syncthreads();
            if (r + 1 < 8) NA_LOAD(r + 1)
            f32x4 st[3][2];
#pragma unroll
            for (int mt = 0; mt < 3; ++mt) {
                st[mt][0] = f32x4{0.f, 0.f, 0.f, 0.f}; st[mt][1] = f32x4{0.f, 0.f, 0.f, 0.f};
#pragma unroll
                for (int s = 0; s < 2; ++s) {
                    const bf16x8 ka = *(const bf16x8*)(Ks + (16 * mt + fr) * 520 + h * 64 + 32 * s + 8 * g);
                    st[mt][0] = __builtin_amdgcn_mfma_f32_16x16x32_bf16(ka, qb[0][s], st[mt][0], 0, 0, 0);
                    st[mt][1] = __builtin_amdgcn_mfma_f32_16x16x32_bf16(ka, qb[1][s], st[mt][1], 0, 0, 0);
                }
            }
            const float* brow = rpb + (h * 15 + (rs + r - gi + 7)) * 31;
            bf16x8 pb[2][2];
#pragma unroll
            for (int nt = 0; nt < 2; ++nt) {
                float mx = -1e30f;
#pragma unroll
                for (int mt = 0; mt < 3; ++mt)
#pragma unroll
                    for (int jj = 0; jj < 4; ++jj) {
                        const int kc = kb + 16 * mt + 4 * g + jj;
                        const bool valid = (kc >= cs[nt]) && (kc < cs[nt] + 16) && (16 * mt + 4 * g + jj < 40);
                        const int bi = min(max(kc - jq[nt] + 15, 0), 30);
                        const float sv = valid ? (st[mt][nt][jj] * 0.125f + brow[bi]) : -1e30f;
                        st[mt][nt][jj] = sv; mx = fmaxf(mx, sv);
                    }
                mx = fmaxf(mx, __shfl_xor(mx, 16)); mx = fmaxf(mx, __shfl_xor(mx, 32));
                const float m_new = fmaxf(m_run[nt], mx);
                const float sc = __expf(m_run[nt] - m_new);
                m_run[nt] = m_new;
                float psum = 0.f;
#pragma unroll
                for (int mt = 0; mt < 3; ++mt)
#pragma unroll
                    for (int jj = 0; jj < 4; ++jj) { const float sv = st[mt][nt][jj]; const float pr = (sv > -1e29f) ? __expf(sv - m_new) : 0.f; st[mt][nt][jj] = pr; psum += pr; }
                psum += __shfl_xor(psum, 16); psum += __shfl_xor(psum, 32);
                l_run[nt] = l_run[nt] * sc + psum;
#pragma unroll
                for (int dt = 0; dt < 4; ++dt) oacc[dt][nt] *= sc;
                union { bf16x8 v; unsigned u[4]; } c0, c1;
                c0.u[0] = pack2(st[0][nt][0], st[0][nt][1]); c0.u[1] = pack2(st[0][nt][2], st[0][nt][3]);
                c0.u[2] = pack2(st[1][nt][0], st[1][nt][1]); c0.u[3] = pack2(st[1][nt][2], st[1][nt][3]);
                c1.u[0] = pack2(st[2][nt][0], st[2][nt][1]); c1.u[1] = pack2(st[2][nt][2], st[2][nt][3]); c1.u[2] = 0u; c1.u[3] = 0u;
                pb[nt][0] = c0.v; pb[nt][1] = c1.v;
            }
            {
                const int q4 = fr >> 2, p4 = fr & 3;
#pragma unroll
                for (int dt = 0; dt < 4; ++dt) {
                    const unsigned base = vs_addr + (unsigned)(((4 * g + q4) * 520 + h * 64 + 16 * dt + 4 * p4) * 2);
                    uint2 r0, r1, r2;
                    na_tr3(base, base + 16 * 520 * 2, base + 32 * 520 * 2, r0, r1, r2);
                    union { bf16x8 v; unsigned u[4]; } a0, a1;
                    a0.u[0] = r0.x; a0.u[1] = r0.y; a0.u[2] = r1.x; a0.u[3] = r1.y;
                    a1.u[0] = r2.x; a1.u[1] = r2.y; a1.u[2] = 0u; a1.u[3] = 0u;
#pragma unroll
                    for (int nt = 0; nt < 2; ++nt) {
                        oacc[dt][nt] = __builtin_amdgcn_mfma_f32_16x16x32_bf16(a0.v, pb[nt][0], oacc[dt][nt], 0, 0, 0);
                        oacc[dt][nt] = __builtin_amdgcn_mfma_f32_16x16x32_bf16(a1.v, pb[nt][1], oacc[dt][nt], 0, 0, 0);
                    }
                }
            }
        }
#undef NA_LOAD
#undef NA_SRC
#undef NA_DST
#pragma unroll
        for (int nt = 0; nt < 2; ++nt) {
            const float inv = 1.0f / l_run[nt];
            u16* orow = mix + ((size_t)b * L_ + gi * 64 + jq[nt]) * 1024 + h * 64 + 4 * g;
#pragma unroll
            for (int dt = 0; dt < 4; ++dt)
                *(uint2*)(orow + 16 * dt) = make_uint2(pack2(oacc[dt][nt][0] * inv, oacc[dt][nt][1] * inv), pack2(oacc[dt][nt][2] * inv, oacc[dt][nt][3] * inv));
        }
    }
}

__device__ __forceinline__ void phase_rwprep(const PP p, int i) {
    const int t = tid_opaque(); const int lane = t & 63, wid = t >> 6;
    const u16* pp = (const u16*)(p.ws() + OFF_P);
    const float* mu = p.in(14) + (size_t)i * 2 * 1920;
    const float* kkw = p.in(20) + (size_t)i * 512;
    u16* R = (u16*)(p.ws() + RW_R); u16* V = (u16*)(p.ws() + RW_V); u16* KK = (u16*)(p.ws() + RW_KK);
    u16* KP = (u16*)(p.ws() + O_KP); u16* AWD = (u16*)(p.ws() + O_AWD); u16* AAD = (u16*)(p.ws() + O_AAD); u16* AGD = (u16*)(p.ws() + O_AGD);
    const int nw = gridDim.x * 8, per = (T_ + nw - 1) / nw;
    const int tok0 = (blockIdx.x * 8 + wid) * per, tok1 = min(tok0 + per, T_);
    if (tok0 >= tok1) return;
    float m0[30], m1[30];
#pragma unroll
    for (int ii = 0; ii < 30; ++ii) { m0[ii] = mu[lane + 64 * ii]; m1[ii] = mu[1920 + lane + 64 * ii]; }
    u16 rp[30], rc[30], rn[30];
    {
        const u16* cur = pp + (size_t)tok0 * ABP + 1536;
        const bool hasp = (tok0 & (L_ - 1)) > 0;
#pragma unroll
        for (int ii = 0; ii < 30; ++ii) { rc[ii] = cur[lane + 64 * ii]; rp[ii] = hasp ? cur[lane + 64 * ii - ABP] : (u16)0; }
    }
#pragma unroll 1
    for (int tok = tok0; tok < tok1; ++tok) {
        const int l = tok & (L_ - 1);
        const bool hasn = l < L_ - 1, hasp = l > 0;
        const u16* cur = pp + (size_t)tok * ABP + 1536;
        if (tok + 1 < T_) {
#pragma unroll
            for (int ii = 0; ii < 30; ++ii) rn[ii] = cur[lane + 64 * ii + ABP];
        }
#pragma unroll
        for (int ii = 0; ii < 30; ++ii) {
            const int col = lane + 64 * ii;
            const float c = bf2f(rc[ii]);
            const float pv = hasp ? bf2f(rp[ii]) : 0.f;
            const float nv = hasn ? bf2f(rn[ii]) : 0.f;
            const float x = c + m0[ii] * (pv - c) + m1[ii] * (nv - c);
            if (ii < 8) R[(size_t)tok * 512 + col] = f2bf(x);
            else if (ii < 16) {
                const int kc = col - 512;
                KP[(size_t)tok * 512 + kc] = f2bf(x);
                const float kv = x * kkw[kc];
                const float ss = wave_sum(kv * kv);
                KK[(size_t)tok * 512 + kc] = f2bf(kv * rsqrtf(ss + 1e-12f));
            }
            else if (ii < 24) V[(size_t)tok * 512 + col - 1024] = f2bf(x);
            else if (ii < 26) AWD[(size_t)tok * 128 + col - 1536] = f2bf(tanhf(x));
            else if (ii < 28) AAD[(size_t)tok * 128 + col - 1664] = f2bf(x);
            else AGD[(size_t)tok * 128 + col - 1792] = f2bf(sigmoidf_(x));
        }
#pragma unroll
        for (int ii = 0; ii < 30; ++ii) { rp[ii] = rc[ii]; rc[ii] = rn[ii]; }
    }
}

__device__ __forceinline__ void phase_lora(const PP p, char* smem, int i) {
    const u16* AWD = (const u16*)(p.ws() + O_AWD); const u16* AAD = (const u16*)(p.ws() + O_AAD); const u16* AGD = (const u16*)(p.ws() + O_AGD);
    const u16* KP = (const u16*)(p.ws() + O_KP); const u16* KK = (const u16*)(p.ws() + RW_KK);
    __half* Wb = (__half*)(p.ws() + RW_W); u16* KD = (u16*)(p.ws() + RW_KD); u16* BQ = (u16*)(p.ws() + RW_BQ); u16* G = (u16*)(p.ws() + RW_G);
    const u16* WUPp = (const u16*)(p.ws() + OFF_WUP); const u16* AUPp = (const u16*)(p.ws() + OFF_AUP); const u16* GUPp = (const u16*)(p.ws() + OFF_GUP);
    const float* w0b = p.in(15) + (size_t)i * 1024; const float* a0b = p.in(17) + (size_t)i * 1024; const float* ka = p.in(21) + (size_t)i * 512;
    auto dec = [&](int id) __attribute__((always_inline)) {
        const int sub = id >> 9, rem = id & 511, tm = rem >> 2, tn = rem & 3;
        SKTile tl;
        if (sub < 2)      { tl.A = AWD + (size_t)tm * 256 * 128 + sub * 64; tl.lda = 128; tl.B = WUPp + ((size_t)(i * 2 + sub) * 512 + tn * 128) * 64; tl.ldb = 64; tl.nk = 1; }
        else if (sub < 4) { tl.A = AAD + (size_t)tm * 256 * 128 + (sub - 2) * 64; tl.lda = 128; tl.B = AUPp + ((size_t)(i * 2 + sub - 2) * 512 + tn * 128) * 64; tl.ldb = 64; tl.nk = 1; }
        else              { tl.A = AGD + (size_t)tm * 256 * 128; tl.lda = 128; tl.B = GUPp + ((size_t)i * 512 + tn * 128) * 128; tl.ldb = 128; tl.nk = 2; }
        return tl;
    };
    auto epi = [&](int id, f32x4 (&acc)[4][4]) __attribute__((always_inline)) {
        const int sub = id >> 9, rem = id & 511, tm = rem >> 2, tn = rem & 3;
        const int tid_ = tid_opaque(); const int lane_ = tid_ & 63, wid_ = tid_ >> 6; const int wm_ = wid_ >> 1, wn_ = wid_ & 1, fr_ = lane_ & 15, fq_ = lane_ >> 4;
        if (sub < 2) {
            const int d = sub; const float* w0 = w0b + d * 512;
            float4 w0v[4];
#pragma unroll
            for (int n = 0; n < 4; ++n) w0v[n] = *(const float4*)(w0 + tn * 128 + wn_ * 64 + n * 16 + fq_ * 4);
            __builtin_amdgcn_sched_barrier(0);
#pragma unroll
            for (int m = 0; m < 4; ++m)
#pragma unroll
                for (int n = 0; n < 4; ++n) {
                    const int col = tn * 128 + wn_ * 64 + n * 16 + fq_ * 4; const size_t tok = (size_t)tm * 256 + wm_ * 64 + m * 16 + fr_; const f32x4 v = acc[m][n];
                    const __half2 h0 = __floats2half2_rn(__expf(-0.606531f * sigmoidf_(w0v[n].x + v[0])), __expf(-0.606531f * sigmoidf_(w0v[n].y + v[1])));
                    const __half2 h1 = __floats2half2_rn(__expf(-0.606531f * sigmoidf_(w0v[n].z + v[2])), __expf(-0.606531f * sigmoidf_(w0v[n].w + v[3])));
                    uint2 o; o.x = *(const unsigned*)&h0; o.y = *(const unsigned*)&h1;
                    *(uint2*)(Wb + (tok * 2 + d) * 512 + col) = o;
                }
        } else if (sub < 4) {
            const int d = sub - 2; const float* a0 = a0b + d * 512;
            float4 a0v[4], kav[4];
#pragma unroll
            for (int n = 0; n < 4; ++n) { const int col = tn * 128 + wn_ * 64 + n * 16 + fq_ * 4; a0v[n] = *(const float4*)(a0 + col); kav[n] = *(const float4*)(ka + col); }
#pragma unroll
            for (int m = 0; m < 4; ++m) {
                const size_t tok = (size_t)tm * 256 + wm_ * 64 + m * 16 + fr_;
                uint2 kpu[4], kku[4];
#pragma unroll
                for (int n = 0; n < 4; ++n) { const int col = tn * 128 + wn_ * 64 + n * 16 + fq_ * 4; kpu[n] = *(const uint2*)(KP + tok * 512 + col); kku[n] = *(const uint2*)(KK + tok * 512 + col); }
                __builtin_amdgcn_sched_barrier(0);
#pragma unroll
                for (int n = 0; n < 4; ++n) {
                    const int col = tn * 128 + wn_ * 64 + n * 16 + fq_ * 4; const f32x4 v = acc[m][n];
                    const float i0 = sigmoidf_(a0v[n].x + v[0]), i1 = sigmoidf_(a0v[n].y + v[1]), i2 = sigmoidf_(a0v[n].z + v[2]), i3 = sigmoidf_(a0v[n].w + v[3]);
                    uint2 okd, obq;
                    okd.x = pack2(lo2f(kpu[n].x) * (1.0f + (i0 - 1.0f) * kav[n].x), hi2f(kpu[n].x) * (1.0f + (i1 - 1.0f) * kav[n].y));
                    okd.y = pack2(lo2f(kpu[n].y) * (1.0f + (i2 - 1.0f) * kav[n].z), hi2f(kpu[n].y) * (1.0f + (i3 - 1.0f) * kav[n].w));
                    obq.x = pack2(lo2f(kku[n].x) * i0, hi2f(kku[n].x) * i1); obq.y = pack2(lo2f(kku[n].y) * i2, hi2f(kku[n].y) * i3);
                    *(uint2*)(KD + (tok * 2 + d) * 512 + col) = okd; *(uint2*)(BQ + (tok * 2 + d) * 512 + col) = obq;
                }
            }
        } else {
            EPI_T( *(uint2*)(G + ((size_t)tm * 256 + r) * 512 + tn * 128 + c0) = pack4(v); )
        }
    };
    gemm_smallk_loop<true>((u16*)smem, 2560, dec, epi);
}

constexpr size_t SC_PM = OFF_P;
constexpr size_t SC_OM = OFF_P + ((size_t)64 << 20);
constexpr size_t SC_QM = OFF_P + ((size_t)128 << 20);
constexpr size_t SC_OL = OFF_HBUF;
constexpr size_t SC_PG = OFF_P + ((size_t)192 << 20);
constexpr size_t SC_QG = SC_PG + ((size_t)4 << 20);
__device__ __forceinline__ int kpos(int kp) { const int kk = kp & 31; return (kp & 32) + ((kk & 15) >> 2) * 8 + (kk >> 4) * 4 + (kk & 3); }
__device__ __forceinline__ f32x4 mm64(const u16* A, const u16* Bt, int m, int n, int fr, int fq, f32x4 acc) {
#pragma unroll
    for (int s2 = 0; s2 < 2; ++s2) {
        const bf16x8 af = *(const bf16x8*)(A + (m * 16 + fr) * 72 + s2 * 32 + fq * 8);
        const bf16x8 bf = *(const bf16x8*)(Bt + (n * 16 + fr) * 72 + s2 * 32 + fq * 8);
        acc = __builtin_amdgcn_mfma_f32_16x16x32_bf16(af, bf, acc, 0, 0, 0);
    }
    return acc;
}
__device__ __forceinline__ void mm64x4(const u16* A, const u16* Bt, int m, int fr, int fq, f32x4 (&acc)[4]) {
    bf16x8 af[2], bf[4][2];
#pragma unroll
    for (int s2 = 0; s2 < 2; ++s2) af[s2] = *(const bf16x8*)(A + (m * 16 + fr) * 72 + s2 * 32 + fq * 8);
#pragma unroll
    for (int n = 0; n < 4; ++n)
#pragma unroll
        for (int s2 = 0; s2 < 2; ++s2) bf[n][s2] = *(const bf16x8*)(Bt + (n * 16 + fr) * 72 + s2 * 32 + fq * 8);
    __builtin_amdgcn_sched_barrier(0);
#pragma unroll
    for (int s2 = 0; s2 < 2; ++s2)
#pragma unroll
        for (int n = 0; n < 4; ++n) acc[n] = __builtin_amdgcn_mfma_f32_16x16x32_bf16(af[s2], bf[n][s2], acc[n], 0, 0, 0);
}
__device__ __forceinline__ float dpp_xor1(float v) { return __int_as_float(__builtin_amdgcn_update_dpp(0, __float_as_int(v), 0xB1, 0xf, 0xf, false)); }
__device__ __forceinline__ float dpp_xor2(float v) { return __int_as_float(__builtin_amdgcn_update_dpp(0, __float_as_int(v), 0x4E, 0xf, 0xf, false)); }
__device__ __forceinline__ float dpp_hmir(float v) { return __int_as_float(__builtin_amdgcn_update_dpp(0, __float_as_int(v), 0x141, 0xf, 0xf, false)); }
__device__ __forceinline__ void unpack8(const uint4 u, float (&o)[8]) {
    o[0] = lo2f(u.x); o[1] = hi2f(u.x); o[2] = lo2f(u.y); o[3] = hi2f(u.y); o[4] = lo2f(u.z); o[5] = hi2f(u.z); o[6] = lo2f(u.w); o[7] = hi2f(u.w);
}
__device__ __forceinline__ void phase_scanA(const PP p, char* smem) {
    const int t0 = tid_opaque();
    u16* M = (u16*)smem;
#define MX(idx) (M + (idx) * 4608)
    float* ABF = (float*)(smem + 13 * 9216);
    u16* M13 = (u16*)ABF; u16* M14 = M13 + 4608;
    float* GC = (float*)(smem + 138240);
    float* SEG = GC + 64;
    const __half* Wb = (const __half*)(p.ws() + RW_W);
    const u16* KK = (const u16*)(p.ws() + RW_KK); const u16* BQ = (const u16*)(p.ws() + RW_BQ); const u16* KD = (const u16*)(p.ws() + RW_KD);
    const u16* R = (const u16*)(p.ws() + RW_R); const u16* V = (const u16*)(p.ws() + RW_V);
    u16* PM = (u16*)(p.ws() + SC_PM); u16* OM = (u16*)(p.ws() + SC_OM); u16* QM = (u16*)(p.ws() + SC_QM); u16* OL = (u16*)(p.ws() + SC_OL);
    uint4 wraw, ukk, ubq, ukd, ur, uv;
#define SA_LOAD(ITEM) { const int ch_ = (ITEM) >> 8, ck_ = (ITEM) & 255; const int d_ = ch_ >> 4, b_ = (ch_ >> 3) & 1, h_ = ch_ & 7; \
        const int li_ = t0 >> 3, lk_ = (t0 & 7) * 8; const int tt_ = d_ ? (L_ - 1 - (ck_ * 64 + li_)) : (ck_ * 64 + li_); const size_t tk_ = (size_t)b_ * L_ + tt_; \
        const size_t g1_ = tk_ * 512 + h_ * 64 + lk_, g2_ = (tk_ * 2 + d_) * 512 + h_ * 64 + lk_; \
        wraw = *(const uint4*)(Wb + g2_); ukk = *(const uint4*)(KK + g1_); ubq = *(const uint4*)(BQ + g2_); ukd = *(const uint4*)(KD + g2_); ur = *(const uint4*)(R + g1_); uv = *(const uint4*)(V + g1_); }
    if ((int)blockIdx.x < 8192) SA_LOAD(blockIdx.x)
#pragma unroll 1
    for (int item = blockIdx.x; item < 8192; item += gridDim.x) {
        const int chain = item >> 8, chunk = item & 255;
        const int d = chain >> 4, b = (chain >> 3) & 1, h = chain & 7;
        int t = t0; asm volatile("" : "+v"(t));
        const int lane = t & 63, wid = t >> 6, fr = lane & 15, fq = lane >> 4;
        const int li = t >> 3, lk0 = (t & 7) * 8;
        __syncthreads();
        {
            const __half2* hp = (const __half2*)&wraw;
            const float2 w0 = __half22float2(hp[0]), w1 = __half22float2(hp[1]), w2 = __half22float2(hp[2]), w3 = __half22float2(hp[3]);
            *(float4*)(ABF + li * 72 + lk0) = make_float4(w0.x, w0.y, w1.x, w1.y);
            *(float4*)(ABF + li * 72 + lk0 + 4) = make_float4(w2.x, w2.y, w3.x, w3.y);
        }
        __syncthreads();
        {
            const int k = t & 63, seg = t >> 6;
            float pr = 1.f;
#pragma unroll
            for (int x = 0; x < 8; ++x) { pr *= ABF[(seg * 8 + x) * 72 + k]; ABF[(seg * 8 + x) * 72 + k] = pr; }
            SEG[seg * 64 + k] = pr;
            __syncthreads();
            float pre = 1.f;
#pragma unroll
            for (int s2 = 0; s2 < 7; ++s2) if (s2 < seg) pre *= SEG[s2 * 64 + k];
#pragma unroll
            for (int x = 0; x < 8; ++x) ABF[(seg * 8 + x) * 72 + k] *= pre;
            if (seg == 7) GC[k] = ABF[63 * 72 + k];
        }
        __syncthreads();
        {
            float G[8], Gm[8], fa[8], fb[8], fk[8], frr[8];
            *(float4*)&G[0] = *(const float4*)(ABF + li * 72 + lk0); *(float4*)&G[4] = *(const float4*)(ABF + li * 72 + lk0 + 4);
            if (li > 0) { *(float4*)&Gm[0] = *(const float4*)(ABF + (li - 1) * 72 + lk0); *(float4*)&Gm[4] = *(const float4*)(ABF + (li - 1) * 72 + lk0 + 4); }
            else {
#pragma unroll
                for (int e = 0; e < 8; ++e) Gm[e] = 1.f;
            }
            unpack8(ukk, fa); unpack8(ubq, fb); unpack8(ukd, fk); unpack8(ur, frr);
            unsigned pa[4], pb[4], pk[4], prr[4];
#pragma unroll
            for (int e = 0; e < 8; e += 2) {
                const float r0 = __builtin_amdgcn_rcpf(G[e]), r1 = __builtin_amdgcn_rcpf(G[e + 1]);
                pa[e >> 1] = pack2(-fa[e] * Gm[e], -fa[e + 1] * Gm[e + 1]);
                pb[e >> 1] = pack2(fb[e] * r0, fb[e + 1] * r1);
                pk[e >> 1] = pack2(fk[e] * r0, fk[e + 1] * r1);
                prr[e >> 1] = pack2(frr[e] * G[e], frr[e + 1] * G[e + 1]);
            }
            *(uint4*)(MX(0) + li * 72 + lk0) = make_uint4(pa[0], pa[1], pa[2], pa[3]);
            *(uint4*)(MX(2) + li * 72 + lk0) = make_uint4(pb[0], pb[1], pb[2], pb[3]);
            *(uint4*)(MX(4) + li * 72 + lk0) = make_uint4(pk[0], pk[1], pk[2], pk[3]);
            *(uint4*)(MX(6) + li * 72 + lk0) = make_uint4(prr[0], prr[1], prr[2], prr[3]);
            *(uint4*)(MX(8) + li * 72 + lk0) = uv;
        }
        __syncthreads();
        {
            const int k = t & 63, i0 = (t >> 6) * 8;
#pragma unroll
            for (int mtx = 0; mtx < 4; ++mtx) {
                const u16* src = (mtx == 0) ? MX(0) : (mtx == 1) ? MX(2) : (mtx == 2) ? MX(4) : MX(8);
                u16* dst = (mtx == 0) ? MX(1) : (mtx == 1) ? MX(3) : (mtx == 2) ? MX(5) : MX(7);
                unsigned w[4];
#pragma unroll
                for (int e = 0; e < 4; ++e) w[e] = (unsigned)src[(i0 + 2 * e) * 72 + k] | ((unsigned)src[(i0 + 2 * e + 1) * 72 + k] << 16);
                *(uint4*)(dst + k * 72 + i0) = make_uint4(w[0], w[1], w[2], w[3]);
            }
        }
        if (item + (int)gridDim.x < 8192) SA_LOAD(item + gridDim.x)
        __syncthreads();
#pragma unroll
        for (int x = 0; x < 2; ++x) {
            const int pm = wid * 2 + x, prod = pm >> 2, m = pm & 3;
            const u16* A = (prod < 2) ? MX(0) : MX(6);
            const u16* Bt = (prod & 1) ? MX(4) : MX(2);
            f32x4 acc4[4] = {f32x4{0.f, 0.f, 0.f, 0.f}, f32x4{0.f, 0.f, 0.f, 0.f}, f32x4{0.f, 0.f, 0.f, 0.f}, f32x4{0.f, 0.f, 0.f, 0.f}};
            mm64x4(A, Bt, m, fr, fq, acc4);
#pragma unroll
            for (int n = 0; n < 4; ++n) {
                const f32x4 acc = acc4[n];
#pragma unroll
                for (int j = 0; j < 4; ++j) {
                    const int i = 16 * m + 4 * fq + j, jc = 16 * n + fr;
                    const bool keep = (prod < 2) ? (jc < i) : (jc <= i);
                    const float val = keep ? acc[j] : 0.f;
                    if (prod == 0) ABF[i * 72 + jc] = val;
                    else MX(7 + prod)[i * 72 + jc] = f2bf(val);
                }
            }
        }
        __syncthreads();
        {
            const int c = 8 * wid + (lane >> 3), jg = lane & 7;
            float Tl[8];
#pragma unroll
            for (int e = 0; e < 8; ++e) Tl[e] = 0.f;
            float4 ra[8][2];
#pragma unroll
            for (int ii = 0; ii < 8; ++ii) { ra[ii][0] = *(const float4*)(ABF + ii * 72 + 8 * jg); ra[ii][1] = *(const float4*)(ABF + ii * 72 + 8 * jg + 4); }
#pragma unroll
            for (int ib = 0; ib < 8; ++ib) {
                float4 rn[8][2];
#pragma unroll
                for (int ii = 0; ii < 8; ++ii) {
                    const int i2 = (ib < 7) ? (8 * (ib + 1) + ii) : ii;
                    rn[ii][0] = *(const float4*)(ABF + i2 * 72 + 8 * jg); rn[ii][1] = *(const float4*)(ABF + i2 * 72 + 8 * jg + 4);
                }
                __builtin_amdgcn_sched_barrier(0);
#pragma unroll
                for (int ii = 0; ii < 8; ++ii) {
                    const int i = 8 * ib + ii;
                    const float4 a0 = ra[ii][0], a1 = ra[ii][1];
                    const float av[8] = {a0.x, a0.y, a0.z, a0.w, a1.x, a1.y, a1.z, a1.w};
                    const int es = (i + 7) & 7;
                    float p7 = (c == i && jg == 0) ? 1.f : 0.f;
#pragma unroll
                    for (int e = 0; e < 8; ++e) if (e != es) p7 += av[e] * Tl[e];
                    float part = p7 + av[es] * Tl[es];
                    part += dpp_xor1(part); part += dpp_xor2(part); part += dpp_hmir(part);
                    Tl[i & 7] = (jg == (i >> 3)) ? part : Tl[i & 7];
                }
                __builtin_amdgcn_sched_barrier(0);
#pragma unroll
                for (int ii = 0; ii < 8; ++ii) { ra[ii][0] = rn[ii][0]; ra[ii][1] = rn[ii][1]; }
            }
#pragma unroll
            for (int e = 0; e < 8; ++e) MX(11)[(8 * jg + e) * 72 + c] = f2bf(Tl[e]);
#pragma unroll
            for (int x = 0; x < 2; ++x) {
                const int id = wid * 2 + x, m = id >> 2, n = id & 3;
                const f32x4 acc = mm64(MX(8), MX(7), m, n, fr, fq, f32x4{0.f, 0.f, 0.f, 0.f});
                uint2 o; o.x = pack2(acc[0], acc[1]); o.y = pack2(acc[2], acc[3]);
                *(uint2*)(MX(12) + (16 * n + fr) * 72 + 16 * m + 4 * fq) = o;
            }
        }
        __syncthreads();
        {
            const int prod = wid >> 2, m = wid & 3;
            const u16* Bt = prod ? MX(1) : MX(12);
            u16* dst = prod ? M14 : M13;
            f32x4 acc4[4] = {f32x4{0.f, 0.f, 0.f, 0.f}, f32x4{0.f, 0.f, 0.f, 0.f}, f32x4{0.f, 0.f, 0.f, 0.f}, f32x4{0.f, 0.f, 0.f, 0.f}};
            mm64x4(MX(11), Bt, m, fr, fq, acc4);
#pragma unroll
            for (int n = 0; n < 4; ++n) {
                const f32x4 acc = acc4[n];
                uint2 o; o.x = pack2(acc[0], acc[1]); o.y = pack2(acc[2], acc[3]);
                *(uint2*)(dst + (16 * n + fr) * 72 + 16 * m + 4 * fq) = o;
            }
        }
        __syncthreads();
        {
            const int mat = wid >> 1;
            u16* SA = MX(8); u16* SB = MX(1);
#pragma unroll
            for (int mm = 0; mm < 2; ++mm) {
                const int m = (wid & 1) * 2 + mm;
                f32x4 acc4[4] = {f32x4{0.f, 0.f, 0.f, 0.f}, f32x4{0.f, 0.f, 0.f, 0.f}, f32x4{0.f, 0.f, 0.f, 0.f}, f32x4{0.f, 0.f, 0.f, 0.f}};
                if (mat == 0) {
                    mm64x4(MX(9), M14, m, fr, fq, acc4);
#pragma unroll
                    for (int n = 0; n < 4; ++n)
#pragma unroll
                        for (int j = 0; j < 4; ++j) {
                            const int i = 16 * m + 4 * fq + j, kp = 16 * n + fr;
                            SA[i * 64 + kpos(kp)] = f2bf(acc4[n][j] + bf2f(MX(6)[i * 72 + kp]));
                        }
                } else if (mat == 1) {
                    mm64x4(MX(9), M13, m, fr, fq, acc4);
                    mm64x4(MX(10), MX(7), m, fr, fq, acc4);
#pragma unroll
                    for (int n = 0; n < 4; ++n) {
                        uint2 o; o.x = pack2(acc4[n][0], acc4[n][1]); o.y = pack2(acc4[n][2], acc4[n][3]);
                        *(uint2*)(OL + (((size_t)item * 4 + n) * 4 + m) * 256 + lane * 4) = o;
                    }
                } else if (mat == 2) {
                    mm64x4(MX(3), M14, m, fr, fq, acc4);
#pragma unroll
                    for (int n = 0; n < 4; ++n)
#pragma unroll
                        for (int j = 0; j < 4; ++j) {
                            const int k = 16 * m + 4 * fq + j, kp = 16 * n + fr;
                            SB[k * 64 + kpos(kp)] = f2bf((acc4[n][j] + ((k == kp) ? 1.f : 0.f)) * GC[k]);
                        }
                } else {
                    mm64x4(MX(3), M13, m, fr, fq, acc4);
                    mm64x4(MX(5), MX(7), m, fr, fq, acc4);
                    const int k0 = 16 * m + 4 * fq;
#pragma unroll
                    for (int n = 0; n < 4; ++n) {
                        uint2 o; o.x = pack2(acc4[n][0] * GC[k0], acc4[n][1] * GC[k0 + 1]); o.y = pack2(acc4[n][2] * GC[k0 + 2], acc4[n][3] * GC[k0 + 3]);
                        *(uint2*)(QM + (((size_t)item * 4 + n) * 4 + m) * 256 + lane * 4) = o;
                    }
                }
            }
            __syncthreads();
            *(uint4*)(OM + (size_t)item * 4096 + t * 8) = *(const uint4*)(SA + t * 8);
            *(uint4*)(PM + (size_t)item * 4096 + t * 8) = *(const uint4*)(SB + t * 8);
        }
    }
#undef MX
#undef SA_LOAD
}

struct StepRegs { bf16x8 pa[4][2]; uint2 qf[4]; };
__device__ __forceinline__ void sb_load(StepRegs& r, const u16* Pm, const u16* Qf, int fr, int fq, int lane) {
#pragma unroll
    for (int m = 0; m < 4; ++m) {
#pragma unroll
        for (int s2 = 0; s2 < 2; ++s2) r.pa[m][s2] = *(const bf16x8*)(Pm + (16 * m + fr) * 64 + 32 * s2 + 8 * fq);
        r.qf[m] = *(const uint2*)(Qf + m * 256 + lane * 4);
    }
}
__device__ __forceinline__ void sb_apply(const StepRegs& r, const bf16x8 (&sb)[2], f32x4 (&acc)[4]) {
#pragma unroll
    for (int m = 0; m < 4; ++m) acc[m] = f32x4{lo2f(r.qf[m].x), hi2f(r.qf[m].x), lo2f(r.qf[m].y), hi2f(r.qf[m].y)};
#pragma unroll
    for (int s2 = 0; s2 < 2; ++s2)
#pragma unroll
        for (int m = 0; m < 4; ++m) acc[m] = __builtin_amdgcn_mfma_f32_16x16x32_bf16(r.pa[m][s2], sb[s2], acc[m], 0, 0, 0);
}
__device__ __forceinline__ void sb_pack(const f32x4 (&acc)[4], bf16x8 (&sb)[2]) {
#pragma unroll
    for (int s2 = 0; s2 < 2; ++s2) {
        union { bf16x8 v; unsigned u[4]; } cv;
        cv.u[0] = pack2(acc[2 * s2][0], acc[2 * s2][1]); cv.u[1] = pack2(acc[2 * s2][2], acc[2 * s2][3]);
        cv.u[2] = pack2(acc[2 * s2 + 1][0], acc[2 * s2 + 1][1]); cv.u[3] = pack2(acc[2 * s2 + 1][2], acc[2 * s2 + 1][3]);
        sb[s2] = cv.v;
    }
}

__device__ __forceinline__ void phase_scanB1(const PP p) {
    const int t = tid_opaque(), lane = t & 63, wid = t >> 6, fr = lane & 15, fq = lane >> 4;
    const u16* PM = (const u16*)(p.ws() + SC_PM); const u16* QM = (const u16*)(p.ws() + SC_QM);
    u16* PG = (u16*)(p.ws() + SC_PG); u16* QG = (u16*)(p.ws() + SC_QG);
    const int ng = wid & 3;
    for (int seq = blockIdx.x * 2 + (wid >> 2); seq < 512; seq += gridDim.x * 2) {
        const int chain = seq >> 4, grp = seq & 15;
        const size_t item0 = (size_t)chain * 256 + grp * 16;
        bf16x8 pb[2], qb[2];
#pragma unroll
        for (int s2 = 0; s2 < 2; ++s2)
#pragma unroll
            for (int e = 0; e < 8; ++e) {
                const int kact = 32 * s2 + ((e < 4) ? (4 * fq + e) : (16 + 4 * fq + e - 4));
                pb[s2][e] = (kact == 16 * ng + fr) ? (short)0x3F80 : (short)0;
                qb[s2][e] = 0;
            }
        StepRegs ra, rb;
        sb_load(ra, PM + item0 * 4096, QM + ((item0 * 4 + ng) * 4) * 256, fr, fq, lane);
        sb_load(rb, PM + (item0 + 1) * 4096, QM + (((item0 + 1) * 4 + ng) * 4) * 256, fr, fq, lane);
#pragma unroll 1
        for (int c = 0; c < 16; c += 2) {
            f32x4 accP[4], accQ[4];
            {
                StepRegs z = ra;
#pragma unroll
                for (int m = 0; m < 4; ++m) z.qf[m] = make_uint2(0u, 0u);
                sb_apply(z, pb, accP); sb_apply(ra, qb, accQ);
                const size_t nx = item0 + ((c + 2 < 16) ? (c + 2) : c);
                sb_load(ra, PM + nx * 4096, QM + ((nx * 4 + ng) * 4) * 256, fr, fq, lane);
                sb_pack(accP, pb); sb_pack(accQ, qb);
            }
            {
                StepRegs z = rb;
#pragma unroll
                for (int m = 0; m < 4; ++m) z.qf[m] = make_uint2(0u, 0u);
                sb_apply(z, pb, accP); sb_apply(rb, qb, accQ);
                const size_t nx = item0 + ((c + 3 < 16) ? (c + 3) : (c + 1));
                sb_load(rb, PM + nx * 4096, QM + ((nx * 4 + ng) * 4) * 256, fr, fq, lane);
                if (c + 2 < 16) { sb_pack(accP, pb); sb_pack(accQ, qb); }
            }
            if (c + 2 >= 16) {
#pragma unroll
                for (int m = 0; m < 4; ++m) {
#pragma unroll
                    for (int j = 0; j < 4; ++j) PG[(size_t)seq * 4096 + (16 * m + 4 * fq + j) * 64 + kpos(16 * ng + fr)] = f2bf(accP[m][j]);
                    uint2 o; o.x = pack2(accQ[m][0], accQ[m][1]); o.y = pack2(accQ[m][2], accQ[m][3]);
                    *(uint2*)(QG + (((size_t)seq * 4 + ng) * 4 + m) * 256 + lane * 4) = o;
                }
            }
        }
    }
}

__device__ __forceinline__ void phase_scanB2(const PP p) {
    const int t = tid_opaque(), lane = t & 63, wid = t >> 6, fr = lane & 15, fq = lane >> 4;
    const u16* PM = (const u16*)(p.ws() + SC_PM); const u16* OM = (const u16*)(p.ws() + SC_OM);
    const u16* QM = (const u16*)(p.ws() + SC_QM); const u16* OL = (const u16*)(p.ws() + SC_OL);
    const u16* PG = (const u16*)(p.ws() + SC_PG); const u16* QG = (const u16*)(p.ws() + SC_QG);
    const int ng = wid & 3;
    for (int seq = blockIdx.x * 2 + (wid >> 2); seq < 512; seq += gridDim.x * 2) {
        const int chain = seq >> 4, grp = seq & 15;
        const int d = chain >> 4, b = (chain >> 3) & 1, h = chain & 7;
        float* O = (float*)(p.ws() + (d ? O_OB : O_OF));
        bf16x8 sb[2];
#pragma unroll
        for (int s2 = 0; s2 < 2; ++s2)
#pragma unroll
            for (int e = 0; e < 8; ++e) sb[s2][e] = 0;
#pragma unroll 1
        for (int g = 0; g < grp; ++g) {
            const size_t sq = (size_t)chain * 16 + g;
            StepRegs r; f32x4 acc[4];
            sb_load(r, PG + sq * 4096, QG + ((sq * 4 + ng) * 4) * 256, fr, fq, lane);
            sb_apply(r, sb, acc); sb_pack(acc, sb);
        }
        const size_t item0 = (size_t)chain * 256 + grp * 16;
        StepRegs sa, sa2, so;
        sb_load(sa, PM + item0 * 4096, QM + ((item0 * 4 + ng) * 4) * 256, fr, fq, lane);
        sb_load(so, OM + item0 * 4096, OL + ((item0 * 4 + ng) * 4) * 256, fr, fq, lane);
        sb_load(sa2, PM + (item0 + 1) * 4096, QM + (((item0 + 1) * 4 + ng) * 4) * 256, fr, fq, lane);
#pragma unroll 1
        for (int c = 0; c < 16; c += 2) {
#pragma unroll
            for (int u = 0; u < 2; ++u) {
                f32x4 accS[4], accO[4];
                StepRegs& ra = u ? sa2 : sa;
                sb_apply(so, sb, accO);
                {
                    const size_t nx = item0 + ((c + u + 1 < 16) ? (c + u + 1) : (c + u));
                    sb_load(so, OM + nx * 4096, OL + ((nx * 4 + ng) * 4) * 256, fr, fq, lane);
                }
                sb_apply(ra, sb, accS);
                {
                    const size_t nx = item0 + ((c + u + 2 < 16) ? (c + u + 2) : (c + u));
                    sb_load(ra, PM + nx * 4096, QM + ((nx * 4 + ng) * 4) * 256, fr, fq, lane);
                }
                const int cc = grp * 16 + c + u;
#pragma unroll
                for (int m = 0; m < 4; ++m)
#pragma unroll
                    for (int j = 0; j < 4; ++j) {
                        const int i = 16 * m + 4 * fq + j;
                        const int tt = d ? (L_ - 1 - (cc * 64 + i)) : (cc * 64 + i);
                        O[((size_t)b * L_ + tt) * 512 + h * 64 + 16 * ng + fr] = accO[m][j];
                    }
                sb_pack(accS, sb);
            }
        }
    }
}

__device__ __forceinline__ void phase_combine(const PP p, int i) {
    const int t = tid_opaque(); const int lane = t & 63, wid = t >> 6;
    const float* OF = (const float*)(p.ws() + O_OF); const float* OB = (const float*)(p.ws() + O_OB);
    const u16* R = (const u16*)(p.ws() + RW_R); const u16* V = (const u16*)(p.ws() + RW_V); const u16* KD = (const u16*)(p.ws() + RW_KD);
    const u16* G = (const u16*)(p.ws() + RW_G);
    const float* gngp = p.in(23) + (size_t)i * 512; const float* gnbp = p.in(24) + (size_t)i * 512; const float* rkp = p.in(22) + (size_t)i * 512;
    u16* mix = (u16*)(p.ws() + OFF_MIX);
    float gng[8], gnb[8], rk[8];
#pragma unroll
    for (int ii = 0; ii < 8; ++ii) { gng[ii] = gngp[lane + 64 * ii]; gnb[ii] = gnbp[lane + 64 * ii]; rk[ii] = rkp[lane + 64 * ii]; }
    const int tstride = gridDim.x * 8;
    int tok = blockIdx.x * 8 + wid;
    float of[8], ob[8]; u16 rr[8], k0[8], k1[8], vv[8], gg[8];
#define CB_LOAD(TK) { _Pragma("unroll") for (int ii = 0; ii < 8; ++ii) { const size_t g1 = (size_t)(TK) * 512 + lane + 64 * ii; \
        of[ii] = OF[g1]; ob[ii] = OB[g1]; rr[ii] = R[g1]; vv[ii] = V[g1]; gg[ii] = G[g1]; \
        k0[ii] = KD[((size_t)(TK) * 2) * 512 + lane + 64 * ii]; k1[ii] = KD[((size_t)(TK) * 2 + 1) * 512 + lane + 64 * ii]; } }
    if (tok < T_) CB_LOAD(tok)
#pragma unroll 1
    for (; tok < T_; tok += tstride) {
        float o[8], rf[8], ks[8], vf[8], gf[8];
#pragma unroll
        for (int ii = 0; ii < 8; ++ii) { o[ii] = of[ii] + ob[ii]; rf[ii] = bf2f(rr[ii]); ks[ii] = bf2f(k0[ii]) + bf2f(k1[ii]); vf[ii] = bf2f(vv[ii]); gf[ii] = bf2f(gg[ii]); }
        if (tok + tstride < T_) CB_LOAD(tok + tstride)
#pragma unroll
        for (int ii = 0; ii < 8; ++ii) {
            const int col = lane + 64 * ii;
            const float mean = wave_sum(o[ii]) * (1.0f / 64.0f);
            const float dv = o[ii] - mean;
            const float var = wave_sum(dv * dv) * (1.0f / 64.0f);
            const float nrm = dv * rsqrtf(var + 64e-5f) * gng[ii] + gnb[ii];
            const float bonus = wave_sum(rf[ii] * ks[ii] * rk[ii]);
            mix[(size_t)tok * 1024 + 512 + col] = f2bf((nrm + bonus * vf[ii]) * gf[ii]);
        }
    }
#undef CB_LOAD
}

struct EpiResid {
    u16* xo; const float* ada;
    __device__ __forceinline__ void operator()(const f32x4 (&acc)[2][2][4][2], const g8::Unit& u, int wr, int wc, int fr, int fq) const {
        const float* g1 = ada + (u.pm >> 6) * 6144 + 2048;
        float4 gv[2][2];
#pragma unroll
        for (int bj = 0; bj < 2; ++bj)
#pragma unroll
            for (int n = 0; n < 2; ++n) gv[bj][n] = *(const float4*)(g1 + u.pn * 256 + bj * 128 + wc * 32 + n * 16 + fq * 4);
#pragma unroll
        for (int ai = 0; ai < 2; ++ai) {
            uint2 xq[4][2][2];
#pragma unroll
            for (int m = 0; m < 4; ++m) {
                const size_t row = (size_t)u.pm * 256 + ai * 128 + wr * 64 + m * 16 + fr;
#pragma unroll
                for (int bj = 0; bj < 2; ++bj)
#pragma unroll
                    for (int n = 0; n < 2; ++n) xq[m][bj][n] = *(const uint2*)(xo + row * 1024 + u.pn * 256 + bj * 128 + wc * 32 + n * 16 + fq * 4);
            }
            __builtin_amdgcn_sched_barrier(0);
#pragma unroll
            for (int m = 0; m < 4; ++m) {
                const size_t row = (size_t)u.pm * 256 + ai * 128 + wr * 64 + m * 16 + fr;
#pragma unroll
                for (int bj = 0; bj < 2; ++bj)
#pragma unroll
                    for (int n = 0; n < 2; ++n) {
                        const int col = u.pn * 256 + bj * 128 + wc * 32 + n * 16 + fq * 4;
                        const f32x4 v = acc[ai][bj][m][n];
                        const float4 xv = up4(xq[m][bj][n]); const float4 g = gv[bj][n];
                        *(uint2*)(xo + row * 1024 + col) = make_uint2(pack2(ALPHA_F * xv.x + g.x * v[0], ALPHA_F * xv.y + g.y * v[1]), pack2(ALPHA_F * xv.z + g.z * v[2], ALPHA_F * xv.w + g.w * v[3]));
                    }
            }
        }
    }
};
__device__ __forceinline__ void phase_gout(const PP p, char* smem, const u16* A, const u16* B, int layer) {
    SchedGrid S; S.A = (const char*)A; S.B = (const char*)B; S.nunits = 128 * 4; S.npn = 4; S.astep = (size_t)256 * 1024 * 2; S.bstep = (size_t)256 * 1024 * 2;
    EpiResid E; E.xo = (u16*)p.out() + (size_t)T_ * 1024; E.ada = (const float*)(p.ws() + OFF_ADA) + (size_t)layer * 2 * 6144;
    g8::gemm<false, false>((G8_LAS unsigned char*)smem, 1024, 1024, 1024, nullptr, S, E);
}

__device__ __forceinline__ void phase_lna(const PP p, char* smem, int layer) {
    const int t = tid_opaque(), lane = t & 63, wid = t >> 6, fr = lane & 15, q = lane >> 4;
    u16* WH = (u16*)smem;
    u16* WL = WH + 32 * 1032;
    float* uv = (float*)(smem + 2 * 32 * 1032 * 2);
    float* part = uv + 64;
    int* cntl = (int*)(part + 16 * 64);
    float* prm = (float*)(cntl + 32);
    const float* ada = (const float*)(p.ws() + OFF_ADA) + (size_t)layer * 2 * 6144;
    const float* lng = p.in(4) + (size_t)(layer * 2) * 1024; const float* lnb = p.in(5) + (size_t)(layer * 2) * 1024;
    const u16* XB = (const u16*)p.out() + (size_t)T_ * 1024;
    u16* X1 = (u16*)(p.ws() + OFF_MIX);
    u16* hb = (u16*)(p.ws() + OFF_HBUF);
    int* toke = (int*)(p.ws() + OFF_TOKE); float* tokg = (float*)(p.ws() + OFF_TOKG); int* cnt = (int*)(p.ws() + OFF_CNT);
    int built_b = -1;
    for (int g = blockIdx.x; g < 256; g += gridDim.x) {
        const int b = g >> 7;
        const float* shp = ada + b * 6144 + 3072; const float* scp = ada + b * 6144 + 4096;
        __syncthreads();
        if (b != built_b) {
            built_b = b;
            {
                float gc[2], bc[2], s1[2], sh[2];
#pragma unroll
                for (int k = 0; k < 2; ++k) { const int c = t + 512 * k; gc[k] = lng[c]; bc[k] = lnb[c]; s1[k] = scp[c]; sh[k] = shp[c]; }
                __builtin_amdgcn_sched_barrier(0);
#pragma unroll
                for (int k = 0; k < 2; ++k) { const int c = t + 512 * k; const float m1 = 1.0f + s1[k]; prm[c] = gc[k]; prm[1024 + c] = bc[k]; prm[2048 + c] = gc[k] * m1; prm[3072 + c] = bc[k] * m1 + sh[k]; }
            }
            __syncthreads();
            const int e = t & 31;
            float su = 0.f, sv = 0.f;
#pragma unroll 1
            for (int k16 = 0; k16 < 4; ++k16) {
                float rwv[16];
#pragma unroll
                for (int j = 0; j < 16; ++j) rwv[j] = p.in(6)[t + 512 * (16 * k16 + j)];
                __builtin_amdgcn_sched_barrier(0);
#pragma unroll
                for (int j = 0; j < 16; ++j) {
                    const int idx = t + 512 * (16 * k16 + j), c = idx >> 5;
                    const float w = rwv[j] * prm[2048 + c];
                    const u16 hi = f2bf(w); const u16 lo = f2bf(w - bf2f(hi));
                    WH[e * 1032 + c] = hi; WL[e * 1032 + c] = lo;
                    su += w; sv += prm[3072 + c] * rwv[j];
                }
            }
            part[(t >> 5) * 64 + e] = su; part[(t >> 5) * 64 + 32 + e] = sv;
            __syncthreads();
            if (t < 64) { float s = 0.f; for (int k = 0; k < 16; ++k) s += part[k * 64 + t]; uv[t] = s + ((t >= 32) ? p.in(7)[t - 32] : 0.f); }
        }
        if (t < 32) cntl[t] = 0;
        __syncthreads();
        const int tok = g * 128 + wid * 16 + fr;
        const u16* xrow = XB + (size_t)tok * 1024 + 8 * q;
        f32x4 acc0 = f32x4{0.f, 0.f, 0.f, 0.f}, acc1 = f32x4{0.f, 0.f, 0.f, 0.f};
        float sm = 0.f, sq = 0.f;
        {
#pragma unroll 1
            for (int s8 = 0; s8 < 4; ++s8) {
                uint4 xs[8];
#pragma unroll
                for (int j = 0; j < 8; ++j) xs[j] = *(const uint4*)(xrow + 32 * (8 * s8 + j));
                __builtin_amdgcn_sched_barrier(0);
#pragma unroll
                for (int j = 0; j < 8; ++j) {
                    const int s = 8 * s8 + j;
                    const uint4 xu = xs[j];
                    union { uint4 u; bf16x8 v; } xa; xa.u = xu;
                    const float x0 = lo2f(xu.x), x1 = hi2f(xu.x), x2 = lo2f(xu.y), x3 = hi2f(xu.y), x4 = lo2f(xu.z), x5 = hi2f(xu.z), x6 = lo2f(xu.w), x7 = hi2f(xu.w);
                    sm += ((x0 + x1) + (x2 + x3)) + ((x4 + x5) + (x6 + x7));
                    sq += ((x0 * x0 + x1 * x1) + (x2 * x2 + x3 * x3)) + ((x4 * x4 + x5 * x5) + (x6 * x6 + x7 * x7));
                    const bf16x8 wh0 = *(const bf16x8*)(WH + fr * 1032 + 32 * s + 8 * q), wl0 = *(const bf16x8*)(WL + fr * 1032 + 32 * s + 8 * q);
                    const bf16x8 wh1 = *(const bf16x8*)(WH + (16 + fr) * 1032 + 32 * s + 8 * q), wl1 = *(const bf16x8*)(WL + (16 + fr) * 1032 + 32 * s + 8 * q);
                    acc0 = __builtin_amdgcn_mfma_f32_16x16x32_bf16(xa.v, wh0, acc0, 0, 0, 0); acc0 = __builtin_amdgcn_mfma_f32_16x16x32_bf16(xa.v, wl0, acc0, 0, 0, 0);
                    acc1 = __builtin_amdgcn_mfma_f32_16x16x32_bf16(xa.v, wh1, acc1, 0, 0, 0); acc1 = __builtin_amdgcn_mfma_f32_16x16x32_bf16(xa.v, wl1, acc1, 0, 0, 0);
                }
            }
        }
        sm += __shfl_xor(sm, 16); sm += __shfl_xor(sm, 32); sq += __shfl_xor(sq, 16); sq += __shfl_xor(sq, 32);
        const float mean = sm * (1.0f / 1024.0f);
        const float rstd = rsqrtf(fmaxf(sq * (1.0f / 1024.0f) - mean * mean, 0.f) + 1e-5f);
        {
            const float u0 = uv[fr], u1 = uv[16 + fr], v0 = uv[32 + fr], v1 = uv[48 + fr];
            float p0[4], p1[4];
#pragma unroll
            for (int j = 0; j < 4; ++j) {
                const float mj = __shfl(mean, 4 * q + j), rj = __shfl(rstd, 4 * q + j);
                const float l0 = rj * (acc0[j] - mj * u0) + v0, l1 = rj * (acc1[j] - mj * u1) + v1;
                float mx = fmaxf(l0, l1);
                mx = fmaxf(mx, __shfl_xor(mx, 1)); mx = fmaxf(mx, __shfl_xor(mx, 2)); mx = fmaxf(mx, __shfl_xor(mx, 4)); mx = fmaxf(mx, __shfl_xor(mx, 8));
                p0[j] = __expf(l0 - mx); p1[j] = __expf(l1 - mx);
            }
            const int qb = lane & ~3;
#pragma unroll
            for (int j = 0; j < 4; ++j) {
                int i1[2], i2[2]; float w1[2], w2[2];
#pragma unroll
                for (int nt = 0; nt < 2; ++nt) {
                    const float pv = nt ? p1[j] : p0[j];
                    const float q0 = __shfl(pv, qb), q1 = __shfl(pv, qb + 1), q2 = __shfl(pv, qb + 2), q3 = __shfl(pv, qb + 3);
                    int a1 = 0; float b1 = q0;
                    if (q1 > b1) { b1 = q1; a1 = 1; } if (q2 > b1) { b1 = q2; a1 = 2; } if (q3 > b1) { b1 = q3; a1 = 3; }
                    int a2 = -1; float b2 = -1.f;
                    if (a1 != 0 && q0 > b2) { b2 = q0; a2 = 0; } if (a1 != 1 && q1 > b2) { b2 = q1; a2 = 1; }
                    if (a1 != 2 && q2 > b2) { b2 = q2; a2 = 2; } if (a1 != 3 && q3 > b2) { b2 = q3; a2 = 3; }
                    i1[nt] = a1; i2[nt] = a2; w1[nt] = b1; w2[nt] = b2;
                }
                float score = w1[0] + w2[0]; int gsel = fr >> 2;
                { const float s1 = w1[1] + w2[1]; if (s1 > score) { score = s1; gsel = 4 + (fr >> 2); } }
#pragma unroll
                for (int o = 4; o <= 8; o <<= 1) {
                    const float os = __shfl_xor(score, o); const int og = __shfl_xor(gsel, o);
                    if (os > score || (os == score && og < gsel)) { score = os; gsel = og; }
                }
                const int src = 16 * q + (gsel & 3) * 4, hsel = gsel >> 2;
                const int si1 = hsel ? __shfl(i1[1], src) : __shfl(i1[0], src), si2 = hsel ? __shfl(i2[1], src) : __shfl(i2[0], src);
                const float sv1 = hsel ? __shfl(w1[1], src) : __shfl(w1[0], src), sv2 = hsel ? __shfl(w2[1], src) : __shfl(w2[0], src);
                if (fr == 0) {
                    const int tk = g * 128 + wid * 16 + 4 * q + j;
                    const int e1 = gsel * 4 + si1, e2 = gsel * 4 + si2;
                    const float den = 1.0f / (sv1 + sv2);
                    toke[tk * 2] = e1; toke[tk * 2 + 1] = e2;
                    tokg[tk * 2] = sv1 * den; tokg[tk * 2 + 1] = sv2 * den;
                    atomicAdd(&cntl[e1], 1); atomicAdd(&cntl[e2], 1);
                }
            }
        }
        {
            u16* x1row = X1 + (size_t)tok * 1024 + 8 * q; u16* hrow = hb + (size_t)tok * 1024 + 8 * q;
            const float mr = -mean * rstd;
#pragma unroll 1
            for (int s8 = 0; s8 < 4; ++s8) {
                uint4 xs[8];
#pragma unroll
                for (int j = 0; j < 8; ++j) xs[j] = *(const uint4*)(xrow + 32 * (8 * s8 + j));
                __builtin_amdgcn_sched_barrier(0);
#pragma unroll
                for (int j = 0; j < 8; ++j) {
                    const int s = 8 * s8 + j, c0 = 32 * s + 8 * q;
                    const uint4 xu = xs[j];
                    const float xv[8] = {lo2f(xu.x), hi2f(xu.x), lo2f(xu.y), hi2f(xu.y), lo2f(xu.z), hi2f(xu.z), lo2f(xu.w), hi2f(xu.w)};
                    const float4 g0 = *(const float4*)(prm + c0), g1 = *(const float4*)(prm + c0 + 4), b0 = *(const float4*)(prm + 1024 + c0), b1 = *(const float4*)(prm + 1024 + c0 + 4);
                    const float4 G0 = *(const float4*)(prm + 2048 + c0), G1 = *(const float4*)(prm + 2048 + c0 + 4), B0 = *(const float4*)(prm + 3072 + c0), B1 = *(const float4*)(prm + 3072 + c0 + 4);
                    const float gv[8] = {g0.x, g0.y, g0.z, g0.w, g1.x, g1.y, g1.z, g1.w}, bv[8] = {b0.x, b0.y, b0.z, b0.w, b1.x, b1.y, b1.z, b1.w};
                    const float Gv[8] = {G0.x, G0.y, G0.z, G0.w, G1.x, G1.y, G1.z, G1.w}, Bv[8] = {B0.x, B0.y, B0.z, B0.w, B1.x, B1.y, B1.z, B1.w};
                    float y[8], hh[8];
#pragma unroll
                    for (int e = 0; e < 8; ++e) { const float z = xv[e] * rstd + mr; y[e] = z * gv[e] + bv[e]; hh[e] = z * Gv[e] + Bv[e]; }
                    *(uint4*)(x1row + 32 * s) = make_uint4(pack2(y[0], y[1]), pack2(y[2], y[3]), pack2(y[4], y[5]), pack2(y[6], y[7]));
                    *(uint4*)(hrow + 32 * s) = make_uint4(pack2(hh[0], hh[1]), pack2(hh[2], hh[3]), pack2(hh[4], hh[5]), pack2(hh[6], hh[7]));
                }
            }
        }
        __syncthreads();
        if (t < 32) cnt[g * 32 + t] = cntl[t];
    }
}

__device__ __forceinline__ void phase_scatter(const PP p, char* smem) {
    const int t = tid_opaque();
    int* part = (int*)smem;
    int* tot = part + 512; int* pstart = tot + 32; int* tstart = pstart + 32; int* base = tstart + 33; int* cursor = base + 32;
    const int* cnt = (const int*)(p.ws() + OFF_CNT);
    const int* toke = (const int*)(p.ws() + OFF_TOKE);
    int* toks = (int*)(p.ws() + OFF_TOKS); int* sltk = (int*)(p.ws() + OFF_SLTK); int* meta = (int*)(p.ws() + OFF_META);
    __syncthreads();
    { const int e = t & 31, pt = t >> 5; int s = 0;
      int cv0[16];
#pragma unroll
      for (int g = 0; g < 16; ++g) cv0[g] = cnt[(pt * 16 + g) * 32 + e];
#pragma unroll
      for (int g = 0; g < 16; g += 4) asm volatile("" : "+v"(cv0[g]), "+v"(cv0[g + 1]), "+v"(cv0[g + 2]), "+v"(cv0[g + 3]));
#pragma unroll
      for (int g = 0; g < 16; ++g) s += cv0[g];
      part[pt * 32 + e] = s; }
    __syncthreads();
    if (t < 32) { int s = 0; for (int q = 0; q < 16; ++q) s += part[q * 32 + t]; tot[t] = s; }
    __syncthreads();
    if (t == 0) { int ps = 0, ts = 0; for (int e = 0; e < 32; ++e) { pstart[e] = ps; tstart[e] = ts; const int nt = (tot[e] + 255) >> 8; ps += nt * 256; ts += nt; } tstart[32] = ts; }
    __syncthreads();
    for (int g = blockIdx.x; g < 256; g += gridDim.x) {
        if (t < 32) {
            int bsum = pstart[t];
            for (int q = 0; q < (g >> 4); ++q) bsum += part[q * 32 + t];
            int cv[15];
#pragma unroll
            for (int q = 0; q < 15; ++q) { const int gq = (g & ~15) + q; cv[q] = (gq < g) ? cnt[gq * 32 + t] : 0; }
#pragma unroll
            for (int q = 0; q < 15; ++q) bsum += cv[q];
            base[t] = bsum; cursor[t] = 0;
        }
        __syncthreads();
        if (t < 256) {
            const int tok = g * 128 + (t >> 1);
            const int e = toke[tok * 2 + (t & 1)];
            const int pos = atomicAdd(&cursor[e], 1);
            const int slot = base[e] + pos;
            sltk[slot] = tok; toks[tok * 2 + (t & 1)] = slot;
        }
        __syncthreads();
        if (g == 0) {
            if (t < 32) { meta[t] = tot[t]; meta[32 + t] = pstart[t]; }
            if (t < 33) meta[64 + t] = tstart[t];
            if (t < 32) { const int e0 = pstart[t] + tot[t], e1 = pstart[t] + (((tot[t] + 255) >> 8) << 8); int z_ = 0; asm volatile("" : "+v"(z_)); for (int s = e0; s < e1; ++s) sltk[s] = z_; }
        }
    }
}

constexpr int HLD = 768;
struct SchedMoe {
    const int* lm; const char* A; const char* B; int nct; size_t bexp, bct, astep; int ntot; int layer;
    __device__ __forceinline__ bool operator()(int i, g8::Unit& u) const {
        int id; if (!xcd_deal(i, ntot, id)) return false;
        const int rt = id / nct, ct = id - rt * nct;
        const int ln_ = (int)(threadIdx.x & 63u);
        const int e = __popcll(__ballot(ln_ >= 1 && ln_ < 32 && lm[64 + (ln_ & 31)] <= rt));
        const int slot0 = lm[32 + e] + (rt - lm[64 + e]) * 256;
        u.pm = rt; u.pn = ct; u.aux = slot0;
        u.a = A + (size_t)slot0 * astep;
        u.b = B + (size_t)(layer * 32 + e) * bexp + (size_t)ct * bct;
        return true;
    }
};
struct EpiSwiGLU {
    u16* H;
    __device__ __forceinline__ void operator()(const f32x4 (&acc)[2][2][4][2], const g8::Unit& u, int wr, int wc, int fr, int fq) const {
#pragma unroll
        for (int ai = 0; ai < 2; ++ai)
#pragma unroll
            for (int m = 0; m < 4; ++m) {
                const size_t row = (size_t)u.aux + ai * 128 + wr * 64 + m * 16 + fr;
                unsigned w[4];
#pragma unroll
                for (int n = 0; n < 2; ++n) {
                    float hv[4];
#pragma unroll
                    for (int j = 0; j < 4; ++j) { const float gv = acc[ai][0][m][n][j], uv = acc[ai][1][m][n][j]; hv[j] = gv * __builtin_amdgcn_rcpf(1.0f + __expf(-gv)) * uv; }
                    w[2 * n] = pack2(hv[0], hv[1]); w[2 * n + 1] = pack2(hv[2], hv[3]);
                }
                *(uint4*)(H + row * HLD + u.pn * 128 + wc * 32 + fq * 8) = make_uint4(w[0], w[1], w[2], w[3]);
                __builtin_amdgcn_sched_barrier(0);
            }
    }
};
__device__ __forceinline__ void phase_moe1(const PP p, char* smem, int layer) {
    int* lm = (int*)(smem + 132096);
    const int* meta = (const int*)(p.ws() + OFF_META);
    __syncthreads();
    { const int t_ = tid_opaque(); if (t_ < 97) lm[t_] = meta[t_]; }
    __syncthreads();
    SchedMoe S; S.lm = lm; S.A = p.ws() + OFF_HBUF; S.B = p.ws() + OFF_WGU; S.nct = 6; S.bexp = (size_t)1536 * 1024 * 2; S.bct = (size_t)256 * 1024 * 2; S.astep = 0;
    S.ntot = lm[64 + 32] * 6; S.layer = layer;
    EpiSwiGLU E; E.H = (u16*)(p.ws() + MOE_H);
    g8::gemm<true, true>((G8_LAS unsigned char*)smem, 1024, 1024, 1024, (const int*)(p.ws() + OFF_SLTK), S, E);
}

struct EpiBf16Slots {
    u16* Y;
    __device__ __forceinline__ void operator()(const f32x4 (&acc)[2][2][4][2], const g8::Unit& u, int wr, int wc, int fr, int fq) const {
#pragma unroll
        for (int ai = 0; ai < 2; ++ai)
#pragma unroll
            for (int m = 0; m < 4; ++m) {
                const size_t row = (size_t)u.aux + ai * 128 + wr * 64 + m * 16 + fr;
#pragma unroll
                for (int bj = 0; bj < 2; ++bj) {
                    const f32x4 v0 = acc[ai][bj][m][0], v1 = acc[ai][bj][m][1];
                    *(uint4*)(Y + row * 1024 + u.pn * 256 + bj * 128 + wc * 32 + fq * 8) = make_uint4(pack2(v0[0], v0[1]), pack2(v0[2], v0[3]), pack2(v1[0], v1[1]), pack2(v1[2], v1[3]));
                }
            }
    }
};
__device__ __forceinline__ void phase_moe2(const PP p, char* smem, int layer) {
    int* lm = (int*)(smem + 132096);
    const int* meta = (const int*)(p.ws() + OFF_META);
    __syncthreads();
    { const int t_ = tid_opaque(); if (t_ < 97) lm[t_] = meta[t_]; }
    __syncthreads();
    SchedMoe S; S.lm = lm; S.A = p.ws() + MOE_H; S.B = p.ws() + OFF_WD; S.nct = 4; S.bexp = (size_t)1024 * FF * 2; S.bct = (size_t)256 * FF * 2; S.astep = (size_t)HLD * 2;
    S.ntot = lm[64 + 32] * 4; S.layer = layer;
    EpiBf16Slots E; E.Y = (u16*)(p.ws() + MOE_Y);
    g8::gemm<true, false>((G8_LAS unsigned char*)smem, 768, HLD, FF, nullptr, S, E);
}

__device__ __forceinline__ void phase_lnb(const PP p, int layer) {
    const int t = tid_opaque(); const int lane = t & 63, wid = t >> 6;
    const float* ada = (const float*)(p.ws() + OFF_ADA) + (size_t)layer * 2 * 6144;
    const float* adan = (const float*)(p.ws() + OFF_ADA) + (size_t)(layer + 1) * 2 * 6144;
    const float* lng = p.in(4) + (size_t)(layer * 2 + 1) * 1024; const float* lnb = p.in(5) + (size_t)(layer * 2 + 1) * 1024;
    const u16* Y = (const u16*)(p.ws() + MOE_Y);
    const int* toks = (const int*)(p.ws() + OFF_TOKS); const float* tokg = (const float*)(p.ws() + OFF_TOKG);
    u16* hb = (u16*)(p.ws() + OFF_HBUF);
    const u16* X1 = (const u16*)(p.ws() + OFF_MIX);
    const int tstride = gridDim.x * 8;
    int tok = blockIdx.x * 8 + wid;
    int ns0 = 0, ns1 = 0; float ng0 = 0.f, ng1 = 0.f;
    float4 nx[4]; uint2 nya[4], nyb[4];
    float cg0 = 0.f, cg1 = 0.f;
    float4 pg[4], pb[4], pG2[4], pB2[4], pga[4]; int cur_b = -1;
#pragma unroll
    for (int q4 = 0; q4 < 4; ++q4) { pg[q4] = *(const float4*)(lng + 4 * lane + 256 * q4); pb[q4] = *(const float4*)(lnb + 4 * lane + 256 * q4); pG2[q4] = pg[q4]; pB2[q4] = pb[q4]; pga[q4] = pg[q4]; }
    if (tok < T_) {
        const int s0 = toks[tok * 2], s1 = toks[tok * 2 + 1]; cg0 = tokg[tok * 2]; cg1 = tokg[tok * 2 + 1];
#pragma unroll
        for (int q4 = 0; q4 < 4; ++q4) {
            const int c0 = 4 * lane + 256 * q4;
            nx[q4] = up4(*(const uint2*)(X1 + (size_t)tok * 1024 + c0));
            nya[q4] = *(const uint2*)(Y + (size_t)s0 * 1024 + c0); nyb[q4] = *(const uint2*)(Y + (size_t)s1 * 1024 + c0);
        }
        if (tok + tstride < T_) { ns0 = toks[(tok + tstride) * 2]; ns1 = toks[(tok + tstride) * 2 + 1]; ng0 = tokg[(tok + tstride) * 2]; ng1 = tokg[(tok + tstride) * 2 + 1]; }
    }
#pragma unroll 1
    for (; tok < T_; tok += tstride) {
        const int b = tok >> 14;
        if (b != cur_b) {
            cur_b = b;
#pragma unroll
            for (int q4 = 0; q4 < 4; ++q4) {
                const int c0 = 4 * lane + 256 * q4;
                pga[q4] = *(const float4*)(ada + b * 6144 + 5120 + c0);
                if (layer < 3) {
                    const float4 sh = *(const float4*)(adan + b * 6144 + c0), sc = *(const float4*)(adan + b * 6144 + 1024 + c0);
                    pG2[q4] = make_float4(pg[q4].x * (1.f + sc.x), pg[q4].y * (1.f + sc.y), pg[q4].z * (1.f + sc.z), pg[q4].w * (1.f + sc.w));
                    pB2[q4] = make_float4(pb[q4].x * (1.f + sc.x) + sh.x, pb[q4].y * (1.f + sc.y) + sh.y, pb[q4].z * (1.f + sc.z) + sh.z, pb[q4].w * (1.f + sc.w) + sh.w);
                }
            }
        }
        const float g0 = cg0, g1 = cg1;
        float* xr = p.out() + (size_t)tok * 1024;
        u16* xbr = (u16*)p.out() + (size_t)T_ * 1024 + (size_t)tok * 1024;
        float v[16];
#pragma unroll
        for (int q4 = 0; q4 < 4; ++q4) {
            const int c0 = 4 * lane + 256 * q4;
            const float4 x = nx[q4];
            const uint2 ya = nya[q4], yb = nyb[q4];
            const float4 gg = pga[q4];
            v[q4 * 4 + 0] = ALPHA_F * x.x + gg.x * (g0 * lo2f(ya.x) + g1 * lo2f(yb.x));
            v[q4 * 4 + 1] = ALPHA_F * x.y + gg.y * (g0 * hi2f(ya.x) + g1 * hi2f(yb.x));
            v[q4 * 4 + 2] = ALPHA_F * x.z + gg.z * (g0 * lo2f(ya.y) + g1 * lo2f(yb.y));
            v[q4 * 4 + 3] = ALPHA_F * x.w + gg.w * (g0 * hi2f(ya.y) + g1 * hi2f(yb.y));
        }
        {
            const int tn = tok + tstride;
            if (tn < T_) {
                cg0 = ng0; cg1 = ng1;
#pragma unroll
                for (int q4 = 0; q4 < 4; ++q4) {
                    const int c0 = 4 * lane + 256 * q4;
                    nx[q4] = up4(*(const uint2*)(X1 + (size_t)tn * 1024 + c0));
                    nya[q4] = *(const uint2*)(Y + (size_t)ns0 * 1024 + c0); nyb[q4] = *(const uint2*)(Y + (size_t)ns1 * 1024 + c0);
                }
                const int t2 = tn + tstride;
                if (t2 < T_) { ns0 = toks[t2 * 2]; ns1 = toks[t2 * 2 + 1]; ng0 = tokg[t2 * 2]; ng1 = tokg[t2 * 2 + 1]; }
            }
        }
        float sm = 0.f;
#pragma unroll
        for (int e = 0; e < 16; ++e) sm += v[e];
        const float mean = wave_sum(sm) * (1.0f / 1024.0f);
        float sq = 0.f;
#pragma unroll
        for (int e = 0; e < 16; ++e) { v[e] -= mean; sq += v[e] * v[e]; }
        const float rstd = rsqrtf(wave_sum(sq) * (1.0f / 1024.0f) + 1e-5f);
#pragma unroll
        for (int q4 = 0; q4 < 4; ++q4) {
            const int c0 = 4 * lane + 256 * q4;
            const float4 gg = pg[q4], bb = pb[q4];
            const float z0 = v[q4 * 4 + 0] * rstd, z1 = v[q4 * 4 + 1] * rstd, z2 = v[q4 * 4 + 2] * rstd, z3 = v[q4 * 4 + 3] * rstd;
            float4 y;
            y.x = z0 * gg.x + bb.x; y.y = z1 * gg.y + bb.y; y.z = z2 * gg.z + bb.z; y.w = z3 * gg.w + bb.w;
            if (layer == 3) *(float4*)(xr + c0) = y;
            if (layer < 3) {
                *(uint2*)(xbr + c0) = make_uint2(pack2(y.x, y.y), pack2(y.z, y.w));
                const float4 G2 = pG2[q4], B2 = pB2[q4];
                uint2 o; o.x = pack2(z0 * G2.x + B2.x, z1 * G2.y + B2.y); o.y = pack2(z2 * G2.z + B2.z, z3 * G2.w + B2.w);
                *(uint2*)(hb + (size_t)tok * 1024 + c0) = o;
            }
        }
    }
}

__device__ __forceinline__ void phase_hdn(const PP p, int i) {
    const int t = tid_opaque(); const int lane = t & 63, wid = t >> 6;
    const float* w1 = p.in(28) + (size_t)i * 33 * 64; const float* w2 = p.in(30) + (size_t)i * 4096; const float* w3 = p.in(32) + (size_t)i * 4096;
    const float b1 = p.in(29)[i * 64 + lane], b2 = p.in(31)[i * 64 + lane], b3 = p.in(33)[i * 64 + lane], frq = p.in(34)[i * 64 + lane];
    float W1c[33], W2c[64], W3c[64];
#pragma unroll
    for (int q = 0; q < 33; ++q) W1c[q] = w1[q * 64 + lane];
#pragma unroll
    for (int q = 0; q < 64; ++q) { W2c[q] = w2[q * 64 + lane]; W3c[q] = w3[q * 64 + lane]; }
    u16* hdn = (u16*)(p.ws() + OFF_HDN) + (size_t)i * L_ * 64;
    const float two_pi_over_L = (float)(6.283185307179586 / 16384.0);
    for (int l = blockIdx.x * 8 + wid; l < L_; l += gridDim.x * 8) {
        float zv = 0.f;
        if (lane == 0) zv = (float)l / (float)(L_ - 1);
        else if (lane <= 32) {
            const int bnd = (lane - 1) & 15;
            const float fb = 1e-4f + (float)bnd * ((15.0f - 1e-4f) / 15.0f);
            const float ang = (two_pi_over_L * (float)l) * fb;
            zv = (lane <= 16) ? cosf(ang) : -sinf(ang);
        }
        float pre = b1;
#pragma unroll
        for (int q = 0; q < 33; ++q) pre += __int_as_float(__builtin_amdgcn_readlane(__float_as_int(zv), q)) * W1c[q];
        float hcur = sinf(frq * pre);
        pre = b2;
#pragma unroll
        for (int q = 0; q < 64; ++q) pre += __int_as_float(__builtin_amdgcn_readlane(__float_as_int(hcur), q)) * W2c[q];
        hcur = sinf(frq * pre);
        pre = b3;
#pragma unroll
        for (int q = 0; q < 64; ++q) pre += __int_as_float(__builtin_amdgcn_readlane(__float_as_int(hcur), q)) * W3c[q];
        hcur = sinf(frq * pre);
        hdn[(size_t)l * 64 + lane] = f2bf(hcur);
    }
}

struct EpiUT {
    u16* UT;
    __device__ __forceinline__ void operator()(const f32x4 (&acc)[2][2][4][2], const g8::Unit& u, int wr, int wc, int fr, int fq) const {
#pragma unroll
        for (int ai = 0; ai < 2; ++ai)
#pragma unroll
            for (int m = 0; m < 4; ++m) {
                const int ch = u.pm * 256 + ai * 128 + wr * 64 + m * 16 + fr;
#pragma unroll
                for (int bj = 0; bj < 2; ++bj) {
                    const int tk = u.pn * 256 + bj * 128 + wc * 32 + fq * 8;
                    const int b = tk >> 14, t0 = tk & (L_ - 1);
                    const f32x4 v0 = acc[ai][bj][m][0], v1 = acc[ai][bj][m][1];
                    *(uint4*)(UT + ((size_t)(b * 3072 + ch)) * L_ + t0) = make_uint4(pack2(v0[0], v0[1]), pack2(v0[2], v0[3]), pack2(v1[0], v1[1]), pack2(v1[2], v1[3]));
                }
            }
    }
};
__device__ __forceinline__ void phase_g3(const PP p, char* smem, int i) {
    SchedGrid S; S.A = p.ws() + OFF_WINH + (size_t)i * 3072 * 1024 * 2; S.B = p.ws() + OFF_HBUF; S.nunits = 12 * 128; S.npn = 128;
    S.astep = (size_t)256 * 1024 * 2; S.bstep = (size_t)256 * 1024 * 2;
    EpiUT E; E.UT = (u16*)(p.ws() + HY_UT);
    g8::gemm<true, false>((G8_LAS unsigned char*)smem, 1024, 1024, 1024, nullptr, S, E);
}

__device__ __forceinline__ void phase_taps(const PP p, char* smem, int i) {
    const u16* A = (const u16*)(p.ws() + OFF_W4T) + (size_t)i * 4096 * 64;
    const u16* B = (const u16*)(p.ws() + OFF_HDN) + (size_t)i * L_ * 64;
    float* taps = (float*)(p.ws() + HY_TAPS);
    auto dec = [&](int id) __attribute__((always_inline)) { SKTile tl; tl.A = A + (size_t)(id >> 7) * 256 * 64; tl.lda = 64; tl.B = B + (size_t)(id & 127) * 128 * 64; tl.ldb = 64; tl.nk = 1; return tl; };
    auto epi = [&](int id, f32x4 (&acc)[4][4]) __attribute__((always_inline)) {
        const int tm = id >> 7, tn = id & 127;
        EPI_LOOP( const int row = tm * 256 + r, col = tn * 128 + c; const int ch = row & 1023;
                  const float ad = 3.070113457325394f + (float)ch * (12.280453829301576f / 1023.0f);
                  const float tl = (float)col * (1.0f / (float)(L_ - 1));
                  const float tv = v * __expf(-tl * ad);
                  if (row & 1024) { taps[(size_t)row * L_ + ((L_ - col) & (L_ - 1))] = (col == 0) ? 0.f : tv; } else taps[(size_t)row * L_ + col] = tv; )
    };
    gemm_smallk_loop<false>((u16*)smem, 16 * 128, dec, epi);
}

__device__ __forceinline__ float2 cmul(float2 a, float2 b) { return make_float2(a.x * b.x - a.y * b.y, a.x * b.y + a.y * b.x); }
__device__ __forceinline__ void fft_fwd(float2* X) {
    const int t = threadIdx.x;
#pragma unroll 1
    for (int s = 0; s < 7; ++s) {
        const int lq = 12 - 2 * s, q = 1 << lq;
        const float invM = 1.0f / (float)(q << 2);
        __syncthreads();
        const bool shared_tw = (lq <= 9);
        float2 w1c = make_float2(1.f, 0.f), w2c = w1c, w3c = w1c;
        if (shared_tw) { const float rv = (float)(t & (q - 1)) * invM; w1c = make_float2(__builtin_amdgcn_cosf(rv), -__builtin_amdgcn_sinf(rv)); w2c = cmul(w1c, w1c); w3c = cmul(w2c, w1c); }
#pragma unroll 1
        for (int hb = 0; hb < 4; ++hb) {
            float2 a[2][4]; int bs[2];
#pragma unroll
            for (int u = 0; u < 2; ++u) {
                const int g = t + 512 * (hb * 2 + u), blk = g >> lq, j = g & (q - 1);
                bs[u] = (blk << (lq + 2)) + j;
                a[u][0] = X[bs[u]]; a[u][1] = X[bs[u] + q]; a[u][2] = X[bs[u] + 2 * q]; a[u][3] = X[bs[u] + 3 * q];
            }
#pragma unroll
            for (int u = 0; u < 2; ++u) {
                float2 w1 = w1c, w2 = w2c, w3 = w3c;
                if (!shared_tw) {
                    const int j = bs[u] & (q - 1);
                    const float rev = (float)j * invM;
                    w1 = make_float2(__builtin_amdgcn_cosf(rev), -__builtin_amdgcn_sinf(rev));
                    w2 = cmul(w1, w1); w3 = cmul(w2, w1);
                }
                const float2 a0 = a[u][0], a1 = a[u][1], a2 = a[u][2], a3 = a[u][3];
                const float2 b0 = make_float2(a0.x + a2.x, a0.y + a2.y), b1 = make_float2(a0.x - a2.x, a0.y - a2.y);
                const float2 b2 = make_float2(a1.x + a3.x, a1.y + a3.y), b3 = make_float2(a1.x - a3.x, a1.y - a3.y);
                const float2 y0 = make_float2(b0.x + b2.x, b0.y + b2.y), y2 = make_float2(b0.x - b2.x, b0.y - b2.y);
                const float2 y1 = make_float2(b1.x + b3.y, b1.y - b3.x), y3 = make_float2(b1.x - b3.y, b1.y + b3.x);
                X[bs[u]] = y0; X[bs[u] + q] = cmul(y1, w1); X[bs[u] + 2 * q] = cmul(y2, w2); X[bs[u] + 3 * q] = cmul(y3, w3);
                __builtin_amdgcn_sched_barrier(0);
            }
        }
    }
    __syncthreads();
}
__device__ __forceinline__ void fft_inv(float2* X) {
    const int t = threadIdx.x;
#pragma unroll 1
    for (int s = 6; s >= 0; --s) {
        const int lq = 12 - 2 * s, q = 1 << lq;
        const float invM = 1.0f / (float)(q << 2);
        __syncthreads();
        const bool shared_tw = (lq <= 9);
        float2 w1c = make_float2(1.f, 0.f), w2c = w1c, w3c = w1c;
        if (shared_tw) { const float rv = (float)(t & (q - 1)) * invM; w1c = make_float2(__builtin_amdgcn_cosf(rv), __builtin_amdgcn_sinf(rv)); w2c = cmul(w1c, w1c); w3c = cmul(w2c, w1c); }
#pragma unroll 1
        for (int hb = 0; hb < 4; ++hb) {
            float2 a[2][4]; int bs[2];
#pragma unroll
            for (int u = 0; u < 2; ++u) {
                const int g = t + 512 * (hb * 2 + u), blk = g >> lq, j = g & (q - 1);
                bs[u] = (blk << (lq + 2)) + j;
                a[u][0] = X[bs[u]]; a[u][1] = X[bs[u] + q]; a[u][2] = X[bs[u] + 2 * q]; a[u][3] = X[bs[u] + 3 * q];
            }
#pragma unroll
            for (int u = 0; u < 2; ++u) {
                float2 w1 = w1c, w2 = w2c, w3 = w3c;
                if (!shared_tw) {
                    const int j = bs[u] & (q - 1);
                    const float rev = (float)j * invM;
                    w1 = make_float2(__builtin_amdgcn_cosf(rev), __builtin_amdgcn_sinf(rev));
                    w2 = cmul(w1, w1); w3 = cmul(w2, w1);
                }
                const float2 c0 = a[u][0], c1 = cmul(a[u][1], w1), c2 = cmul(a[u][2], w2), c3 = cmul(a[u][3], w3);
                const float2 e0 = make_float2(c0.x + c2.x, c0.y + c2.y), e1 = make_float2(c0.x - c2.x, c0.y - c2.y);
                const float2 e2 = make_float2(c1.x + c3.x, c1.y + c3.y), e3 = make_float2(c1.x - c3.x, c1.y - c3.y);
                X[bs[u]] = make_float2(e0.x + e2.x, e0.y + e2.y);
                X[bs[u] + q] = make_float2(e1.x - e3.y, e1.y + e3.x);
                X[bs[u] + 2 * q] = make_float2(e0.x - e2.x, e0.y - e2.y);
                X[bs[u] + 3 * q] = make_float2(e1.x + e3.y, e1.y - e3.x);
                __builtin_amdgcn_sched_barrier(0);
            }
        }
    }
    __syncthreads();
}
__device__ __forceinline__ void cv8(const uint4 u, const u16 pv, const u16 nv, int n0, float w0, float w1, float w2, float cb, float (&out)[8]) {
    float v[10];
    v[0] = (n0 > 0) ? bf2f(pv) : 0.f;
    v[1] = lo2f(u.x); v[2] = hi2f(u.x); v[3] = lo2f(u.y); v[4] = hi2f(u.y); v[5] = lo2f(u.z); v[6] = hi2f(u.z); v[7] = lo2f(u.w); v[8] = hi2f(u.w);
    v[9] = (n0 + 8 < L_) ? bf2f(nv) : 0.f;
#pragma unroll
    for (int e = 0; e < 8; ++e) out[e] = w0 * v[e] + w1 * v[e + 1] + w2 * v[e + 2] + cb;
}

constexpr int HLD2 = 136;
__device__ __forceinline__ bf16x8 neg8(bf16x8 v) { union { bf16x8 v; unsigned u[4]; } c; c.v = v; c.u[0] ^= 0x80008000u; c.u[1] ^= 0x80008000u; c.u[2] ^= 0x80008000u; c.u[3] ^= 0x80008000u; return c.v; }
template <int MODE>
__device__ __forceinline__ void cmm128(const u16* A0, const u16* A1, const u16* B0, const u16* B1, int wid, int fr, int fq, f32x4 (&accr)[8], f32x4 (&acci)[8]) {
#pragma unroll
    for (int nt = 0; nt < 8; ++nt) { accr[nt] = f32x4{0.f, 0.f, 0.f, 0.f}; acci[nt] = f32x4{0.f, 0.f, 0.f, 0.f}; }
    const u16* a0p = A0 + (16 * wid + fr) * HLD2 + 8 * fq; const u16* a1p = A1 + (16 * wid + fr) * HLD2 + 8 * fq;
    const u16* b0p = B0 + fr * HLD2 + 8 * fq; const u16* b1p = B1 + fr * HLD2 + 8 * fq;
    bf16x8 a0 = *(const bf16x8*)a0p, a1 = *(const bf16x8*)a1p;
    bf16x8 b0 = *(const bf16x8*)b0p, b1 = *(const bf16x8*)b1p;
#pragma unroll 1
    for (int s = 0; s < 4; ++s) {
        const bf16x8 na = neg8(MODE == 1 ? a0 : a1);
        bf16x8 a0n = a0, a1n = a1;
#pragma unroll
        for (int nt = 0; nt < 8; ++nt) {
            bf16x8 b0n, b1n;
            if (nt < 7) { b0n = *(const bf16x8*)(b0p + (nt + 1) * 16 * HLD2 + 32 * s); b1n = *(const bf16x8*)(b1p + (nt + 1) * 16 * HLD2 + 32 * s); }
            else        { b0n = *(const bf16x8*)(b0p + 32 * (s + 1)); b1n = *(const bf16x8*)(b1p + 32 * (s + 1)); }
            if (nt == 3) { a0n = *(const bf16x8*)(a0p + 32 * (s + 1)); a1n = *(const bf16x8*)(a1p + 32 * (s + 1)); }
            __builtin_amdgcn_sched_barrier(0);
            accr[nt] = __builtin_amdgcn_mfma_f32_16x16x32_bf16(a0, b0, accr[nt], 0, 0, 0);
            acci[nt] = __builtin_amdgcn_mfma_f32_16x16x32_bf16(MODE == 1 ? na : a0, b1, acci[nt], 0, 0, 0);
            accr[nt] = __builtin_amdgcn_mfma_f32_16x16x32_bf16(MODE == 0 ? na : a1, b1, accr[nt], 0, 0, 0);
            acci[nt] = __builtin_amdgcn_mfma_f32_16x16x32_bf16(MODE == 2 ? na : a1, b0, acci[nt], 0, 0, 0);
            __builtin_amdgcn_sched_barrier(0);
            b0 = b0n; b1 = b1n;
        }
        a0 = a0n; a1 = a1n;
    }
}
template <int TW>
__device__ __forceinline__ void store_T128(const f32x4 (&accr)[8], const f32x4 (&acci)[8], u16* PR, u16* PI, int wid, int fr, int fq) {
    const int R0 = 16 * wid + 4 * fq;
#pragma unroll
    for (int nt = 0; nt < 8; ++nt) {
        const int col = 16 * nt + fr;
        float re[4], im[4];
#pragma unroll
        for (int j = 0; j < 4; ++j) {
            const float xr = accr[nt][j], xi = acci[nt][j];
            if (TW == 0) { re[j] = xr; im[j] = xi; }
            else {
                const float rev = (float)((R0 + j) * col) * (1.0f / 16384.0f);
                const float cs = __builtin_amdgcn_cosf(rev), sn = __builtin_amdgcn_sinf(rev);
                if (TW == 1) { re[j] = xr * cs + xi * sn; im[j] = xi * cs - xr * sn; }
                else         { re[j] = xr * cs - xi * sn; im[j] = xi * cs + xr * sn; }
            }
        }
        *(uint2*)(PR + col * HLD2 + R0) = make_uint2(pack2(re[0], re[1]), pack2(re[2], re[3]));
        *(uint2*)(PI + col * HLD2 + R0) = make_uint2(pack2(im[0], im[1]), pack2(im[2], im[3]));
        __builtin_amdgcn_sched_barrier(0);
    }
}
__device__ __forceinline__ void fft128_fwd(const u16* FC, const u16* FS, u16* DR, u16* DI, int wid, int fr, int fq, f32x4 (&accr)[8], f32x4 (&acci)[8]) {
    __syncthreads();
    cmm128<1>(DR, DI, FC, FS, wid, fr, fq, accr, acci);
    __syncthreads();
    store_T128<1>(accr, acci, DR, DI, wid, fr, fq);
    __syncthreads();
    cmm128<2>(FC, FS, DR, DI, wid, fr, fq, accr, acci);
}
__device__ __forceinline__ void fft128_inv(const u16* FC, const u16* FS, u16* DR, u16* DI, int wid, int fr, int fq, f32x4 (&accr)[8], f32x4 (&acci)[8]) {
    __syncthreads();
    store_T128<0>(accr, acci, DR, DI, wid, fr, fq);
    __syncthreads();
    cmm128<0>(DR, DI, FC, FS, wid, fr, fq, accr, acci);
    __syncthreads();
    store_T128<2>(accr, acci, DR, DI, wid, fr, fq);
    __syncthreads();
    cmm128<0>(FC, FS, DR, DI, wid, fr, fq, accr, acci);
}

__device__ __forceinline__ void phase_hyena(const PP p, char* smem, int i) {
    const int t_outer = tid_opaque();
    int t = t_outer; int lane = t & 63, wid = t >> 6, fr = lane & 15, fq = lane >> 4;
    u16* FC = (u16*)smem; u16* FS = FC + 128 * HLD2; u16* DR = FS + 128 * HLD2; u16* DI = DR + 128 * HLD2;
    unsigned* TT = (unsigned*)DR;
    float* red = (float*)(smem + 4 * 128 * HLD2 * 2);
    const float* taps = (const float*)(p.ws() + HY_TAPS);
    const u16* UT = (const u16*)(p.ws() + HY_UT);
    u16* Y2T = (u16*)(p.ws() + HY_Y2T);
    unsigned* zT = (unsigned*)(p.ws() + HY_Y1) + (size_t)blockIdx.x * 65536;
    float4* AS = (float4*)(p.ws() + HY_SPEC) + (size_t)blockIdx.x * 8192;
    const float* cw = p.in(26) + (size_t)i * 3 * 3072; const float* cbp = p.in(27) + (size_t)i * 3072;
    const float invN = 1.0f / 32768.0f;
    __syncthreads();
    for (int e = t; e < 128 * 128; e += NTHR) {
        const int u = e >> 7, v = e & 127;
        const float rev = (float)((u * v) & 127) * (1.0f / 128.0f);
        FC[u * HLD2 + v] = f2bf(__builtin_amdgcn_cosf(rev)); FS[u * HLD2 + v] = f2bf(__builtin_amdgcn_sinf(rev));
    }
#pragma unroll 1
    for (int c = blockIdx.x; c < 1024; c += gridDim.x) {
#pragma unroll 1
        for (int arr = 0; arr < 3; ++arr) {
            const int ch = (arr == 0) ? (2048 + c) : ((arr == 1) ? c : (1024 + c));
            const float w0 = cw[ch], w1 = cw[3072 + ch], w2 = cw[6144 + ch], wb = cbp[ch];
            const u16* u0 = UT + (size_t)(0 * 3072 + ch) * L_; const u16* u1 = UT + (size_t)(1 * 3072 + ch) * L_;
            __syncthreads();
            {
                uint4 ua[4], ub[4]; unsigned pa[4], na[4], pb2[4], nb2[4];
#pragma unroll
                for (int g4 = 0; g4 < 4; ++g4) {
                    const int n0 = 8 * (t + 512 * g4), np = max(n0 - 1, 0), nn = min(n0 + 8, L_ - 1);
                    ua[g4] = *(const uint4*)(u0 + n0); ub[g4] = *(const uint4*)(u1 + n0);
                    pa[g4] = u0[np]; na[g4] = u0[nn]; pb2[g4] = u1[np]; nb2[g4] = u1[nn];
                }
                __builtin_amdgcn_sched_barrier(0);
#pragma unroll
                for (int g4 = 0; g4 < 4; ++g4) asm volatile("" : "+v"(pa[g4]), "+v"(na[g4]), "+v"(pb2[g4]), "+v"(nb2[g4]));
#pragma unroll
                for (int g4 = 0; g4 < 4; ++g4) {
                    const int n0 = 8 * (t + 512 * g4);
                    float a[8], b[8];
                    cv8(ua[g4], (u16)pa[g4], (u16)na[g4], n0, w0, w1, w2, wb, a); cv8(ub[g4], (u16)pb2[g4], (u16)nb2[g4], n0, w0, w1, w2, wb, b);
                    unsigned* d = TT + (n0 >> 7) * 132 + (n0 & 127);
                    *(uint4*)d = make_uint4(pack2(a[0], b[0]), pack2(a[1], b[1]), pack2(a[2], b[2]), pack2(a[3], b[3]));
                    *(uint4*)(d + 4) = make_uint4(pack2(a[4], b[4]), pack2(a[5], b[5]), pack2(a[6], b[6]), pack2(a[7], b[7]));
                }
            }
            __syncthreads();
#pragma unroll
            for (int k = 0; k < 4; ++k) {
                const int task = t + 512 * k, b = task & 127, a0 = (task >> 7) * 8;
                unsigned v[8];
#pragma unroll
                for (int e = 0; e < 8; ++e) v[e] = TT[(a0 + e) * 132 + b];
                unsigned* d = zT + arr * 16384 + b * 128 + a0;
                *(uint4*)d = make_uint4(v[0], v[1], v[2], v[3]); *(uint4*)(d + 4) = make_uint4(v[4], v[5], v[6], v[7]);
            }
        }
#pragma unroll 1
        for (int o = 0; o < 2; ++o) {
            const float* tf = taps + (size_t)(o * 2048 + c) * L_;
            const float* tg = taps + (size_t)(o * 2048 + 1024 + c) * L_;
            const float skip = p.in(36)[(size_t)(i * 2 + o) * 1024 + c];
            const unsigned* gT = zT + (1 + o) * 16384;
            float inv = 0.f;
#pragma unroll 1
            for (int half = 0; half < 2; ++half) {
                t = t_outer; asm volatile("" : "+v"(t)); lane = t & 63; wid = t >> 6; fr = lane & 15; fq = lane >> 4;
                f32x4 accr[8], acci[8];
                __syncthreads();
                {
                    float fv[4][8], gv[4][8];
#pragma unroll
                    for (int k = 0; k < 4; ++k) {
                        const int task = t + 512 * k, b = task & 127, a0 = (task >> 7) * 8;
#pragma unroll
                        for (int e = 0; e < 8; ++e) { const int n = 128 * (a0 + e) + b; fv[k][e] = tf[n]; gv[k][e] = tg[n]; }
                    }
                    if (half == 0) {
                        float ssum = 0.f;
#pragma unroll
                        for (int k = 0; k < 4; ++k)
#pragma unroll
                            for (int e = 0; e < 8; ++e) ssum += fabsf(fv[k][e]) + fabsf(gv[k][e]);
                        ssum = wave_sum(ssum);
                        if (lane == 0) red[wid] = ssum;
#pragma unroll
                        for (int k = 0; k < 4; ++k) {
                            const int task = t + 512 * k, b = task & 127, a0 = (task >> 7) * 8;
                            float xr[8];
#pragma unroll
                            for (int e = 0; e < 8; ++e) xr[e] = fv[k][e] + gv[k][e];
                            *(uint4*)(DR + b * HLD2 + a0) = make_uint4(pack2(xr[0], xr[1]), pack2(xr[2], xr[3]), pack2(xr[4], xr[5]), pack2(xr[6], xr[7]));
                            *(uint4*)(DI + b * HLD2 + a0) = make_uint4(0u, 0u, 0u, 0u);
                        }
                    } else {
#pragma unroll
                        for (int k = 0; k < 4; ++k) {
                            const int task = t + 512 * k, b = task & 127, a0 = (task >> 7) * 8;
                            float xr[8], xi[8];
#pragma unroll
                            for (int e = 0; e < 8; ++e) {
                                const int n = 128 * (a0 + e) + b;
                                const float rev = (float)n * invN, dd = fv[k][e] - gv[k][e];
                                xr[e] = dd * __builtin_amdgcn_cosf(rev); xi[e] = -dd * __builtin_amdgcn_sinf(rev);
                            }
                            *(uint4*)(DR + b * HLD2 + a0) = make_uint4(pack2(xr[0], xr[1]), pack2(xr[2], xr[3]), pack2(xr[4], xr[5]), pack2(xr[6], xr[7]));
                            *(uint4*)(DI + b * HLD2 + a0) = make_uint4(pack2(xi[0], xi[1]), pack2(xi[2], xi[3]), pack2(xi[4], xi[5]), pack2(xi[6], xi[7]));
                        }
                    }
                }
                fft128_fwd(FC, FS, DR, DI, wid, fr, fq, accr, acci);
                if (half == 0) {
                    float tot = 0.f;
#pragma unroll
                    for (int q = 0; q < 8; ++q) tot += red[q];
                    inv = 1.0f / (tot + 1e-6f);
                }
                unsigned Fr[32];
#pragma unroll
                for (int nt = 0; nt < 8; ++nt)
#pragma unroll
                    for (int j = 0; j < 4; ++j) Fr[nt * 4 + j] = pack2(accr[nt][j] * inv, acci[nt][j] * inv);
                t = t_outer; asm volatile("" : "+v"(t)); lane = t & 63; wid = t >> 6; fr = lane & 15; fq = lane >> 4;
                __syncthreads();
                {
                    uint4 zq[4][2];
#pragma unroll
                    for (int k = 0; k < 4; ++k) {
                        const int task = t + 512 * k, b = task & 127, a0 = (task >> 7) * 8;
                        zq[k][0] = *(const uint4*)(zT + b * 128 + a0); zq[k][1] = *(const uint4*)(zT + b * 128 + a0 + 4);
                    }
                    if (half == 0) {
#pragma unroll
                        for (int k = 0; k < 4; ++k) {
                            const int task = t + 512 * k, b = task & 127, a0 = (task >> 7) * 8;
                            const unsigned zz[8] = {zq[k][0].x, zq[k][0].y, zq[k][0].z, zq[k][0].w, zq[k][1].x, zq[k][1].y, zq[k][1].z, zq[k][1].w};
                            *(uint4*)(DR + b * HLD2 + a0) = make_uint4((zz[0] & 0xffffu) | (zz[1] << 16), (zz[2] & 0xffffu) | (zz[3] << 16), (zz[4] & 0xffffu) | (zz[5] << 16), (zz[6] & 0xffffu) | (zz[7] << 16));
                            *(uint4*)(DI + b * HLD2 + a0) = make_uint4((zz[0] >> 16) | (zz[1] & 0xffff0000u), (zz[2] >> 16) | (zz[3] & 0xffff0000u), (zz[4] >> 16) | (zz[5] & 0xffff0000u), (zz[6] >> 16) | (zz[7] & 0xffff0000u));
                        }
                    } else {
#pragma unroll
                        for (int k = 0; k < 4; ++k) {
                            const int task = t + 512 * k, b = task & 127, a0 = (task >> 7) * 8;
                            const unsigned zz[8] = {zq[k][0].x, zq[k][0].y, zq[k][0].z, zq[k][0].w, zq[k][1].x, zq[k][1].y, zq[k][1].z, zq[k][1].w};
                            float xr[8], xi[8];
#pragma unroll
                            for (int e = 0; e < 8; ++e) {
                                const float zr = lo2f(zz[e]), zi = hi2f(zz[e]);
                                const float rev = (float)(128 * (a0 + e) + b) * invN; const float cs = __builtin_amdgcn_cosf(rev), sn = __builtin_amdgcn_sinf(rev);
                                xr[e] = zr * cs + zi * sn; xi[e] = zi * cs - zr * sn;
                            }
                            *(uint4*)(DR + b * HLD2 + a0) = make_uint4(pack2(xr[0], xr[1]), pack2(xr[2], xr[3]), pack2(xr[4], xr[5]), pack2(xr[6], xr[7]));
                            *(uint4*)(DI + b * HLD2 + a0) = make_uint4(pack2(xi[0], xi[1]), pack2(xi[2], xi[3]), pack2(xi[4], xi[5]), pack2(xi[6], xi[7]));
                        }
                    }
                }
                fft128_fwd(FC, FS, DR, DI, wid, fr, fq, accr, acci);
                t = t_outer; asm volatile("" : "+v"(t)); lane = t & 63; wid = t >> 6; fr = lane & 15; fq = lane >> 4;
#pragma unroll
                for (int nt = 0; nt < 8; ++nt)
#pragma unroll
                    for (int j = 0; j < 4; ++j) {
                        const float fr_ = lo2f(Fr[nt * 4 + j]), fi_ = hi2f(Fr[nt * 4 + j]);
                        const float xr = accr[nt][j], xi = acci[nt][j];
                        accr[nt][j] = xr * fr_ - xi * fi_; acci[nt][j] = xr * fi_ + xi * fr_;
                    }
                fft128_inv(FC, FS, DR, DI, wid, fr, fq, accr, acci);
                if (half == 0) {
#pragma unroll
                    for (int nt = 0; nt < 8; ++nt) {
                        AS[((wid * 8 + nt) * 64 + lane) * 2 + 0] = make_float4(accr[nt][0], accr[nt][1], accr[nt][2], accr[nt][3]);
                        AS[((wid * 8 + nt) * 64 + lane) * 2 + 1] = make_float4(acci[nt][0], acci[nt][1], acci[nt][2], acci[nt][3]);
                    }
                } else {
                    t = t_outer; asm volatile("" : "+v"(t)); lane = t & 63; wid = t >> 6; fr = lane & 15; fq = lane >> 4;
                    const int a0 = 16 * wid + 4 * fq;
#pragma unroll
                    for (int nb = 0; nb < 2; ++nb) {
                        float4 ar4[4], ai4[4]; uint4 zq4[4], gq4[4];
#pragma unroll
                        for (int k = 0; k < 4; ++k) {
                            const int nt = 4 * nb + k, b = 16 * nt + fr;
                            ar4[k] = AS[((wid * 8 + nt) * 64 + lane) * 2 + 0]; ai4[k] = AS[((wid * 8 + nt) * 64 + lane) * 2 + 1];
                            zq4[k] = *(const uint4*)(zT + b * 128 + a0); gq4[k] = *(const uint4*)(gT + b * 128 + a0);
                        }
                        __builtin_amdgcn_sched_barrier(0);
#pragma unroll
                        for (int k = 0; k < 4; ++k) {
                            const int nt = 4 * nb + k, b = 16 * nt + fr;
                            const float are[4] = {ar4[k].x, ar4[k].y, ar4[k].z, ar4[k].w}, aim[4] = {ai4[k].x, ai4[k].y, ai4[k].z, ai4[k].w};
                            const unsigned zz[4] = {zq4[k].x, zq4[k].y, zq4[k].z, zq4[k].w}, gg[4] = {gq4[k].x, gq4[k].y, gq4[k].z, gq4[k].w};
                            unsigned yo[4];
#pragma unroll
                            for (int j = 0; j < 4; ++j) {
                                const int n = 128 * (a0 + j) + b;
                                const float rev = (float)n * invN; const float cs = __builtin_amdgcn_cosf(rev), sn = __builtin_amdgcn_sinf(rev);
                                const float br = accr[nt][j] * cs - acci[nt][j] * sn, bi = acci[nt][j] * cs + accr[nt][j] * sn;
                                const float yr = ((are[j] + br) * invN + lo2f(zz[j]) * skip) * lo2f(gg[j]);
                                const float yi = ((aim[j] + bi) * invN + hi2f(zz[j]) * skip) * hi2f(gg[j]);
                                yo[j] = pack2(yr, yi);
                                if (o == 1) { Y2T[(size_t)(0 * 1024 + c) * L_ + n] = f2bf(yr); Y2T[(size_t)(1 * 1024 + c) * L_ + n] = f2bf(yi); }
                            }
                            if (o == 0) *(uint4*)(zT + b * 128 + a0) = make_uint4(yo[0], yo[1], yo[2], yo[3]);
                        }
                    }
                }
            }
        }
    }
}

__device__ __forceinline__ void phase_transpose(const PP p, char* smem) {
    const int t = tid_opaque();
    u16* tile = (u16*)smem;
    const u16* Y2T = (const u16*)(p.ws() + HY_Y2T);
    u16* Y2 = (u16*)(p.ws() + HY_Y2);
    const int r = t >> 3, ch = t & 7;
    for (int base = blockIdx.x * 8; base < 8192; base += gridDim.x * 8) {
        uint4 u[8];
#pragma unroll
        for (int k = 0; k < 8; ++k) {
            const int id = base + k, b = id >> 12, c0 = ((id >> 8) & 15) * 64, n0 = (id & 255) * 64;
            u[k] = *(const uint4*)(Y2T + ((size_t)(b * 1024 + c0 + r)) * L_ + n0 + ch * 8);
        }
        __syncthreads();
#pragma unroll
        for (int k = 0; k < 8; ++k) {
            u16* d = tile + k * (64 * 66) + r * 66 + ch * 8;
            d[0] = (u16)(u[k].x & 0xffff); d[1] = (u16)(u[k].x >> 16); d[2] = (u16)(u[k].y & 0xffff); d[3] = (u16)(u[k].y >> 16);
            d[4] = (u16)(u[k].z & 0xffff); d[5] = (u16)(u[k].z >> 16); d[6] = (u16)(u[k].w & 0xffff); d[7] = (u16)(u[k].w >> 16);
        }
        __syncthreads();
#pragma unroll
        for (int k = 0; k < 8; ++k) {
            const int id = base + k, b = id >> 12, c0 = ((id >> 8) & 15) * 64, n0 = (id & 255) * 64;
            const u16* tk = tile + k * (64 * 66);
            unsigned w[4];
#pragma unroll
            for (int e = 0; e < 4; ++e) w[e] = (unsigned)tk[(ch * 8 + 2 * e) * 66 + r] | ((unsigned)tk[(ch * 8 + 2 * e + 1) * 66 + r] << 16);
            *(uint4*)(Y2 + ((size_t)b * L_ + n0 + r) * 1024 + c0 + ch * 8) = make_uint4(w[0], w[1], w[2], w[3]);
        }
    }
}

}

__device__ __forceinline__ PP pq(KP kp) { asm volatile("" : "+s"(kp)); PP r; r.k = kp; return r; }
__global__ void __launch_bounds__(512, 2) fwd_kernel(P p_unused) {
    KP kp = (KP)__builtin_amdgcn_kernarg_segment_ptr();
    extern __shared__ __attribute__((aligned(16))) char smem_raw[];
    char* smem = smem_raw + 16;
    if (threadIdx.x == 0) *(uint4*)smem_raw = make_uint4(0u, 0u, 0u, 0u);
    __syncthreads();
    (void)xcd_barrier_post((unsigned*)(pq(kp).ws() + OFF_BAR), (volatile LAS unsigned*)smem_raw);
#define GRID_BARRIER() do { XcdBarrier b_; b_.bar = (unsigned*)(pq(kp).ws() + OFF_BAR); b_.x = xb_xcc_id(); b_.st = (volatile LAS unsigned*)smem_raw; xcd_barrier(b_); } while (0)
    phase_prologue_a(pq(kp), smem);
    phase_hdn(pq(kp), 0);
    phase_hdn(pq(kp), 1);
    GRID_BARRIER();
    phase_prologue_b(pq(kp));
    GRID_BARRIER();
#pragma unroll 1
    for (int layer = 0; layer < 4; ++layer) {
        const int i = layer >> 1;
        if ((layer & 1) == 0) {
            phase_g1(pq(kp), smem, i);
            GRID_BARRIER();
            phase_na(pq(kp), smem, i);
            phase_rwprep(pq(kp), i);
            GRID_BARRIER();
            phase_lora(pq(kp), smem, i);
            GRID_BARRIER();
            phase_scanA(pq(kp), smem);
            GRID_BARRIER();
            phase_scanB1(pq(kp));
            GRID_BARRIER();
            phase_scanB2(pq(kp));
            GRID_BARRIER();
            phase_combine(pq(kp), i);
            GRID_BARRIER();
        } else {
            phase_g3(pq(kp), smem, i);
            __syncthreads();
            phase_taps(pq(kp), smem, i);
            GRID_BARRIER();
            phase_hyena(pq(kp), smem, i);
            GRID_BARRIER();
            phase_transpose(pq(kp), smem);
            GRID_BARRIER();
        }
        phase_gout(pq(kp), smem, (const u16*)(pq(kp).ws() + ((layer & 1) ? HY_Y2 : OFF_MIX)), (const u16*)(pq(kp).ws() + ((layer & 1) ? OFF_WOUTH : OFF_WOUTE)) + (size_t)i * 1024 * 1024, layer);
        GRID_BARRIER();
        phase_lna(pq(kp), smem, layer);
        GRID_BARRIER();
        phase_scatter(pq(kp), smem);
        GRID_BARRIER();
        phase_moe1(pq(kp), smem, layer);
        GRID_BARRIER();
        phase_moe2(pq(kp), smem, layer);
        GRID_BARRIER();
        phase_lnb(pq(kp), layer);
        GRID_BARRIER();
    }
}

extern "C" void kernel_launch(void* const* d_in, const int* in_sizes, int n_in,
                              void* d_out, int out_size, void* d_ws, size_t ws_size,
                              hipStream_t stream) {
    static int grid = 0;
    if (!grid) {
        int dev = 0, cus = 0, per_cu = 0;
        hipGetDevice(&dev);
        hipDeviceGetAttribute(&cus, hipDeviceAttributeMultiprocessorCount, dev);
        hipFuncSetAttribute((const void*)fwd_kernel, hipFuncAttributeMaxDynamicSharedMemorySize, LDS_BYTES);
        hipOccupancyMaxActiveBlocksPerMultiprocessor(&per_cu, fwd_kernel, NTHR, LDS_BYTES);
        if (per_cu < 1) { fprintf(stderr, "occupancy query returned %d\n", per_cu); per_cu = 1; }
        grid = cus;
    }
    if (ws_size < WS_NEED || n_in < 38) { fprintf(stderr, "workspace too small: %zu < %zu\n", ws_size, (size_t)WS_NEED); return; }
    hipMemsetAsync(d_ws, 0, XCD_BAR_WORDS * sizeof(unsigned), stream);
    P p{};
    for (int i = 0; i < 38; ++i) p.in[i] = (const float*)d_in[i];
    p.out = (float*)d_out; p.ws = (char*)d_ws;
    hipLaunchKernelGGL(fwd_kernel, dim3(grid), dim3(NTHR), LDS_BYTES, stream, p);
}
```

```cpp
#include <hip/hip_runtime.h>
#include <hip/hip_fp16.h>
#include <stdint.h>
#include <stdio.h>

#define XB_TMO      128
#define XB_XCNT(j)  (256  + 64 * (j))
#define XB_XSUB(j)  (1280 + 64 * (j))
#define XB_XGEN(j)  (2304 + 64 * (j))
#define XB_TOP      3328
#define XB_TOPGEN   3392
#define XCD_BAR_WORDS 3456
#define XB_SPIN_CAP (1u << 22)
#define LAS __attribute__((address_space(3)))

__device__ __forceinline__ unsigned xb_ld(unsigned* p)              { return __hip_atomic_load(p, __ATOMIC_RELAXED, __HIP_MEMORY_SCOPE_AGENT); }
__device__ __forceinline__ unsigned xb_add(unsigned* p, unsigned v) { return __hip_atomic_fetch_add(p, v, __ATOMIC_RELAXED, __HIP_MEMORY_SCOPE_AGENT); }
__device__ __forceinline__ unsigned xb_xcc_id() { return (unsigned)__builtin_amdgcn_s_getreg((3 << 11) | 20) & 0xFu; }
#define XB_SPIN(cond, bar) do { unsigned _sp = 0; while (cond) { __builtin_amdgcn_s_sleep(1); \
    if ((++_sp & 255u) == 0u) { if (xb_ld(&(bar)[XB_TMO])) break; if (_sp > XB_SPIN_CAP) { atomicAdd(&(bar)[XB_TMO], 1u); break; } } } } while (0)

struct XcdBarrier { unsigned* bar; unsigned x; volatile LAS unsigned* st; };

__device__ __forceinline__ XcdBarrier xcd_barrier_post(unsigned* bar, volatile LAS unsigned* st) {
    XcdBarrier b; b.bar = bar; b.x = xb_xcc_id(); b.st = st;
    if (threadIdx.x == 0) (void)xb_add(&bar[XB_XCNT(b.x)], 1u);
    return b;
}
__device__ __forceinline__ void xcd_barrier_complete(unsigned* bar, unsigned x, unsigned& nloc, unsigned& nx) {
    const unsigned G = gridDim.x * gridDim.y * gridDim.z;
    unsigned sum, cnt, mine, sp = 0u;
    for (;;) {
        sum = 0u; cnt = 0u; mine = 0u;
#pragma unroll
        for (unsigned j = 0; j < 16; ++j) { const unsigned c = xb_ld(&bar[XB_XCNT(j)]); sum += c; cnt += (c > 0u) ? 1u : 0u; mine = (j == x) ? c : mine; }
        if (sum == G) break;
        __builtin_amdgcn_s_sleep(1);
        if ((++sp & 255u) == 0u) { if (xb_ld(&bar[XB_TMO])) break; if (sp > XB_SPIN_CAP) { atomicAdd(&bar[XB_TMO], 1u); break; } }
    }
    nloc = mine > 0u ? mine : 1u; nx = cnt > 0u ? cnt : 1u;
}
__device__ __forceinline__ void xcd_barrier(const XcdBarrier& b) {
    asm volatile("s_waitcnt vmcnt(0)" ::: "memory");
    __syncthreads();
    if (threadIdx.x == 0) {
        unsigned* bar = b.bar;
        __builtin_amdgcn_s_waitcnt(0);
        unsigned nloc = b.st[0], nx = b.st[1];
        if (nloc == 0u) { xcd_barrier_complete(bar, b.x, nloc, nx); b.st[0] = nloc; b.st[1] = nx; }
        const unsigned old = xb_add(&bar[XB_XSUB(b.x)], 1u);
        const unsigned gen = old / nloc;
        if (old + 1u == (gen + 1u) * nloc) {
            __builtin_amdgcn_fence(__ATOMIC_RELEASE, "agent");
            asm volatile("s_waitcnt vmcnt(0)" ::: "memory");
            const unsigned og = xb_add(&bar[XB_TOP], 1u);
            const unsigned tg = og / nx;
            if (og + 1u == (tg + 1u) * nx) xb_add(&bar[XB_TOPGEN], 1u);
            else XB_SPIN(xb_ld(&bar[XB_TOPGEN]) == tg, bar);
            __builtin_amdgcn_fence(__ATOMIC_ACQUIRE, "agent");
            xb_add(&bar[XB_XGEN(b.x)], 1u);
            asm volatile("s_waitcnt vmcnt(0)" ::: "memory");
        } else {
            XB_SPIN(xb_ld(&bar[XB_XGEN(b.x)]) == gen, bar);
            __builtin_amdgcn_fence(__ATOMIC_ACQUIRE, "agent");
            asm volatile("s_waitcnt vmcnt(0)" ::: "memory");
        }
    }
    __syncthreads();
}

namespace {
constexpr int T_ = 32768, D_ = 1024, L_ = 16384;
constexpr int ABP = 3456;
constexpr int FF = 704;
constexpr int NSLOT = 73728;
constexpr float ALPHA_F = 1.681792830507429f;
constexpr int NTHR = 512;
constexpr int LDS_BYTES = 152 * 1024;

typedef unsigned short u16;
using bf16x8 = __attribute__((ext_vector_type(8))) short;
using f32x4  = __attribute__((ext_vector_type(4))) float;

constexpr size_t al(size_t x) { return (x + 255) & ~(size_t)255; }
constexpr size_t OFF_BAR   = 0;
constexpr size_t OFF_ADA   = al(OFF_BAR + 16384);
constexpr size_t OFF_CNT   = al(OFF_ADA + 4 * 2 * 6144 * 4);
constexpr size_t OFF_META  = al(OFF_CNT + 256 * 32 * 4);
constexpr size_t OFF_TOKE  = al(OFF_META + 4096);
constexpr size_t OFF_TOKG  = al(OFF_TOKE + (size_t)T_ * 2 * 4);
constexpr size_t OFF_TOKS  = al(OFF_TOKG + (size_t)T_ * 2 * 4);
constexpr size_t OFF_SLTK  = al(OFF_TOKS + (size_t)T_ * 2 * 4);
constexpr size_t OFF_HDN   = al(OFF_SLTK + (size_t)NSLOT * 4);
constexpr size_t OFF_WGU   = al(OFF_HDN + (size_t)2 * L_ * 64 * 2);
constexpr size_t OFF_WD    = al(OFF_WGU + (size_t)4 * 32 * 1536 * 1024 * 2);
constexpr size_t OFF_WINE  = al(OFF_WD + (size_t)4 * 32 * 1024 * 704 * 2);
constexpr size_t OFF_WOUTE = al(OFF_WINE + (size_t)2 * 3584 * 1024 * 2);
constexpr size_t OFF_WINH  = al(OFF_WOUTE + (size_t)2 * 1024 * 1024 * 2);
constexpr size_t OFF_WOUTH = al(OFF_WINH + (size_t)2 * 3072 * 1024 * 2);
constexpr size_t OFF_WUP   = al(OFF_WOUTH + (size_t)2 * 1024 * 1024 * 2);
constexpr size_t OFF_AUP   = al(OFF_WUP + (size_t)4 * 512 * 64 * 2);
constexpr size_t OFF_GUP   = al(OFF_AUP + (size_t)4 * 512 * 64 * 2);
constexpr size_t OFF_W4T   = al(OFF_GUP + (size_t)2 * 512 * 128 * 2);
constexpr size_t OFF_HBUF  = al(OFF_W4T + (size_t)2 * 4096 * 64 * 2);
constexpr size_t OFF_P     = al(OFF_HBUF + (size_t)T_ * 1024 * 2);
constexpr size_t SZ_P      = (size_t)T_ * ABP * 2;
constexpr size_t OFF_MIX   = al(OFF_P + SZ_P);
constexpr size_t OFF_RW    = al(OFF_MIX + (size_t)T_ * 1024 * 2);
constexpr size_t SZ_RW     = (size_t)320 << 20;
constexpr size_t OFF_O     = al(OFF_RW + SZ_RW);
constexpr size_t SZ_O      = (size_t)128 << 20;
constexpr size_t WS_NEED   = OFF_O + SZ_O;

constexpr size_t RW_R   = OFF_RW;
constexpr size_t RW_V   = RW_R + (size_t)T_ * 512 * 2;
constexpr size_t RW_KK  = RW_V + (size_t)T_ * 512 * 2;
constexpr size_t RW_G   = RW_KK + (size_t)T_ * 512 * 2;
constexpr size_t RW_W   = RW_G + (size_t)T_ * 512 * 2;
constexpr size_t RW_KD  = RW_W + (size_t)T_ * 1024 * 2;
constexpr size_t RW_BQ  = RW_KD + (size_t)T_ * 1024 * 2;
constexpr size_t O_OF   = OFF_O;
constexpr size_t O_OB   = OFF_O + (size_t)T_ * 512 * 4;
constexpr size_t O_KP   = OFF_O;
constexpr size_t O_AWD  = O_KP + (size_t)T_ * 512 * 2;
constexpr size_t O_AAD  = O_AWD + (size_t)T_ * 128 * 2;
constexpr size_t O_AGD  = O_AAD + (size_t)T_ * 128 * 2;
constexpr size_t MOE_H  = OFF_P;
constexpr size_t MOE_Y  = OFF_RW;
constexpr size_t HY_UT   = OFF_P;
constexpr size_t HY_TAPS = OFF_RW;
constexpr size_t HY_Y2   = OFF_RW + (size_t)4096 * L_ * 4;
constexpr size_t HY_Y2T  = OFF_MIX;
constexpr size_t HY_SPEC = OFF_O;
constexpr size_t HY_Y1   = OFF_HBUF;

struct P { const float* in[38]; float* out; char* ws; };
typedef const __attribute__((address_space(4))) P* KP;
struct PP { KP k;
    __device__ __forceinline__ const float* in(int i) const { return k->in[i]; }
    __device__ __forceinline__ char* ws() const { return k->ws; }
    __device__ __forceinline__ float* out() const { return k->out; } };

__device__ __forceinline__ int tid_opaque() { int t = threadIdx.x; asm volatile("" : "+v"(t)); return t; }
__device__ __forceinline__ float bf2f(u16 h) { return __uint_as_float(((unsigned)h) << 16); }
typedef float f32x2_t __attribute__((ext_vector_type(2)));
typedef __bf16 bf16x2_t __attribute__((ext_vector_type(2)));
__device__ __forceinline__ u16 f2bf(float f) { const __bf16 h = (__bf16)f; return __builtin_bit_cast(u16, h); }
__device__ __forceinline__ unsigned pack2(float a, float b) { const f32x2_t v = {a, b}; const bf16x2_t r = __builtin_convertvector(v, bf16x2_t); return __builtin_bit_cast(unsigned, r); }
__device__ __forceinline__ float lo2f(unsigned u) { return __uint_as_float(u << 16); }
__device__ __forceinline__ float hi2f(unsigned u) { return __uint_as_float(u & 0xffff0000u); }
__device__ __forceinline__ float4 up4(uint2 u) { return make_float4(lo2f(u.x), hi2f(u.x), lo2f(u.y), hi2f(u.y)); }
__device__ __forceinline__ float wave_sum(float v) {
#pragma unroll
    for (int o = 32; o >= 1; o >>= 1) v += __shfl_xor(v, o);
    return v;
}
__device__ __forceinline__ float wave_max(float v) {
#pragma unroll
    for (int o = 32; o >= 1; o >>= 1) v = fmaxf(v, __shfl_xor(v, o));
    return v;
}
__device__ __forceinline__ float sigmoidf_(float x) { return __builtin_amdgcn_rcpf(1.0f + __expf(-x)); }

constexpr int GLD = 72;
constexpr int G_AS = 256 * GLD;
constexpr int G_BS = 128 * GLD;

template <bool TR = false, class AL, class BL>
__device__ __forceinline__ void gemm_mainloop(u16* smem, int nk, AL aload, BL bload, f32x4 (&acc)[4][4]) {
    const int tid = tid_opaque(), lane = tid & 63, wid = tid >> 6;
    const int wm = wid >> 1, wn = wid & 1, fr = lane & 15, fq = lane >> 4;
    u16* As = smem; u16* Bs = smem + 2 * G_AS;
    const int arow = tid >> 3, akc = (tid & 7) * 8;
    uint4 ra[4], rb[2], ra2[4], rb2[2];
#pragma unroll
    for (int m = 0; m < 4; ++m)
#pragma unroll
        for (int n = 0; n < 4; ++n) acc[m][n] = f32x4{0.f, 0.f, 0.f, 0.f};
#define G_LOAD(RA, RB, KT) { _Pragma("unroll") for (int i = 0; i < 4; ++i) RA[i] = aload(i, arow + 64 * i, (KT) * 64 + akc); \
                             _Pragma("unroll") for (int i = 0; i < 2; ++i) RB[i] = bload(i, arow + 64 * i, (KT) * 64 + akc); }
#define G_STORE(RA, RB, BUF) { _Pragma("unroll") for (int i = 0; i < 4; ++i) *(uint4*)(As + (BUF) * G_AS + (arow + 64 * i) * GLD + akc) = RA[i]; \
                               _Pragma("unroll") for (int i = 0; i < 2; ++i) *(uint4*)(Bs + (BUF) * G_BS + (arow + 64 * i) * GLD + akc) = RB[i]; }
#define G_COMPUTE(BUF) { const u16* Ab = As + (BUF) * G_AS + (wm * 64 + fr) * GLD + fq * 8; const u16* Bb = Bs + (BUF) * G_BS + (wn * 64 + fr) * GLD + fq * 8; \
        _Pragma("unroll") for (int ks = 0; ks < 2; ++ks) { bf16x8 af[4], bfr[4]; \
            _Pragma("unroll") for (int m = 0; m < 4; ++m) af[m] = *(const bf16x8*)(Ab + m * 16 * GLD + ks * 32); \
            _Pragma("unroll") for (int n = 0; n < 4; ++n) bfr[n] = *(const bf16x8*)(Bb + n * 16 * GLD + ks * 32); \
            _Pragma("unroll") for (int m = 0; m < 4; ++m) _Pragma("unroll") for (int n = 0; n < 4; ++n) \
                acc[m][n] = TR ? __builtin_amdgcn_mfma_f32_16x16x32_bf16(bfr[n], af[m], acc[m][n], 0, 0, 0) : __builtin_amdgcn_mfma_f32_16x16x32_bf16(af[m], bfr[n], acc[m][n], 0, 0, 0); } }
    G_LOAD(ra, rb, 0)
    if (nk > 1) G_LOAD(ra2, rb2, 1)
    G_STORE(ra, rb, 0)
    if (nk > 2) G_LOAD(ra, rb, 2)
    __syncthreads();
#pragma unroll 1
    for (int kt = 0; kt < nk; kt += 2) {
        G_COMPUTE(0)
        if (kt + 1 < nk) G_STORE(ra2, rb2, 1)
        if (kt + 3 < nk) G_LOAD(ra2, rb2, kt + 3)
        __syncthreads();
        if (kt + 1 < nk) {
            G_COMPUTE(1)
            if (kt + 2 < nk) G_STORE(ra, rb, 0)
            if (kt + 4 < nk) G_LOAD(ra, rb, kt + 4)
            __syncthreads();
        }
    }
#undef G_LOAD
#undef G_STORE
#undef G_COMPUTE
}


namespace g8 {
#define G8_LAS __attribute__((address_space(3)))
constexpr int BM = 256, BK = 64, HALF = 128, HTB = HALF * BK * 2;
__device__ __forceinline__ int lds_byte(int r, int c) { const int st = (r >> 4) * 2 + (c >> 5), rr = r & 15, cc = c & 31, ob = rr * 64 + cc * 2; return st * 1024 + (ob ^ (((ob >> 9) & 1) << 5)); }
__device__ __forceinline__ void stage_rc(int b, int& R, int& C) { const int st = b / 1024, sb = b % 1024, swz = sb ^ (((sb >> 9) & 1) << 5); R = (st >> 1) * 16 + swz / 64; C = (st & 1) * 32 + (swz % 64) / 2; }
__device__ __forceinline__ int perm32(int rho) { const int n = rho >> 4, i = rho & 15; return 8 * (i >> 2) + 4 * n + (i & 3); }
struct Unit { const char* a; const char* b; int pm, pn, aux; };

template <bool PERM, bool GATHER, class Sched, class Epi>
__device__ __forceinline__ void gemm(G8_LAS unsigned char* lds, const int K, const int lda, const int ldb, const int* __restrict__ rowidx, const Sched& S, const Epi& E) {
    const int tid = tid_opaque(), wid = __builtin_amdgcn_readfirstlane(tid >> 6), lane = tid & 63, wr = wid >> 2, wc = wid & 3, fr = lane & 15, fq = lane >> 4;
    const int nt = K / BK;
    unsigned voffA[2], voffB[2];
#pragma unroll
    for (int i = 0; i < 2; ++i) { int R, C; stage_rc(tid * 16 + i * 8192, R, C); const int Rb = PERM ? ((R & ~31) + perm32(R & 31)) : R;
        voffA[i] = (unsigned)(R * lda + C) * 2u; voffB[i] = (unsigned)(Rb * ldb + C) * 2u; }
    const size_t kstep = (size_t)(BK * 2);
    const size_t hstepA = (size_t)HALF * lda * 2, hstepB = (size_t)HALF * ldb * 2;
    const unsigned ldsw = (unsigned)wid * 1024u;
    const int aoff = lds_byte(wr * 64 + fr, fq * 8), boff = lds_byte(wc * 32 + fr, fq * 8);
#define G8_SA(b, h) (((b) * 2 + (h)) * HTB)
#define G8_SB(b, h) ((4 + (b) * 2 + (h)) * HTB)
#define G8_STAGE(bufoff, gbase, voff) do { _Pragma("unroll") for (int _i = 0; _i < 2; ++_i) \
        __builtin_amdgcn_global_load_lds((const unsigned*)((const char*)(gbase) + (voff)[_i]), (G8_LAS unsigned*)(lds + (bufoff) + ldsw + _i * 8192), 16, 0, 0); } while (0)
#define G8_STAGE_A(bufoff, gbase, h, sel) do { if (GATHER) { _Pragma("unroll") for (int _i = 0; _i < 2; ++_i) \
        __builtin_amdgcn_global_load_lds((const unsigned*)((const char*)(gbase) + ((sel) ? goN[h][_i] : goC[h][_i])), (G8_LAS unsigned*)(lds + (bufoff) + ldsw + _i * 8192), 16, 0, 0); } \
        else G8_STAGE(bufoff, (gbase) + (h) * hstepA, voffA); } while (0)
#define G8_LDA(dst, b, h) do { _Pragma("unroll") for (int m = 0; m < 4; ++m) _Pragma("unroll") for (int k = 0; k < 2; ++k) dst[m][k] = *(const G8_LAS bf16x8*)(lds + G8_SA(b, h) + aoff + m * 2048 + k * 1024); } while (0)
#define G8_LDB(dst, b, h) do { _Pragma("unroll") for (int n = 0; n < 2; ++n) _Pragma("unroll") for (int k = 0; k < 2; ++k) dst[n][k] = *(const G8_LAS bf16x8*)(lds + G8_SB(b, h) + boff + n * 2048 + k * 1024); } while (0)
#define G8_MMA(ai, bj, At, Bt) do { __builtin_amdgcn_s_setprio(1); _Pragma("unroll") for (int m = 0; m < 4; ++m) _Pragma("unroll") for (int n = 0; n < 2; ++n) _Pragma("unroll") for (int k = 0; k < 2; ++k) \
        acc[ai][bj][m][n] = __builtin_amdgcn_mfma_f32_16x16x32_bf16(Bt[n][k], At[m][k], acc[ai][bj][m][n], 0, 0, 0); __builtin_amdgcn_s_setprio(0); } while (0)
#define G8_WAIT_V(n) asm volatile("s_waitcnt vmcnt(" #n ")" ::: "memory")
#define G8_WAIT_L(n) asm volatile("s_waitcnt lgkmcnt(" #n ")" ::: "memory")
#define G8_BAR __builtin_amdgcn_s_barrier()
#define G8_SCHED __builtin_amdgcn_sched_barrier(0)
    Unit cur, nxt; int ui = 0;
    if (!S(0, cur)) return;
    unsigned goC[2][2], goN[2][2];
#define G8_GOFF(go, u) do { if (GATHER) { const int tq_ = tid_opaque(); int ri_[2][2]; \
        _Pragma("unroll") for (int _i = 0; _i < 2; ++_i) { int R_, C_; stage_rc(tq_ * 16 + _i * 8192, R_, C_); \
            _Pragma("unroll") for (int h = 0; h < 2; ++h) ri_[h][_i] = rowidx[(u).aux + h * HALF + R_]; } \
        asm volatile("" : "+v"(ri_[0][0]), "+v"(ri_[0][1]), "+v"(ri_[1][0]), "+v"(ri_[1][1]));     \
        _Pragma("unroll") for (int _i = 0; _i < 2; ++_i) { int R_, C_; stage_rc(tq_ * 16 + _i * 8192, R_, C_); \
            _Pragma("unroll") for (int h = 0; h < 2; ++h) (go)[h][_i] = (unsigned)(ri_[h][_i] * lda + C_) * 2u; } } } while (0)
    G8_GOFF(goC, cur);
    f32x4 acc[2][2][4][2];
#pragma unroll
    for (int a = 0; a < 2; ++a)
#pragma unroll
        for (int b = 0; b < 2; ++b)
#pragma unroll
            for (int m = 0; m < 4; ++m)
#pragma unroll
                for (int n = 0; n < 2; ++n) acc[a][b][m][n] = f32x4{0.f, 0.f, 0.f, 0.f};
    bf16x8 At[4][2], B0[2][2], B1[2][2];
    const char* cA = cur.a; const char* cB = cur.b;
    G8_STAGE(G8_SB(0, 0), cB, voffB); G8_STAGE_A(G8_SA(0, 0), cA, 0, false); G8_STAGE(G8_SB(0, 1), cB + hstepB, voffB); G8_STAGE_A(G8_SA(0, 1), cA, 1, false);
    if (wr == 1) G8_BAR;
    G8_WAIT_V(4); G8_BAR;
    G8_STAGE(G8_SB(1, 0), cB + kstep, voffB); G8_STAGE_A(G8_SA(1, 0), cA + kstep, 0, false); G8_STAGE(G8_SB(1, 1), cB + hstepB + kstep, voffB);
    G8_WAIT_V(6); G8_BAR;
    for (;;) {
        const bool has_next = S(ui + 1, nxt);
        const char* nA = has_next ? nxt.a : cA; const char* nB = has_next ? nxt.b : cB;
        if (has_next) G8_GOFF(goN, nxt);
        else { _Pragma("unroll") for (int h = 0; h < 2; ++h) _Pragma("unroll") for (int _i = 0; _i < 2; ++_i) goN[h][_i] = goC[h][_i]; }
#pragma unroll 1
        for (int t = 0; t < nt; t += 2) {
            const bool last = (t == nt - 2);
            const char* a1 = cA + (size_t)(t + 1) * kstep;
            const char* a2 = last ? nA : cA + (size_t)(t + 2) * kstep; const char* b2 = last ? nB : cB + (size_t)(t + 2) * kstep;
            const char* a3 = a2 + kstep; const char* b3 = b2 + kstep;
            G8_LDB(B0, 0, 0); G8_SCHED; G8_LDA(At, 0, 0); G8_STAGE_A(G8_SA(1, 1), a1, 1, false);
            G8_WAIT_L(8); G8_BAR; G8_WAIT_L(0); G8_MMA(0, 0, At, B0); G8_BAR; G8_SCHED;
            G8_LDB(B1, 0, 1); G8_STAGE(G8_SB(0, 0), b2, voffB);
            G8_BAR; G8_WAIT_L(0); G8_MMA(0, 1, At, B1); G8_BAR;
            G8_LDA(At, 0, 1); G8_STAGE_A(G8_SA(0, 0), a2, 0, last);
            G8_BAR; G8_WAIT_L(0); G8_MMA(1, 0, At, B0); G8_BAR; G8_SCHED;
            G8_STAGE(G8_SB(0, 1), b2 + hstepB, voffB);
            G8_WAIT_V(6); G8_BAR; G8_MMA(1, 1, At, B1); G8_BAR;
            G8_LDB(B0, 1, 0); G8_SCHED; G8_LDA(At, 1, 0); G8_STAGE_A(G8_SA(0, 1), a2, 1, last);
            G8_WAIT_L(8); G8_BAR; G8_WAIT_L(0); G8_MMA(0, 0, At, B0); G8_BAR; G8_SCHED;
            G8_LDB(B1, 1, 1); G8_STAGE(G8_SB(1, 0), b3, voffB);
            G8_BAR; G8_WAIT_L(0); G8_MMA(0, 1, At, B1); G8_BAR;
            G8_LDA(At, 1, 1); G8_STAGE_A(G8_SA(1, 0), a3, 0, last);
            G8_BAR; G8_WAIT_L(0); G8_MMA(1, 0, At, B0); G8_BAR; G8_SCHED;
            G8_STAGE(G8_SB(1, 1), b3 + hstepB, voffB);
            G8_WAIT_V(6); G8_BAR; G8_MMA(1, 1, At, B1); G8_BAR;
        }
        E(acc, cur, wr, wc, fr, fq);
        if (!has_next) break;
#pragma unroll
        for (int a = 0; a < 2; ++a)
#pragma unroll
            for (int b = 0; b < 2; ++b)
#pragma unroll
                for (int m = 0; m < 4; ++m)
#pragma unroll
                    for (int n = 0; n < 2; ++n) acc[a][b][m][n] = f32x4{0.f, 0.f, 0.f, 0.f};
        cur = nxt; cA = nA; cB = nB; ++ui;
#pragma unroll
        for (int h = 0; h < 2; ++h)
#pragma unroll
            for (int _i = 0; _i < 2; ++_i) goC[h][_i] = goN[h][_i];
    }
    G8_WAIT_V(0);
    if (wr == 0) G8_BAR;
    G8_BAR;
#undef G8_SA
#undef G8_SB
#undef G8_STAGE
#undef G8_STAGE_A
#undef G8_LDA
#undef G8_LDB
#undef G8_MMA
#undef G8_WAIT_V
#undef G8_WAIT_L
#undef G8_BAR
#undef G8_SCHED
#undef G8_GOFF
}
}


struct SKTile { const u16* A; int lda; const u16* B; int ldb; int nk; };
template <bool TR, class Dec, class Epi>
__device__ __forceinline__ void gemm_smallk_loop(u16* smem, int ntiles, const Dec& dec, const Epi& epi) {
    const int tid = tid_opaque(), lane = tid & 63, wid = tid >> 6;
    const int wm = wid >> 1, wn = wid & 1, fr = lane & 15, fq = lane >> 4;
    u16* As = smem; u16* Bs = smem + 2 * G_AS;
    const int arow = tid >> 3, akc = (tid & 7) * 8;
    uint4 p0, p1, p2, p3, q0, q1, s0, s1, s2, s3, u0, u1;
    s0 = s1 = s2 = s3 = u0 = u1 = make_uint4(0u, 0u, 0u, 0u);
#define SK_LD(T, KO, A0, A1, A2, A3, B0, B1) { const u16* pa_ = (T).A + (size_t)arow * (T).lda + (KO) + akc; const u16* pb_ = (T).B + (size_t)arow * (T).ldb + (KO) + akc; \
        A0 = *(const uint4*)pa_; A1 = *(const uint4*)(pa_ + (size_t)64 * (T).lda); A2 = *(const uint4*)(pa_ + (size_t)128 * (T).lda); A3 = *(const uint4*)(pa_ + (size_t)192 * (T).lda); \
        B0 = *(const uint4*)pb_; B1 = *(const uint4*)(pb_ + (size_t)64 * (T).ldb); }
#define SK_ST(AS, BS, A0, A1, A2, A3, B0, B1) { *(uint4*)((AS) + arow * GLD + akc) = A0; *(uint4*)((AS) + (arow + 64) * GLD + akc) = A1; *(uint4*)((AS) + (arow + 128) * GLD + akc) = A2; \
        *(uint4*)((AS) + (arow + 192) * GLD + akc) = A3; *(uint4*)((BS) + arow * GLD + akc) = B0; *(uint4*)((BS) + (arow + 64) * GLD + akc) = B1; }
    if ((int)blockIdx.x >= ntiles) return;
    {
        const SKTile c0 = dec(blockIdx.x);
        SK_LD(c0, 0, p0, p1, p2, p3, q0, q1)
        if (c0.nk > 1) SK_LD(c0, 64, s0, s1, s2, s3, u0, u1)
    }
#pragma unroll 1
    for (int id = blockIdx.x; id < ntiles; id += gridDim.x) {
        const SKTile cur = dec(id);
        const int nk = cur.nk;
        SK_ST(As, Bs, p0, p1, p2, p3, q0, q1)
        if (nk > 1) SK_ST(As + G_AS, Bs + G_BS, s0, s1, s2, s3, u0, u1)
        __syncthreads();
        const int nid = id + gridDim.x;
        if (nid < ntiles) {
            const SKTile nxt = dec(nid);
            SK_LD(nxt, 0, p0, p1, p2, p3, q0, q1)
            if (nxt.nk > 1) SK_LD(nxt, 64, s0, s1, s2, s3, u0, u1)
        }
        f32x4 acc[4][4];
#pragma unroll
        for (int m = 0; m < 4; ++m)
#pragma unroll
            for (int n = 0; n < 4; ++n) acc[m][n] = f32x4{0.f, 0.f, 0.f, 0.f};
#pragma unroll 1
        for (int kt = 0; kt < nk; ++kt) {
            const u16* Ab = As + kt * G_AS + (wm * 64 + fr) * GLD + fq * 8; const u16* Bb = Bs + kt * G_BS + (wn * 64 + fr) * GLD + fq * 8;
#pragma unroll
            for (int ks = 0; ks < 2; ++ks) {
                bf16x8 af[4], bfr[4];
#pragma unroll
                for (int m = 0; m < 4; ++m) af[m] = *(const bf16x8*)(Ab + m * 16 * GLD + ks * 32);
#pragma unroll
                for (int n = 0; n < 4; ++n) bfr[n] = *(const bf16x8*)(Bb + n * 16 * GLD + ks * 32);
#pragma unroll
                for (int m = 0; m < 4; ++m)
#pragma unroll
                    for (int n = 0; n < 4; ++n)
                        acc[m][n] = TR ? __builtin_amdgcn_mfma_f32_16x16x32_bf16(bfr[n], af[m], acc[m][n], 0, 0, 0) : __builtin_amdgcn_mfma_f32_16x16x32_bf16(af[m], bfr[n], acc[m][n], 0, 0, 0);
            }
        }
        epi(id, acc);
        __syncthreads();
    }
#undef SK_LD
#undef SK_ST
}

struct RowLoad {
    const u16* base; size_t ld;
    __device__ __forceinline__ uint4 operator()(int, int row, int k) const { return *(const uint4*)(base + (size_t)row * ld + k); }
};

#define EPI_LOOP(...) \
    { const int tid_ = tid_opaque(); const int lane_ = tid_ & 63, wid_ = tid_ >> 6; const int wm_ = wid_ >> 1, wn_ = wid_ & 1, fr_ = lane_ & 15, fq_ = lane_ >> 4; \
      _Pragma("unroll") for (int m = 0; m < 4; ++m) _Pragma("unroll") for (int n = 0; n < 4; ++n) _Pragma("unroll") for (int j = 0; j < 4; ++j) { \
          const int r = wm_ * 64 + m * 16 + fq_ * 4 + j; const int c = wn_ * 64 + n * 16 + fr_; const float v = acc[m][n][j]; __VA_ARGS__ } }

#define EPI_T(...) \
    { const int tid_ = tid_opaque(); const int lane_ = tid_ & 63, wid_ = tid_ >> 6; const int wm_ = wid_ >> 1, wn_ = wid_ & 1, fr_ = lane_ & 15, fq_ = lane_ >> 4; \
      _Pragma("unroll") for (int m = 0; m < 4; ++m) _Pragma("unroll") for (int n = 0; n < 4; ++n) { \
          const int r = wm_ * 64 + m * 16 + fr_; const int c0 = wn_ * 64 + n * 16 + fq_ * 4; const f32x4 v = acc[m][n]; __VA_ARGS__ } }
__device__ __forceinline__ uint2 pack4(const f32x4 v) { return make_uint2(pack2(v[0], v[1]), pack2(v[2], v[3])); }

__device__ __forceinline__ void conv_wave(const float* __restrict__ src, int K, int N, int f0, u16* __restrict__ dst, int ldd, int mapkind, int lane, float* tile) {
    const float* s = src + f0 + lane;
    for (int k0 = 0; k0 < K; k0 += 64) {
#pragma unroll 16
        for (int r = 0; r < 64; ++r) tile[r * 65 + lane] = s[(size_t)(k0 + r) * N];
        asm volatile("s_waitcnt lgkmcnt(0)" ::: "memory");
#pragma unroll 2
        for (int c = 0; c < 8; ++c) {
            const int id = c * 64 + lane, fl = id >> 3, kc = id & 7;
            float v[8];
#pragma unroll
            for (int e = 0; e < 8; ++e) v[e] = tile[(kc * 8 + e) * 65 + fl];
            const int f = f0 + fl;
            int r = f;
            if (mapkind != 0) r = ((f >> 7) * 256) + (f & 127) + (mapkind == 2 ? 128 : 0);
            uint4 o; o.x = pack2(v[0], v[1]); o.y = pack2(v[2], v[3]); o.z = pack2(v[4], v[5]); o.w = pack2(v[6], v[7]);
            *(uint4*)(dst + (size_t)r * ldd + k0 + kc * 8) = o;
        }
        asm volatile("s_waitcnt lgkmcnt(0)" ::: "memory");
    }
}

__device__ __forceinline__ void phase_prologue_a(const PP p, char* smem) {
    const int t = tid_opaque(), lane = t & 63, wid = t >> 6;
    float* cs = (float*)smem;
    float* red = cs + 2048;
    for (int i = t; i < 2048; i += NTHR) { const float c = p.in(1)[i]; cs[i] = c / (1.0f + __expf(-c)); }
    __syncthreads();
    float* ada = (float*)(p.ws() + OFF_ADA);
    for (int item = blockIdx.x; item < 192; item += gridDim.x) {
        const int l = item / 48, cg = item % 48, cl = t & 127, kc = t >> 7;
        const int col = cg * 128 + cl;
        const float* w = p.in(2) + (size_t)l * 1024 * 6144 + col;
        float a0 = 0.f, a1 = 0.f;
#pragma unroll 8
        for (int k = kc * 256; k < kc * 256 + 256; ++k) { const float wv = w[(size_t)k * 6144]; a0 += cs[k] * wv; a1 += cs[1024 + k] * wv; }
        red[(kc * 128 + cl) * 2 + 0] = a0; red[(kc * 128 + cl) * 2 + 1] = a1;
        __syncthreads();
        if (t < 256) {
            const int b = t >> 7, c2 = t & 127;
            float s = 0.f;
            for (int q = 0; q < 4; ++q) s += red[(q * 128 + c2) * 2 + b];
            ada[(size_t)(l * 2 + b) * 6144 + cg * 128 + c2] = s + p.in(3)[(size_t)l * 6144 + cg * 128 + c2];
        }
        __syncthreads();
    }
    const int gw = blockIdx.x * 8 + wid, gstride = gridDim.x * 8;
    float* tile = (float*)smem + wid * (64 * 65);
    u16* WGU = (u16*)(p.ws() + OFF_WGU); u16* WD = (u16*)(p.ws() + OFF_WD);
    for (int w = gw; w < 256; w += gstride) {
        u16* d = WGU + (size_t)(w >> 1) * 1536 * 1024 + (size_t)(5 * 256 + (w & 1) * 128 + 64) * 1024;
        for (int q = lane; q < 64 * 1024 / 8; q += 64) *(uint4*)(d + (size_t)q * 8) = make_uint4(0u, 0u, 0u, 0u);
    }
    for (int w = gw; w < 5340; w += gstride) {
        if (w < 1408) { const int j = w / 11, g = w % 11; conv_wave(p.in(8) + (size_t)j * 1024 * 704, 1024, 704, g * 64, WGU + (size_t)j * 1536 * 1024, 1024, 1, lane, tile); }
        else if (w < 2816) { const int w2 = w - 1408; const int j = w2 / 11, g = w2 % 11; conv_wave(p.in(9) + (size_t)j * 1024 * 704, 1024, 704, g * 64, WGU + (size_t)j * 1536 * 1024, 1024, 2, lane, tile); }
        else if (w < 4864) { const int w2 = w - 2816; const int j = w2 >> 4, g = w2 & 15; conv_wave(p.in(10) + (size_t)j * 704 * 1024, 704, 1024, g * 64, WD + (size_t)j * 1024 * 704, 704, 0, lane, tile); }
        else {
            int w2 = w - 4864;
            if (w2 < 108) { const int j = w2 / 54, g = w2 % 54; conv_wave(p.in(11) + (size_t)j * 1024 * ABP, 1024, ABP, g * 64, (u16*)(p.ws() + OFF_WINE) + (size_t)j * 3584 * 1024, 1024, 0, lane, tile); continue; }
            w2 -= 108;
            if (w2 < 32) { const int j = w2 >> 4, g = w2 & 15; conv_wave(p.in(12) + (size_t)j * 1024 * 1024, 1024, 1024, g * 64, (u16*)(p.ws() + OFF_WOUTE) + (size_t)j * 1024 * 1024, 1024, 0, lane, tile); continue; }
            w2 -= 32;
            if (w2 < 96) { const int j = w2 / 48, g = w2 % 48; conv_wave(p.in(25) + (size_t)j * 1024 * 3072, 1024, 3072, g * 64, (u16*)(p.ws() + OFF_WINH) + (size_t)j * 3072 * 1024, 1024, 0, lane, tile); continue; }
            w2 -= 96;
            if (w2 < 32) { const int j = w2 >> 4, g = w2 & 15; conv_wave(p.in(37) + (size_t)j * 1024 * 1024, 1024, 1024, g * 64, (u16*)(p.ws() + OFF_WOUTH) + (size_t)j * 1024 * 1024, 1024, 0, lane, tile); continue; }
            w2 -= 32;
            if (w2 < 32) { const int j = w2 >> 3, g = w2 & 7; conv_wave(p.in(16) + (size_t)j * 64 * 512, 64, 512, g * 64, (u16*)(p.ws() + OFF_WUP) + (size_t)j * 512 * 64, 64, 0, lane, tile); continue; }
            w2 -= 32;
            if (w2 < 32) { const int j = w2 >> 3, g = w2 & 7; conv_wave(p.in(18) + (size_t)j * 64 * 512, 64, 512, g * 64, (u16*)(p.ws() + OFF_AUP) + (size_t)j * 512 * 64, 64, 0, lane, tile); continue; }
            w2 -= 32;
            if (w2 < 16) { const int j = w2 >> 3, g = w2 & 7; conv_wave(p.in(19) + (size_t)j * 128 * 512, 128, 512, g * 64, (u16*)(p.ws() + OFF_GUP) + (size_t)j * 512 * 128, 128, 0, lane, tile); continue; }
            w2 -= 16;
            { const int j = w2 >> 6, g = w2 & 63; conv_wave(p.in(35) + (size_t)j * 64 * 4096, 64, 4096, g * 64, (u16*)(p.ws() + OFF_W4T) + (size_t)j * 4096 * 64, 64, 0, lane, tile); }
        }
    }
}

__device__ __forceinline__ void phase_prologue_b(const PP p) {
    const float* ada = (const float*)(p.ws() + OFF_ADA);
    const float4* xin = (const float4*)p.in(0);
    uint2* xo = (uint2*)((u16*)p.out() + (size_t)T_ * 1024);
    uint2* hb = (uint2*)(p.ws() + OFF_HBUF);
    const int gsz = gridDim.x * NTHR;
    const int t0_ = tid_opaque();
    const int idx0 = blockIdx.x * NTHR + t0_, c4 = (idx0 & 255) * 4;
    const float4 sh0 = *(const float4*)(ada + c4), sc0 = *(const float4*)(ada + 1024 + c4);
    const float4 sh1 = *(const float4*)(ada + 6144 + c4), sc1 = *(const float4*)(ada + 6144 + 1024 + c4);
#pragma unroll 1
    for (int base = idx0; base < T_ * 256; base += 8 * gsz) {
        float4 v[8];
#pragma unroll
        for (int j = 0; j < 8; ++j) { const int idx = min(base + j * gsz, T_ * 256 - 1); v[j] = xin[idx]; }
        __builtin_amdgcn_sched_barrier(0);
#pragma unroll
        for (int j = 0; j < 8; ++j) {
            const int idx = base + j * gsz;
            if (idx < T_ * 256) {
                const bool b1 = (idx >> 8) >= L_;
                const float4 sh = b1 ? sh1 : sh0, sc = b1 ? sc1 : sc0;
                xo[idx] = make_uint2(pack2(v[j].x, v[j].y), pack2(v[j].z, v[j].w));
                uint2 o;
                o.x = pack2(v[j].x * (1.f + sc.x) + sh.x, v[j].y * (1.f + sc.y) + sh.y);
                o.y = pack2(v[j].z * (1.f + sc.z) + sh.z, v[j].w * (1.f + sc.w) + sh.w);
                hb[idx] = o;
            }
        }
    }
}


__device__ __forceinline__ bool xcd_deal(int i, int U, int& id) {
    int G = gridDim.x; asm volatile("" : "+s"(G));
    int bx = blockIdx.x; asm volatile("" : "+s"(bx));
    if (G & 7) { id = bx + i * G; return id < U; }
    const int x = bx & 7, r = bx >> 3, nper = G >> 3;
    const int q = U >> 3, rem = U & 7;
    const int cnt = q + (x < rem ? 1 : 0), start = x * q + min(x, rem);
    const int j = r + i * nper;
    id = start + j;
    return j < cnt;
}
struct SchedGrid {
    const char* A; const char* B; int nunits, npn; size_t astep, bstep; int npm_cm = 0;
    __device__ __forceinline__ bool operator()(int i, g8::Unit& u) const {
        int id; if (!xcd_deal(i, nunits, id)) return false;
        if (npm_cm > 0) { u.pn = id / npm_cm; u.pm = id - u.pn * npm_cm; }
        else { u.pm = id / npn; u.pn = id - u.pm * npn; } u.a = A + (size_t)u.pm * astep; u.b = B + (size_t)u.pn * bstep; u.aux = 0; return true;
    }
};
struct EpiBf16Rows {
    u16* O; size_t ld; int ncols;
    __device__ __forceinline__ void operator()(const f32x4 (&acc)[2][2][4][2], const g8::Unit& u, int wr, int wc, int fr, int fq) const {
#pragma unroll
        for (int ai = 0; ai < 2; ++ai)
#pragma unroll
            for (int m = 0; m < 4; ++m) {
                const size_t row = (size_t)u.pm * 256 + ai * 128 + wr * 64 + m * 16 + fr;
#pragma unroll
                for (int bj = 0; bj < 2; ++bj) {
                    const int col = u.pn * 256 + bj * 128 + wc * 32 + fq * 8;
                    if (col < ncols) {
                        const f32x4 v0 = acc[ai][bj][m][0], v1 = acc[ai][bj][m][1];
                        *(uint4*)(O + row * ld + col) = make_uint4(pack2(v0[0], v0[1]), pack2(v0[2], v0[3]), pack2(v1[0], v1[1]), pack2(v1[2], v1[3]));
                    }
                }
            }
    }
};
__device__ __forceinline__ void phase_g1(const PP p, char* smem, int i) {
    SchedGrid S; S.A = p.ws() + OFF_HBUF; S.B = p.ws() + OFF_WINE + (size_t)i * 3584 * 1024 * 2; S.nunits = 128 * 14; S.npn = 14;
    S.astep = (size_t)256 * 1024 * 2; S.bstep = (size_t)256 * 1024 * 2;
    EpiBf16Rows E; E.O = (u16*)(p.ws() + OFF_P); E.ld = ABP; E.ncols = ABP;
    g8::gemm<true, false>((G8_LAS unsigned char*)smem, 1024, 1024, 1024, nullptr, S, E);
}

__device__ __forceinline__ void na_tr3(unsigned a0, unsigned a1, unsigned a2, uint2& r0, uint2& r1, uint2& r2) {
    asm volatile("ds_read_b64_tr_b16 %0, %3\n\tds_read_b64_tr_b16 %1, %4\n\tds_read_b64_tr_b16 %2, %5\n\ts_waitcnt lgkmcnt(0)"
                 : "=&v"(r0), "=&v"(r1), "=&v"(r2) : "v"(a0), "v"(a1), "v"(a2) : "memory");
}
__device__ __forceinline__ void phase_na(const PP p, char* smem, int i) {
    const int t_outer = tid_opaque(); int t = t_outer; const int lane = t & 63, h = t >> 6, fr = lane & 15, g = lane >> 4;
    const u16* pp = (const u16*)(p.ws() + OFF_P);
    u16* mix = (u16*)(p.ws() + OFF_MIX);
    u16* Ks = (u16*)smem;
    u16* Vs = Ks + 48 * 520;
    float* rpb = (float*)(smem + 2 * 48 * 520 * 2);
    __syncthreads();
    for (int idx = t; idx < 8 * 15 * 31; idx += NTHR) rpb[idx] = p.in(13)[(size_t)i * 3720 + idx];
    { unsigned z_ = 0u; asm volatile("" : "+v"(z_));
      for (int idx = t; idx < 2 * 8 * 65; idx += NTHR) { const int m = idx / 520, rr = (idx % 520) / 65, cch = idx % 65; *(uint4*)((m ? Vs : Ks) + (40 + rr) * 520 + cch * 8) = make_uint4(z_, z_, z_, z_); } }
    const unsigned vs_addr = (unsigned)(size_t)Vs;
    for (int k_ = 0, item = 0; xcd_deal(k_, 1024, item); ++k_) {
        const int b = item >> 9, gi = (item >> 1) & 255, hr = item & 1;
        const int kb = hr * 24;
        const int rs = min(max(gi - 4, 0), 248);
        bf16x8 qb[2][2];
        int jq[2], cs[2];
#pragma unroll
        for (int nt = 0; nt < 2; ++nt) {
            jq[nt] = hr * 32 + 16 * nt + fr; cs[nt] = min(max(jq[nt] - 8, 0), 48);
            const u16* qrow = pp + ((size_t)b * L_ + gi * 64 + jq[nt]) * ABP + h * 64 + 8 * g;
            qb[nt][0] = *(const bf16x8*)qrow; qb[nt][1] = *(const bf16x8*)(qrow + 32);
        }
        f32x4 oacc[4][2];
#pragma unroll
        for (int dt = 0; dt < 4; ++dt)
#pragma unroll
            for (int nt = 0; nt < 2; ++nt) oacc[dt][nt] = f32x4{0.f, 0.f, 0.f, 0.f};
        float m_run[2] = {-1e30f, -1e30f}, l_run[2] = {0.f, 0.f};
        uint4 g0, g1, g2, g3, g4, g5, g6, g7, g8, g9;
#define NA_SRC(X, RR) (pp + ((size_t)b * L_ + (rs + (RR)) * 64 + kb + (((t + NTHR * (X)) - ((t + NTHR * (X)) >= 2560 ? 2560 : 0)) >> 6)) * ABP + 512 + ((t + NTHR * (X)) >= 2560 ? 512 : 0) + ((t + NTHR * (X)) & 63) * 8)
#define NA_DST(X) (((t + NTHR * (X)) >= 2560 ? Vs : Ks) + (((t + NTHR * (X)) - ((t + NTHR * (X)) >= 2560 ? 2560 : 0)) >> 6) * 520 + ((t + NTHR * (X)) & 63) * 8)
#define NA_LOAD(RR) { g0 = *(const uint4*)NA_SRC(0, RR); g1 = *(const uint4*)NA_SRC(1, RR); g2 = *(const uint4*)NA_SRC(2, RR); g3 = *(const uint4*)NA_SRC(3, RR); g4 = *(const uint4*)NA_SRC(4, RR); \
                      g5 = *(const uint4*)NA_SRC(5, RR); g6 = *(const uint4*)NA_SRC(6, RR); g7 = *(const uint4*)NA_SRC(7, RR); g8 = *(const uint4*)NA_SRC(8, RR); g9 = *(const uint4*)NA_SRC(9, RR); }
        NA_LOAD(0)
#pragma unroll 1
        for (int r = 0; r < 8; ++r) {
            t = t_outer; asm volatile("" : "+v"(t));
            __syncthreads();
            *(uint4*)NA_DST(0) = g0; *(uint4*)NA_DST(1) = g1; *(uint4*)NA_DST(2) = g2; *(uint4*)NA_DST(3) = g3; *(uint4*)NA_DST(4) = g4;
            *(uint4*)NA_DST(5) = g5; *(uint4*)NA_DST(6) = g6; *(uint4*)NA_DST(7) = g7; *(uint4*)NA_DST(8) = g8; *(uint4*)NA_DST(9) = g9;
            __syncthreads();
            if (r + 1 < 8) NA_LOAD(r + 1)
            f32x4 st[3][2];
#pragma unroll
            for (int mt = 0; mt < 3; ++mt) {
                st[mt][0] = f32x4{0.f, 0.f, 0.f, 0.f}; st[mt][1] = f32x4{0.f, 0.f, 0.f, 0.f};
#pragma unroll
                for (int s = 0; s < 2; ++s) {
                    const bf16x8 ka = *(const bf16x8*)(Ks + (16 * mt + fr) * 520 + h * 64 + 32 * s + 8 * g);
                    st[mt][0] = __builtin_amdgcn_mfma_f32_16x16x32_bf16(ka, qb[0][s], st[mt][0], 0, 0, 0);
                    st[mt][1] = __builtin_amdgcn_mfma_f32_16x16x32_bf16(ka, qb[1][s], st[mt][1], 0, 0, 0);
                }
            }
            const float* brow = rpb + (h * 15 + (rs + r - gi + 7)) * 31;
            bf16x8 pb[2][2];
#pragma unroll
            for (int nt = 0; nt < 2; ++nt) {
                float mx = -1e30f;
#pragma unroll
                for (int mt = 0; mt < 3; ++mt)
#pragma unroll
                    for (int jj = 0; jj < 4; ++jj) {
                        const int kc = kb + 16 * mt + 4 * g + jj;
                        const bool valid = (kc >= cs[nt]) && (kc < cs[nt] + 16) && (16 * mt + 4 * g + jj < 40);
                        const int bi = min(max(kc - jq[nt] + 15, 0), 30);
                        const float sv = valid ? (st[mt][nt][jj] * 0.125f + brow[bi]) : -1e30f;
                        st[mt][nt][jj] = sv; mx = fmaxf(mx, sv);
                    }
                mx = fmaxf(mx, __shfl_xor(mx, 16)); mx = fmaxf(mx, __shfl_xor(mx, 32));
                const float m_new = fmaxf(m_run[nt], mx);
                const float sc = __expf(m_run[nt] - m_new);
                m_run[nt] = m_new;
                float psum = 0.f;
#pragma unroll
                for (int mt = 0; mt < 3; ++mt)
#pragma unroll
                    for (int jj = 0; jj < 4; ++jj) { const float sv = st[mt][nt][jj]; const float pr = (sv > -1e29f) ? __expf(sv - m_new) : 0.f; st[mt][nt][jj] = pr; psum += pr; }
                psum += __shfl_xor(psum, 16); psum += __shfl_xor(psum, 32);
                l_run[nt] = l_run[nt] * sc + psum;
#pragma unroll
                for (int dt = 0; dt < 4; ++dt) oacc[dt][nt] *= sc;
                union { bf16x8 v; unsigned u[4]; } c0, c1;
                c0.u[0] = pack2(st[0][nt][0], st[0][nt][1]); c0.u[1] = pack2(st[0][nt][2], st[0][nt][3]);
                c0.u[2] = pack2(st[1][nt][0], st[1][nt][1]); c0.u[3] = pack2(st[1][nt][2], st[1][nt][3]);
                c1.u[0] = pack2(st[2][nt][0], st[2][nt][1]); c1.u[1] = pack2(st[2][nt][2], st[2][nt][3]); c1.u[2] = 0u; c1.u[3] = 0u;
                pb[nt][0] = c0.v; pb[nt][1] = c1.v;
            }
            {
                const int q4 = fr >> 2, p4 = fr & 3;
#pragma unroll
                for (int dt = 0; dt < 4; ++dt) {
                    const unsigned base = vs_addr + (unsigned)(((4 * g + q4) * 520 + h * 64 + 16 * dt + 4 * p4) * 2);
                    uint2 r0, r1, r2;
                    na_tr3(base, base + 16 * 520 * 2, base + 32 * 520 * 2, r0, r1, r2);
                    union { bf16x8 v; unsigned u[4]; } a0, a1;
                    a0.u[0] = r0.x; a0.u[1] = r0.y; a0.u[2] = r1.x; a0.u[3] = r1.y;
                    a1.u[0] = r2.x; a1.u[1] = r2.y; a1.u[2] = 0u; a1.u[3] = 0u;
#pragma unroll
                    for (int nt = 0; nt < 2; ++nt) {
                        oacc[dt][nt] = __builtin_amdgcn_mfma_f32_16x16x32_bf16(a0.v, pb[nt][0], oacc[dt][nt], 0, 0, 0);
                        oacc[dt][nt] = __builtin_amdgcn_mfma_f32_16x16x32_bf16(a1.v, pb[nt][1], oacc[dt][nt], 0, 0, 0);
                    }
                }
            }
        }
#undef NA_LOAD
#undef NA_SRC
#undef NA_DST
#pragma unroll
        for (int nt = 0; nt < 2; ++nt) {
            const float inv = 1.0f / l_run[nt];
            u16* orow = mix + ((size_t)b * L_ + gi * 64 + jq[nt]) * 1024 + h * 64 + 4 * g;
#pragma unroll
            for (int dt = 0; dt < 4; ++dt)
                *(uint2*)(orow + 16 * dt) = make_uint2(pack2(oacc[dt][nt][0] * inv, oacc[dt][nt][1] * inv), pack2(oacc[dt][nt][2] * inv, oacc[dt][nt][3] * inv));
        }
    }
}

__device__ __forceinline__ void phase_rwprep(const PP p, int i) {
    const int t = tid_opaque(); const int lane = t & 63, wid = t >> 6;
    const u16* pp = (const u16*)(p.ws() + OFF_P);
    const float* mu = p.in(14) + (size_t)i * 2 * 1920;
    const float* kkw = p.in(20) + (size_t)i * 512;
    u16* R = (u16*)(p.ws() + RW_R); u16* V = (u16*)(p.ws() + RW_V); u16* KK = (u16*)(p.ws() + RW_KK);
    u16* KP = (u16*)(p.ws() + O_KP); u16* AWD = (u16*)(p.ws() + O_AWD); u16* AAD = (u16*)(p.ws() + O_AAD); u16* AGD = (u16*)(p.ws() + O_AGD);
    const int nw = gridDim.x * 8, per = (T_ + nw - 1) / nw;
    const int tok0 = (blockIdx.x * 8 + wid) * per, tok1 = min(tok0 + per, T_);
    if (tok0 >= tok1) return;
    float m0[30], m1[30];
#pragma unroll
    for (int ii = 0; ii < 30; ++ii) { m0[ii] = mu[lane + 64 * ii]; m1[ii] = mu[1920 + lane + 64 * ii]; }
    u16 rp[30], rc[30], rn[30];
    {
        const u16* cur = pp + (size_t)tok0 * ABP + 1536;
        const bool hasp = (tok0 & (L_ - 1)) > 0;
#pragma unroll
        for (int ii = 0; ii < 30; ++ii) { rc[ii] = cur[lane + 64 * ii]; rp[ii] = hasp ? cur[lane + 64 * ii - ABP] : (u16)0; }
    }
#pragma unroll 1
    for (int tok = tok0; tok < tok1; ++tok) {
        const int l = tok & (L_ - 1);
        const bool hasn = l < L_ - 1, hasp = l > 0;
        const u16* cur = pp + (size_t)tok * ABP + 1536;
        if (tok + 1 < T_) {
#pragma unroll
            for (int ii = 0; ii < 30; ++ii) rn[ii] = cur[lane + 64 * ii + ABP];
        }
#pragma unroll
        for (int ii = 0; ii < 30; ++ii) {
            const int col = lane + 64 * ii;
            const float c = bf2f(rc[ii]);
            const float pv = hasp ? bf2f(rp[ii]) : 0.f;
            const float nv = hasn ? bf2f(rn[ii]) : 0.f;
            const float x = c + m0[ii] * (pv - c) + m1[ii] * (nv - c);
            if (ii < 8) R[(size_t)tok * 512 + col] = f2bf(x);
            else if (ii < 16) {
                const int kc = col - 512;
                KP[(size_t)tok * 512 + kc] = f2bf(x);
                const float kv = x * kkw[kc];
                const float ss = wave_sum(kv * kv);
                KK[(size_t)tok * 512 + kc] = f2bf(kv * rsqrtf(ss + 1e-12f));
            }
            else if (ii < 24) V[(size_t)tok * 512 + col - 1024] = f2bf(x);
            else if (ii < 26) AWD[(size_t)tok * 128 + col - 1536] = f2bf(tanhf(x));
            else if (ii < 28) AAD[(size_t)tok * 128 + col - 1664] = f2bf(x);
            else AGD[(size_t)tok * 128 + col - 1792] = f2bf(sigmoidf_(x));
        }
#pragma unroll
        for (int ii = 0; ii < 30; ++ii) { rp[ii] = rc[ii]; rc[ii] = rn[ii]; }
    }
}

__device__ __forceinline__ void phase_lora(const PP p, char* smem, int i) {
    const u16* AWD = (const u16*)(p.ws() + O_AWD); const u16* AAD = (const u16*)(p.ws() + O_AAD); const u16* AGD = (const u16*)(p.ws() + O_AGD);
    const u16* KP = (const u16*)(p.ws() + O_KP); const u16* KK = (const u16*)(p.ws() + RW_KK);
    __half* Wb = (__half*)(p.ws() + RW_W); u16* KD = (u16*)(p.ws() + RW_KD); u16* BQ = (u16*)(p.ws() + RW_BQ); u16* G = (u16*)(p.ws() + RW_G);
    const u16* WUPp = (const u16*)(p.ws() + OFF_WUP); const u16* AUPp = (const u16*)(p.ws() + OFF_AUP); const u16* GUPp = (const u16*)(p.ws() + OFF_GUP);
    const float* w0b = p.in(15) + (size_t)i * 1024; const float* a0b = p.in(17) + (size_t)i * 1024; const float* ka = p.in(21) + (size_t)i * 512;
    auto dec = [&](int id) __attribute__((always_inline)) {
        const int sub = id >> 9, rem = id & 511, tm = rem >> 2, tn = rem & 3;
        SKTile tl;
        if (sub < 2)      { tl.A = AWD + (size_t)tm * 256 * 128 + sub * 64; tl.lda = 128; tl.B = WUPp + ((size_t)(i * 2 + sub) * 512 + tn * 128) * 64; tl.ldb = 64; tl.nk = 1; }
        else if (sub < 4) { tl.A = AAD + (size_t)tm * 256 * 128 + (sub - 2) * 64; tl.lda = 128; tl.B = AUPp + ((size_t)(i * 2 + sub - 2) * 512 + tn * 128) * 64; tl.ldb = 64; tl.nk = 1; }
        else              { tl.A = AGD + (size_t)tm * 256 * 128; tl.lda = 128; tl.B = GUPp + ((size_t)i * 512 + tn * 128) * 128; tl.ldb = 128; tl.nk = 2; }
        return tl;
    };
    auto epi = [&](int id, f32x4 (&acc)[4][4]) __attribute__((always_inline)) {
        const int sub = id >> 9, rem = id & 511, tm = rem >> 2, tn = rem & 3;
        const int tid_ = tid_opaque(); const int lane_ = tid_ & 63, wid_ = tid_ >> 6; const int wm_ = wid_ >> 1, wn_ = wid_ & 1, fr_ = lane_ & 15, fq_ = lane_ >> 4;
        if (sub < 2) {
            const int d = sub; const float* w0 = w0b + d * 512;
            float4 w0v[4];
#pragma unroll
            for (int n = 0; n < 4; ++n) w0v[n] = *(const float4*)(w0 + tn * 128 + wn_ * 64 + n * 16 + fq_ * 4);
            __builtin_amdgcn_sched_barrier(0);
#pragma unroll
            for (int m = 0; m < 4; ++m)
#pragma unroll
                for (int n = 0; n < 4; ++n) {
                    const int col = tn * 128 + wn_ * 64 + n * 16 + fq_ * 4; const size_t tok = (size_t)tm * 256 + wm_ * 64 + m * 16 + fr_; const f32x4 v = acc[m][n];
                    const __half2 h0 = __floats2half2_rn(__expf(-0.606531f * sigmoidf_(w0v[n].x + v[0])), __expf(-0.606531f * sigmoidf_(w0v[n].y + v[1])));
                    const __half2 h1 = __floats2half2_rn(__expf(-0.606531f * sigmoidf_(w0v[n].z + v[2])), __expf(-0.606531f * sigmoidf_(w0v[n].w + v[3])));
                    uint2 o; o.x = *(const unsigned*)&h0; o.y = *(const unsigned*)&h1;
                    *(uint2*)(Wb + (tok * 2 + d) * 512 + col) = o;
                }
        } else if (sub < 4) {
            const int d = sub - 2; const float* a0 = a0b + d * 512;
            float4 a0v[4], kav[4];
#pragma unroll
            for (int n = 0; n < 4; ++n) { const int col = tn * 128 + wn_ * 64 + n * 16 + fq_ * 4; a0v[n] = *(const float4*)(a0 + col); kav[n] = *(const float4*)(ka + col); }
#pragma unroll
            for (int m = 0; m < 4; ++m) {
                const size_t tok = (size_t)tm * 256 + wm_ * 64 + m * 16 + fr_;
                uint2 kpu[4], kku[4];
#pragma unroll
                for (int n = 0; n < 4; ++n) { const int col = tn * 128 + wn_ * 64 + n * 16 + fq_ * 4; kpu[n] = *(const uint2*)(KP + tok * 512 + col); kku[n] = *(const uint2*)(KK + tok * 512 + col); }
                __builtin_amdgcn_sched_barrier(0);
#pragma unroll
                for (int n = 0; n < 4; ++n) {
                    const int col = tn * 128 + wn_ * 64 + n * 16 + fq_ * 4; const f32x4 v = acc[m][n];
                    const float i0 = sigmoidf_(a0v[n].x + v[0]), i1 = sigmoidf_(a0v[n].y + v[1]), i2 = sigmoidf_(a0v[n].z + v[2]), i3 = sigmoidf_(a0v[n].w + v[3]);
                    uint2 okd, obq;
                    okd.x = pack2(lo2f(kpu[n].x) * (1.0f + (i0 - 1.0f) * kav[n].x), hi2f(kpu[n].x) * (1.0f + (i1 - 1.0f) * kav[n].y));
                    okd.y = pack2(lo2f(kpu[n].y) * (1.0f + (i2 - 1.0f) * kav[n].z), hi2f(kpu[n].y) * (1.0f + (i3 - 1.0f) * kav[n].w));
                    obq.x = pack2(lo2f(kku[n].x) * i0, hi2f(kku[n].x) * i1); obq.y = pack2(lo2f(kku[n].y) * i2, hi2f(kku[n].y) * i3);
                    *(uint2*)(KD + (tok * 2 + d) * 512 + col) = okd; *(uint2*)(BQ + (tok * 2 + d) * 512 + col) = obq;
                }
            }
        } else {
            EPI_T( *(uint2*)(G + ((size_t)tm * 256 + r) * 512 + tn * 128 + c0) = pack4(v); )
        }
    };
    gemm_smallk_loop<true>((u16*)smem, 2560, dec, epi);
}

constexpr size_t SC_PM = OFF_P;
constexpr size_t SC_OM = OFF_P + ((size_t)64 << 20);
constexpr size_t SC_QM = OFF_P + ((size_t)128 << 20);
constexpr size_t SC_OL = OFF_HBUF;
constexpr size_t SC_PG = OFF_P + ((size_t)192 << 20);
constexpr size_t SC_QG = SC_PG + ((size_t)4 << 20);
__device__ __forceinline__ int kpos(int kp) { const int kk = kp & 31; return (kp & 32) + ((kk & 15) >> 2) * 8 + (kk >> 4) * 4 + (kk & 3); }
__device__ __forceinline__ f32x4 mm64(const u16* A, const u16* Bt, int m, int n, int fr, int fq, f32x4 acc) {
#pragma unroll
    for (int s2 = 0; s2 < 2; ++s2) {
        const bf16x8 af = *(const bf16x8*)(A + (m * 16 + fr) * 72 + s2 * 32 + fq * 8);
        const bf16x8 bf = *(const bf16x8*)(Bt + (n * 16 + fr) * 72 + s2 * 32 + fq * 8);
        acc = __builtin_amdgcn_mfma_f32_16x16x32_bf16(af, bf, acc, 0, 0, 0);
    }
    return acc;
}
__device__ __forceinline__ void mm64x4(const u16* A, const u16* Bt, int m, int fr, int fq, f32x4 (&acc)[4]) {
    bf16x8 af[2], bf[4][2];
#pragma unroll
    for (int s2 = 0; s2 < 2; ++s2) af[s2] = *(const bf16x8*)(A + (m * 16 + fr) * 72 + s2 * 32 + fq * 8);
#pragma unroll
    for (int n = 0; n < 4; ++n)
#pragma unroll
        for (int s2 = 0; s2 < 2; ++s2) bf[n][s2] = *(const bf16x8*)(Bt + (n * 16 + fr) * 72 + s2 * 32 + fq * 8);
    __builtin_amdgcn_sched_barrier(0);
#pragma unroll
    for (int s2 = 0; s2 < 2; ++s2)
#pragma unroll
        for (int n = 0; n < 4; ++n) acc[n] = __builtin_amdgcn_mfma_f32_16x16x32_bf16(af[s2], bf[n][s2], acc[n], 0, 0, 0);
}
__device__ __forceinline__ float dpp_xor1(float v) { return __int_as_float(__builtin_amdgcn_update_dpp(0, __float_as_int(v), 0xB1, 0xf, 0xf, false)); }
__device__ __forceinline__ float dpp_xor2(float v) { return __int_as_float(__builtin_amdgcn_update_dpp(0, __float_as_int(v), 0x4E, 0xf, 0xf, false)); }
__device__ __forceinline__ float dpp_hmir(float v) { return __int_as_float(__builtin_amdgcn_update_dpp(0, __float_as_int(v), 0x141, 0xf, 0xf, false)); }
__device__ __forceinline__ void unpack8(const uint4 u, float (&o)[8]) {
    o[0] = lo2f(u.x); o[1] = hi2f(u.x); o[2] = lo2f(u.y); o[3] = hi2f(u.y); o[4] = lo2f(u.z); o[5] = hi2f(u.z); o[6] = lo2f(u.w); o[7] = hi2f(u.w);
}
__device__ __forceinline__ void phase_scanA(const PP p, char* smem) {
    const int t0 = tid_opaque();
    u16* M = (u16*)smem;
#define MX(idx) (M + (idx) * 4608)
    float* ABF = (float*)(smem + 13 * 9216);
    u16* M13 = (u16*)ABF; u16* M14 = M13 + 4608;
    float* GC = (float*)(smem + 138240);
    float* SEG = GC + 64;
    const __half* Wb = (const __half*)(p.ws() + RW_W);
    const u16* KK = (const u16*)(p.ws() + RW_KK); const u16* BQ = (const u16*)(p.ws() + RW_BQ); const u16* KD = (const u16*)(p.ws() + RW_KD);
    const u16* R = (const u16*)(p.ws() + RW_R); const u16* V = (const u16*)(p.ws() + RW_V);
    u16* PM = (u16*)(p.ws() + SC_PM); u16* OM = (u16*)(p.ws() + SC_OM); u16* QM = (u16*)(p.ws() + SC_QM); u16* OL = (u16*)(p.ws() + SC_OL);
    uint4 ukk, ubq, ukd, ur, uv; unsigned short wq0, wq1, wq2, wq3, wq4, wq5, wq6, wq7;
#define SA_LOAD(ITEM) { const int ch_ = (ITEM) >> 8, ck_ = (ITEM) & 255; const int d_ = ch_ >> 4, b_ = (ch_ >> 3) & 1, h_ = ch_ & 7; \
        const int li_ = t0 >> 3, lk_ = (t0 & 7) * 8; const int tt_ = d_ ? (L_ - 1 - (ck_ * 64 + li_)) : (ck_ * 64 + li_); const size_t tk_ = (size_t)b_ * L_ + tt_; \
        const size_t g1_ = tk_ * 512 + h_ * 64 + lk_, g2_ = (tk_ * 2 + d_) * 512 + h_ * 64 + lk_; \
        { const int k2_ = t0 & 63, sg_ = t0 >> 6; const int ts_ = ck_ * 64 + sg_ * 8; const int tt0_ = d_ ? (L_ - 1 - ts_) : ts_; \
          const unsigned short* wp_ = (const unsigned short*)Wb + (((size_t)b_ * L_ + tt0_) * 2 + d_) * 512 + h_ * 64 + k2_; const int st_ = d_ ? -1024 : 1024; \
          wq0 = wp_[0]; wq1 = wp_[st_]; wq2 = wp_[2 * st_]; wq3 = wp_[3 * st_]; wq4 = wp_[4 * st_]; wq5 = wp_[5 * st_]; wq6 = wp_[6 * st_]; wq7 = wp_[7 * st_]; } \
        ukk = *(const uint4*)(KK + g1_); ubq = *(const uint4*)(BQ + g2_); ukd = *(const uint4*)(KD + g2_); ur = *(const uint4*)(R + g1_); uv = *(const uint4*)(V + g1_); }
    if ((int)blockIdx.x < 8192) SA_LOAD(blockIdx.x)
#pragma unroll 1
    for (int item = blockIdx.x; item < 8192; item += gridDim.x) {
        const int chain = item >> 8, chunk = item & 255;
        const int d = chain >> 4, b = (chain >> 3) & 1, h = chain & 7;
        int t = t0; asm volatile("" : "+v"(t));
        const int lane = t & 63, wid = t >> 6, fr = lane & 15, fq = lane >> 4;
        const int li = t >> 3, lk0 = (t & 7) * 8;
        __syncthreads();
        {
            const int k = t & 63, seg = t >> 6;
            float av[8] = {__half2float(__ushort_as_half(wq0)), __half2float(__ushort_as_half(wq1)), __half2float(__ushort_as_half(wq2)), __half2float(__ushort_as_half(wq3)),
                           __half2float(__ushort_as_half(wq4)), __half2float(__ushort_as_half(wq5)), __half2float(__ushort_as_half(wq6)), __half2float(__ushort_as_half(wq7))};
            float pr = 1.f;
#pragma unroll
            for (int x = 0; x < 8; ++x) { pr *= av[x]; av[x] = pr; }
            SEG[seg * 64 + k] = pr;
            __syncthreads();
            float pre = 1.f;
#pragma unroll
            for (int s2 = 0; s2 < 7; ++s2) if (s2 < seg) pre *= SEG[s2 * 64 + k];
#pragma unroll
            for (int x = 0; x < 8; ++x) ABF[(seg * 8 + x) * 72 + k] = av[x] * pre;
            if (seg == 7) GC[k] = av[7] * pre;
        }
        __syncthreads();
        {
            float G[8], Gm[8], fa[8], fb[8], fk[8], frr[8];
            *(float4*)&G[0] = *(const float4*)(ABF + li * 72 + lk0); *(float4*)&G[4] = *(const float4*)(ABF + li * 72 + lk0 + 4);
            if (li > 0) { *(float4*)&Gm[0] = *(const float4*)(ABF + (li - 1) * 72 + lk0); *(float4*)&Gm[4] = *(const float4*)(ABF + (li - 1) * 72 + lk0 + 4); }
            else {
#pragma unroll
                for (int e = 0; e < 8; ++e) Gm[e] = 1.f;
            }
            unpack8(ukk, fa); unpack8(ubq, fb); unpack8(ukd, fk); unpack8(ur, frr);
            unsigned pa[4], pb[4], pk[4], prr[4];
#pragma unroll
            for (int e = 0; e < 8; e += 2) {
                const float r0 = __builtin_amdgcn_rcpf(G[e]), r1 = __builtin_amdgcn_rcpf(G[e + 1]);
                pa[e >> 1] = pack2(-fa[e] * Gm[e], -fa[e + 1] * Gm[e + 1]);
                pb[e >> 1] = pack2(fb[e] * r0, fb[e + 1] * r1);
                pk[e >> 1] = pack2(fk[e] * r0, fk[e + 1] * r1);
                prr[e >> 1] = pack2(frr[e] * G[e], frr[e + 1] * G[e + 1]);
            }
            *(uint4*)(MX(0) + li * 72 + lk0) = make_uint4(pa[0], pa[1], pa[2], pa[3]);
            *(uint4*)(MX(2) + li * 72 + lk0) = make_uint4(pb[0], pb[1], pb[2], pb[3]);
            *(uint4*)(MX(4) + li * 72 + lk0) = make_uint4(pk[0], pk[1], pk[2], pk[3]);
            *(uint4*)(MX(6) + li * 72 + lk0) = make_uint4(prr[0], prr[1], prr[2], prr[3]);
            *(uint4*)(MX(8) + li * 72 + lk0) = uv;
        }
        __syncthreads();
        {
            const int k = t & 63, i0 = (t >> 6) * 8;
#pragma unroll
            for (int mtx = 0; mtx < 4; ++mtx) {
                const u16* src = (mtx == 0) ? MX(0) : (mtx == 1) ? MX(2) : (mtx == 2) ? MX(4) : MX(8);
                u16* dst = (mtx == 0) ? MX(1) : (mtx == 1) ? MX(3) : (mtx == 2) ? MX(5) : MX(7);
                unsigned w[4];
#pragma unroll
                for (int e = 0; e < 4; ++e) w[e] = (unsigned)src[(i0 + 2 * e) * 72 + k] | ((unsigned)src[(i0 + 2 * e + 1) * 72 + k] << 16);
                *(uint4*)(dst + k * 72 + i0) = make_uint4(w[0], w[1], w[2], w[3]);
            }
        }
        if (item + (int)gridDim.x < 8192) SA_LOAD(item + gridDim.x)
        __syncthreads();
#pragma unroll
        for (int x = 0; x < 2; ++x) {
            const int pm = wid * 2 + x, prod = pm >> 2, m = pm & 3;
            const u16* A = (prod < 2) ? MX(0) : MX(6);
            const u16* Bt = (prod & 1) ? MX(4) : MX(2);
            f32x4 acc4[4] = {f32x4{0.f, 0.f, 0.f, 0.f}, f32x4{0.f, 0.f, 0.f, 0.f}, f32x4{0.f, 0.f, 0.f, 0.f}, f32x4{0.f, 0.f, 0.f, 0.f}};
            mm64x4(A, Bt, m, fr, fq, acc4);
#pragma unroll
            for (int n = 0; n < 4; ++n) {
                const f32x4 acc = acc4[n];
#pragma unroll
                for (int j = 0; j < 4; ++j) {
                    const int i = 16 * m + 4 * fq + j, jc = 16 * n + fr;
                    const bool keep = (prod < 2) ? (jc < i) : (jc <= i);
                    const float val = keep ? acc[j] : 0.f;
                    if (prod == 0) ABF[i * 72 + jc] = val;
                    else MX(7 + prod)[i * 72 + jc] = f2bf(val);
                }
            }
        }
        __syncthreads();
        {
            const int c = 8 * wid + (lane >> 3), jg = lane & 7;
            float Tl[8];
#pragma unroll
            for (int e = 0; e < 8; ++e) Tl[e] = 0.f;
            float4 ra[8][2];
#pragma unroll
            for (int ii = 0; ii < 8; ++ii) { ra[ii][0] = *(const float4*)(ABF + ii * 72 + 8 * jg); ra[ii][1] = *(const float4*)(ABF + ii * 72 + 8 * jg + 4); }
#pragma unroll
            for (int ib = 0; ib < 8; ++ib) {
                float4 rn[8][2];
#pragma unroll
                for (int ii = 0; ii < 8; ++ii) {
                    const int i2 = (ib < 7) ? (8 * (ib + 1) + ii) : ii;
                    rn[ii][0] = *(const float4*)(ABF + i2 * 72 + 8 * jg); rn[ii][1] = *(const float4*)(ABF + i2 * 72 + 8 * jg + 4);
                }
                __builtin_amdgcn_sched_barrier(0);
#pragma unroll
                for (int ii = 0; ii < 8; ++ii) {
                    const int i = 8 * ib + ii;
                    const float4 a0 = ra[ii][0], a1 = ra[ii][1];
                    const float av[8] = {a0.x, a0.y, a0.z, a0.w, a1.x, a1.y, a1.z, a1.w};
                    const int es = (i + 7) & 7;
                    float p7 = (c == i && jg == 0) ? 1.f : 0.f;
#pragma unroll
                    for (int e = 0; e < 8; ++e) if (e != es) p7 += av[e] * Tl[e];
                    float part = p7 + av[es] * Tl[es];
                    part += dpp_xor1(part); part += dpp_xor2(part); part += dpp_hmir(part);
                    Tl[i & 7] = (jg == (i >> 3)) ? part : Tl[i & 7];
                }
                __builtin_amdgcn_sched_barrier(0);
#pragma unroll
                for (int ii = 0; ii < 8; ++ii) { ra[ii][0] = rn[ii][0]; ra[ii][1] = rn[ii][1]; }
            }
#pragma unroll
            for (int e = 0; e < 8; ++e) MX(11)[(8 * jg + e) * 72 + c] = f2bf(Tl[e]);
#pragma unroll
            for (int x = 0; x < 2; ++x) {
                const int id = wid * 2 + x, m = id >> 2, n = id & 3;
                const f32x4 acc = mm64(MX(8), MX(7), m, n, fr, fq, f32x4{0.f, 0.f, 0.f, 0.f});
                uint2 o; o.x = pack2(acc[0], acc[1]); o.y = pack2(acc[2], acc[3]);
                *(uint2*)(MX(12) + (16 * n + fr) * 72 + 16 * m + 4 * fq) = o;
            }
        }
        __syncthreads();
        {
            const int prod = wid >> 2, m = wid & 3;
            const u16* Bt = prod ? MX(1) : MX(12);
            u16* dst = prod ? M14 : M13;
            f32x4 acc4[4] = {f32x4{0.f, 0.f, 0.f, 0.f}, f32x4{0.f, 0.f, 0.f, 0.f}, f32x4{0.f, 0.f, 0.f, 0.f}, f32x4{0.f, 0.f, 0.f, 0.f}};
            mm64x4(MX(11), Bt, m, fr, fq, acc4);
#pragma unroll
            for (int n = 0; n < 4; ++n) {
                const f32x4 acc = acc4[n];
                uint2 o; o.x = pack2(acc[0], acc[1]); o.y = pack2(acc[2], acc[3]);
                *(uint2*)(dst + (16 * n + fr) * 72 + 16 * m + 4 * fq) = o;
            }
        }
        __syncthreads();
        {
            const int mat = wid >> 1;
            u16* SA = MX(8); u16* SB = MX(1);
#pragma unroll
            for (int mm = 0; mm < 2; ++mm) {
                const int m = (wid & 1) * 2 + mm;
                f32x4 acc4[4] = {f32x4{0.f, 0.f, 0.f, 0.f}, f32x4{0.f, 0.f, 0.f, 0.f}, f32x4{0.f, 0.f, 0.f, 0.f}, f32x4{0.f, 0.f, 0.f, 0.f}};
                if (mat == 0) {
                    mm64x4(MX(9), M14, m, fr, fq, acc4);
#pragma unroll
                    for (int n = 0; n < 4; ++n)
#pragma unroll
                        for (int j = 0; j < 4; ++j) {
                            const int i = 16 * m + 4 * fq + j, kp = 16 * n + fr;
                            SA[i * 64 + kpos(kp)] = f2bf(acc4[n][j] + bf2f(MX(6)[i * 72 + kp]));
                        }
                } else if (mat == 1) {
                    mm64x4(MX(9), M13, m, fr, fq, acc4);
                    mm64x4(MX(10), MX(7), m, fr, fq, acc4);
#pragma unroll
                    for (int n = 0; n < 4; ++n) {
                        uint2 o; o.x = pack2(acc4[n][0], acc4[n][1]); o.y = pack2(acc4[n][2], acc4[n][3]);
                        *(uint2*)(OL + (((size_t)item * 4 + n) * 4 + m) * 256 + lane * 4) = o;
                    }
                } else if (mat == 2) {
                    mm64x4(MX(3), M14, m, fr, fq, acc4);
#pragma unroll
                    for (int n = 0; n < 4; ++n)
#pragma unroll
                        for (int j = 0; j < 4; ++j) {
                            const int k = 16 * m + 4 * fq + j, kp = 16 * n + fr;
                            SB[k * 64 + kpos(kp)] = f2bf((acc4[n][j] + ((k == kp) ? 1.f : 0.f)) * GC[k]);
                        }
                } else {
                    mm64x4(MX(3), M13, m, fr, fq, acc4);
                    mm64x4(MX(5), MX(7), m, fr, fq, acc4);
                    const int k0 = 16 * m + 4 * fq;
#pragma unroll
                    for (int n = 0; n < 4; ++n) {
                        uint2 o; o.x = pack2(acc4[n][0] * GC[k0], acc4[n][1] * GC[k0 + 1]); o.y = pack2(acc4[n][2] * GC[k0 + 2], acc4[n][3] * GC[k0 + 3]);
                        *(uint2*)(QM + (((size_t)item * 4 + n) * 4 + m) * 256 + lane * 4) = o;
                    }
                }
            }
            __syncthreads();
            *(uint4*)(OM + (size_t)item * 4096 + t * 8) = *(const uint4*)(SA + t * 8);
            *(uint4*)(PM + (size_t)item * 4096 + t * 8) = *(const uint4*)(SB + t * 8);
        }
    }
#undef MX
#undef SA_LOAD
}

struct StepRegs { bf16x8 pa[4][2]; uint2 qf[4]; };
__device__ __forceinline__ void sb_load(StepRegs& r, const u16* Pm, const u16* Qf, int fr, int fq, int lane) {
#pragma unroll
    for (int m = 0; m < 4; ++m) {
#pragma unroll
        for (int s2 = 0; s2 < 2; ++s2) r.pa[m][s2] = *(const bf16x8*)(Pm + (16 * m + fr) * 64 + 32 * s2 + 8 * fq);
        r.qf[m] = *(const uint2*)(Qf + m * 256 + lane * 4);
    }
}
__device__ __forceinline__ void sb_apply(const StepRegs& r, const bf16x8 (&sb)[2], f32x4 (&acc)[4]) {
#pragma unroll
    for (int m = 0; m < 4; ++m) acc[m] = f32x4{lo2f(r.qf[m].x), hi2f(r.qf[m].x), lo2f(r.qf[m].y), hi2f(r.qf[m].y)};
#pragma unroll
    for (int s2 = 0; s2 < 2; ++s2)
#pragma unroll
        for (int m = 0; m < 4; ++m) acc[m] = __builtin_amdgcn_mfma_f32_16x16x32_bf16(r.pa[m][s2], sb[s2], acc[m], 0, 0, 0);
}
__device__ __forceinline__ void sb_pack(const f32x4 (&acc)[4], bf16x8 (&sb)[2]) {
#pragma unroll
    for (int s2 = 0; s2 < 2; ++s2) {
        union { bf16x8 v; unsigned u[4]; } cv;
        cv.u[0] = pack2(acc[2 * s2][0], acc[2 * s2][1]); cv.u[1] = pack2(acc[2 * s2][2], acc[2 * s2][3]);
        cv.u[2] = pack2(acc[2 * s2 + 1][0], acc[2 * s2 + 1][1]); cv.u[3] = pack2(acc[2 * s2 + 1][2], acc[2 * s2 + 1][3]);
        sb[s2] = cv.v;
    }
}

__device__ __forceinline__ void phase_scanB1(const PP p) {
    const int t = tid_opaque(), lane = t & 63, wid = t >> 6, fr = lane & 15, fq = lane >> 4;
    const u16* PM = (const u16*)(p.ws() + SC_PM); const u16* QM = (const u16*)(p.ws() + SC_QM);
    u16* PG = (u16*)(p.ws() + SC_PG); u16* QG = (u16*)(p.ws() + SC_QG);
    const int ng = wid & 3;
    for (int seq = blockIdx.x * 2 + (wid >> 2); seq < 512; seq += gridDim.x * 2) {
        const int chain = seq >> 4, grp = seq & 15;
        const size_t item0 = (size_t)chain * 256 + grp * 16;
        bf16x8 pb[2], qb[2];
#pragma unroll
        for (int s2 = 0; s2 < 2; ++s2)
#pragma unroll
            for (int e = 0; e < 8; ++e) {
                const int kact = 32 * s2 + ((e < 4) ? (4 * fq + e) : (16 + 4 * fq + e - 4));
                pb[s2][e] = (kact == 16 * ng + fr) ? (short)0x3F80 : (short)0;
                qb[s2][e] = 0;
            }
        StepRegs ra, rb;
        sb_load(ra, PM + item0 * 4096, QM + ((item0 * 4 + ng) * 4) * 256, fr, fq, lane);
        sb_load(rb, PM + (item0 + 1) * 4096, QM + (((item0 + 1) * 4 + ng) * 4) * 256, fr, fq, lane);
#pragma unroll 1
        for (int c = 0; c < 16; c += 2) {
            f32x4 accP[4], accQ[4];
            {
                StepRegs z = ra;
#pragma unroll
                for (int m = 0; m < 4; ++m) z.qf[m] = make_uint2(0u, 0u);
                sb_apply(z, pb, accP); sb_apply(ra, qb, accQ);
                const size_t nx = item0 + ((c + 2 < 16) ? (c + 2) : c);
                sb_load(ra, PM + nx * 4096, QM + ((nx * 4 + ng) * 4) * 256, fr, fq, lane);
                sb_pack(accP, pb); sb_pack(accQ, qb);
            }
            {
                StepRegs z = rb;
#pragma unroll
                for (int m = 0; m < 4; ++m) z.qf[m] = make_uint2(0u, 0u);
                sb_apply(z, pb, accP); sb_apply(rb, qb, accQ);
                const size_t nx = item0 + ((c + 3 < 16) ? (c + 3) : (c + 1));
                sb_load(rb, PM + nx * 4096, QM + ((nx * 4 + ng) * 4) * 256, fr, fq, lane);
                if (c + 2 < 16) { sb_pack(accP, pb); sb_pack(accQ, qb); }
            }
            if (c + 2 >= 16) {
#pragma unroll
                for (int m = 0; m < 4; ++m) {
#pragma unroll
                    for (int j = 0; j < 4; ++j) PG[(size_t)seq * 4096 + (16 * m + 4 * fq + j) * 64 + kpos(16 * ng + fr)] = f2bf(accP[m][j]);
                    uint2 o; o.x = pack2(accQ[m][0], accQ[m][1]); o.y = pack2(accQ[m][2], accQ[m][3]);
                    *(uint2*)(QG + (((size_t)seq * 4 + ng) * 4 + m) * 256 + lane * 4) = o;
                }
            }
        }
    }
}

__device__ __forceinline__ void phase_scanB2(const PP p) {
    const int t = tid_opaque(), lane = t & 63, wid = t >> 6, fr = lane & 15, fq = lane >> 4;
    const u16* PM = (const u16*)(p.ws() + SC_PM); const u16* OM = (const u16*)(p.ws() + SC_OM);
    const u16* QM = (const u16*)(p.ws() + SC_QM); const u16* OL = (const u16*)(p.ws() + SC_OL);
    const u16* PG = (const u16*)(p.ws() + SC_PG); const u16* QG = (const u16*)(p.ws() + SC_QG);
    const int ng = wid & 3;
    for (int seq = blockIdx.x * 2 + (wid >> 2); seq < 512; seq += gridDim.x * 2) {
        const int chain = seq >> 4, grp = seq & 15;
        const int d = chain >> 4, b = (chain >> 3) & 1, h = chain & 7;
        float* O = (float*)(p.ws() + (d ? O_OB : O_OF));
        bf16x8 sb[2];
#pragma unroll
        for (int s2 = 0; s2 < 2; ++s2)
#pragma unroll
            for (int e = 0; e < 8; ++e) sb[s2][e] = 0;
#pragma unroll 1
        for (int g = 0; g < grp; ++g) {
            const size_t sq = (size_t)chain * 16 + g;
            StepRegs r; f32x4 acc[4];
            sb_load(r, PG + sq * 4096, QG + ((sq * 4 + ng) * 4) * 256, fr, fq, lane);
            sb_apply(r, sb, acc); sb_pack(acc, sb);
        }
        const size_t item0 = (size_t)chain * 256 + grp * 16;
        StepRegs sa, sa2, so;
        sb_load(sa, PM + item0 * 4096, QM + ((item0 * 4 + ng) * 4) * 256, fr, fq, lane);
        sb_load(so, OM + item0 * 4096, OL + ((item0 * 4 + ng) * 4) * 256, fr, fq, lane);
        sb_load(sa2, PM + (item0 + 1) * 4096, QM + (((item0 + 1) * 4 + ng) * 4) * 256, fr, fq, lane);
#pragma unroll 1
        for (int c = 0; c < 16; c += 2) {
#pragma unroll
            for (int u = 0; u < 2; ++u) {
                f32x4 accS[4], accO[4];
                StepRegs& ra = u ? sa2 : sa;
                sb_apply(so, sb, accO);
                {
                    const size_t nx = item0 + ((c + u + 1 < 16) ? (c + u + 1) : (c + u));
                    sb_load(so, OM + nx * 4096, OL + ((nx * 4 + ng) * 4) * 256, fr, fq, lane);
                }
                sb_apply(ra, sb, accS);
                {
                    const size_t nx = item0 + ((c + u + 2 < 16) ? (c + u + 2) : (c + u));
                    sb_load(ra, PM + nx * 4096, QM + ((nx * 4 + ng) * 4) * 256, fr, fq, lane);
                }
                const int cc = grp * 16 + c + u;
#pragma unroll
                for (int m = 0; m < 4; ++m)
#pragma unroll
                    for (int j = 0; j < 4; ++j) {
                        const int i = 16 * m + 4 * fq + j;
                        const int tt = d ? (L_ - 1 - (cc * 64 + i)) : (cc * 64 + i);
                        O[((size_t)b * L_ + tt) * 512 + h * 64 + 16 * ng + fr] = accO[m][j];
                    }
                sb_pack(accS, sb);
            }
        }
    }
}

__device__ __forceinline__ void phase_combine(const PP p, int i) {
    const int t = tid_opaque(); const int lane = t & 63, wid = t >> 6;
    const float* OF = (const float*)(p.ws() + O_OF); const float* OB = (const float*)(p.ws() + O_OB);
    const u16* R = (const u16*)(p.ws() + RW_R); const u16* V = (const u16*)(p.ws() + RW_V); const u16* KD = (const u16*)(p.ws() + RW_KD);
    const u16* G = (const u16*)(p.ws() + RW_G);
    const float* gngp = p.in(23) + (size_t)i * 512; const float* gnbp = p.in(24) + (size_t)i * 512; const float* rkp = p.in(22) + (size_t)i * 512;
    u16* mix = (u16*)(p.ws() + OFF_MIX);
    float gng[8], gnb[8], rk[8];
#pragma unroll
    for (int ii = 0; ii < 8; ++ii) { gng[ii] = gngp[lane + 64 * ii]; gnb[ii] = gnbp[lane + 64 * ii]; rk[ii] = rkp[lane + 64 * ii]; }
    const int tstride = gridDim.x * 8;
    int tok = blockIdx.x * 8 + wid;
    float of[8], ob[8]; u16 rr[8], k0[8], k1[8], vv[8], gg[8];
#define CB_LOAD(TK) { _Pragma("unroll") for (int ii = 0; ii < 8; ++ii) { const size_t g1 = (size_t)(TK) * 512 + lane + 64 * ii; \
        of[ii] = OF[g1]; ob[ii] = OB[g1]; rr[ii] = R[g1]; vv[ii] = V[g1]; gg[ii] = G[g1]; \
        k0[ii] = KD[((size_t)(TK) * 2) * 512 + lane + 64 * ii]; k1[ii] = KD[((size_t)(TK) * 2 + 1) * 512 + lane + 64 * ii]; } }
    if (tok < T_) CB_LOAD(tok)
#pragma unroll 1
    for (; tok < T_; tok += tstride) {
        float o[8], rf[8], ks[8], vf[8], gf[8];
#pragma unroll
        for (int ii = 0; ii < 8; ++ii) { o[ii] = of[ii] + ob[ii]; rf[ii] = bf2f(rr[ii]); ks[ii] = bf2f(k0[ii]) + bf2f(k1[ii]); vf[ii] = bf2f(vv[ii]); gf[ii] = bf2f(gg[ii]); }
        if (tok + tstride < T_) CB_LOAD(tok + tstride)
#pragma unroll
        for (int ii = 0; ii < 8; ++ii) {
            const int col = lane + 64 * ii;
            const float mean = wave_sum(o[ii]) * (1.0f / 64.0f);
            const float dv = o[ii] - mean;
            const float var = wave_sum(dv * dv) * (1.0f / 64.0f);
            const float nrm = dv * rsqrtf(var + 64e-5f) * gng[ii] + gnb[ii];
            const float bonus = wave_sum(rf[ii] * ks[ii] * rk[ii]);
            mix[(size_t)tok * 1024 + 512 + col] = f2bf((nrm + bonus * vf[ii]) * gf[ii]);
        }
    }
#undef CB_LOAD
}

struct EpiResid {
    u16* xo; const float* ada;
    __device__ __forceinline__ void operator()(const f32x4 (&acc)[2][2][4][2], const g8::Unit& u, int wr, int wc, int fr, int fq) const {
        const float* g1 = ada + (u.pm >> 6) * 6144 + 2048;
        float4 gv[2][2];
#pragma unroll
        for (int bj = 0; bj < 2; ++bj)
#pragma unroll
            for (int n = 0; n < 2; ++n) gv[bj][n] = *(const float4*)(g1 + u.pn * 256 + bj * 128 + wc * 32 + n * 16 + fq * 4);
#pragma unroll
        for (int ai = 0; ai < 2; ++ai) {
            uint2 xq[4][2][2];
#pragma unroll
            for (int m = 0; m < 4; ++m) {
                const size_t row = (size_t)u.pm * 256 + ai * 128 + wr * 64 + m * 16 + fr;
#pragma unroll
                for (int bj = 0; bj < 2; ++bj)
#pragma unroll
                    for (int n = 0; n < 2; ++n) xq[m][bj][n] = *(const uint2*)(xo + row * 1024 + u.pn * 256 + bj * 128 + wc * 32 + n * 16 + fq * 4);
            }
            __builtin_amdgcn_sched_barrier(0);
#pragma unroll
            for (int m = 0; m < 4; ++m) {
                const size_t row = (size_t)u.pm * 256 + ai * 128 + wr * 64 + m * 16 + fr;
#pragma unroll
                for (int bj = 0; bj < 2; ++bj)
#pragma unroll
                    for (int n = 0; n < 2; ++n) {
                        const int col = u.pn * 256 + bj * 128 + wc * 32 + n * 16 + fq * 4;
                        const f32x4 v = acc[ai][bj][m][n];
                        const float4 xv = up4(xq[m][bj][n]); const float4 g = gv[bj][n];
                        *(uint2*)(xo + row * 1024 + col) = make_uint2(pack2(ALPHA_F * xv.x + g.x * v[0], ALPHA_F * xv.y + g.y * v[1]), pack2(ALPHA_F * xv.z + g.z * v[2], ALPHA_F * xv.w + g.w * v[3]));
                    }
            }
        }
    }
};
__device__ __forceinline__ void phase_gout(const PP p, char* smem, const u16* A, const u16* B, int layer) {
    SchedGrid S; S.A = (const char*)A; S.B = (const char*)B; S.nunits = 128 * 4; S.npn = 4; S.astep = (size_t)256 * 1024 * 2; S.bstep = (size_t)256 * 1024 * 2;
    EpiResid E; E.xo = (u16*)p.out() + (size_t)T_ * 1024; E.ada = (const float*)(p.ws() + OFF_ADA) + (size_t)layer * 2 * 6144;
    g8::gemm<false, false>((G8_LAS unsigned char*)smem, 1024, 1024, 1024, nullptr, S, E);
}

__device__ __forceinline__ void phase_lna(const PP p, char* smem, int layer) {
    const int t = tid_opaque(), lane = t & 63, wid = t >> 6, fr = lane & 15, q = lane >> 4;
    u16* WH = (u16*)smem;
    u16* WL = WH + 32 * 1032;
    float* uv = (float*)(smem + 2 * 32 * 1032 * 2);
    float* part = uv + 64;
    int* cntl = (int*)(part + 16 * 64);
    float* prm = (float*)(cntl + 32);
    const float* ada = (const float*)(p.ws() + OFF_ADA) + (size_t)layer * 2 * 6144;
    const float* lng = p.in(4) + (size_t)(layer * 2) * 1024; const float* lnb = p.in(5) + (size_t)(layer * 2) * 1024;
    const u16* XB = (const u16*)p.out() + (size_t)T_ * 1024;
    u16* X1 = (u16*)(p.ws() + OFF_MIX);
    u16* hb = (u16*)(p.ws() + OFF_HBUF);
    int* toke = (int*)(p.ws() + OFF_TOKE); float* tokg = (float*)(p.ws() + OFF_TOKG); int* cnt = (int*)(p.ws() + OFF_CNT);
    int built_b = -1;
    for (int g = blockIdx.x; g < 256; g += gridDim.x) {
        const int b = g >> 7;
        const float* shp = ada + b * 6144 + 3072; const float* scp = ada + b * 6144 + 4096;
        __syncthreads();
        if (b != built_b) {
            built_b = b;
            {
                float gc[2], bc[2], s1[2], sh[2];
#pragma unroll
                for (int k = 0; k < 2; ++k) { const int c = t + 512 * k; gc[k] = lng[c]; bc[k] = lnb[c]; s1[k] = scp[c]; sh[k] = shp[c]; }
                __builtin_amdgcn_sched_barrier(0);
#pragma unroll
                for (int k = 0; k < 2; ++k) { const int c = t + 512 * k; const float m1 = 1.0f + s1[k]; prm[c] = gc[k]; prm[1024 + c] = bc[k]; prm[2048 + c] = gc[k] * m1; prm[3072 + c] = bc[k] * m1 + sh[k]; }
            }
            __syncthreads();
            const int e = t & 31;
            float su = 0.f, sv = 0.f;
#pragma unroll 1
            for (int k16 = 0; k16 < 4; ++k16) {
                float rwv[16];
#pragma unroll
                for (int j = 0; j < 16; ++j) rwv[j] = p.in(6)[t + 512 * (16 * k16 + j)];
                __builtin_amdgcn_sched_barrier(0);
#pragma unroll
                for (int j = 0; j < 16; ++j) {
                    const int idx = t + 512 * (16 * k16 + j), c = idx >> 5;
                    const float w = rwv[j] * prm[2048 + c];
                    const u16 hi = f2bf(w); const u16 lo = f2bf(w - bf2f(hi));
                    WH[e * 1032 + c] = hi; WL[e * 1032 + c] = lo;
                    su += w; sv += prm[3072 + c] * rwv[j];
                }
            }
            part[(t >> 5) * 64 + e] = su; part[(t >> 5) * 64 + 32 + e] = sv;
            __syncthreads();
            if (t < 64) { float s = 0.f; for (int k = 0; k < 16; ++k) s += part[k * 64 + t]; uv[t] = s + ((t >= 32) ? p.in(7)[t - 32] : 0.f); }
        }
        if (t < 32) cntl[t] = 0;
        __syncthreads();
        const int tok = g * 128 + wid * 16 + fr;
        const u16* xrow = XB + (size_t)tok * 1024 + 8 * q;
        f32x4 acc0 = f32x4{0.f, 0.f, 0.f, 0.f}, acc1 = f32x4{0.f, 0.f, 0.f, 0.f};
        float sm = 0.f, sq = 0.f;
        {
#pragma unroll 1
            for (int s8 = 0; s8 < 4; ++s8) {
                uint4 xs[8];
#pragma unroll
                for (int j = 0; j < 8; ++j) xs[j] = *(const uint4*)(xrow + 32 * (8 * s8 + j));
                __builtin_amdgcn_sched_barrier(0);
#pragma unroll
                for (int j = 0; j < 8; ++j) {
                    const int s = 8 * s8 + j;
                    const uint4 xu = xs[j];
                    union { uint4 u; bf16x8 v; } xa; xa.u = xu;
                    const float x0 = lo2f(xu.x), x1 = hi2f(xu.x), x2 = lo2f(xu.y), x3 = hi2f(xu.y), x4 = lo2f(xu.z), x5 = hi2f(xu.z), x6 = lo2f(xu.w), x7 = hi2f(xu.w);
                    sm += ((x0 + x1) + (x2 + x3)) + ((x4 + x5) + (x6 + x7));
                    sq += ((x0 * x0 + x1 * x1) + (x2 * x2 + x3 * x3)) + ((x4 * x4 + x5 * x5) + (x6 * x6 + x7 * x7));
                    const bf16x8 wh0 = *(const bf16x8*)(WH + fr * 1032 + 32 * s + 8 * q), wl0 = *(const bf16x8*)(WL + fr * 1032 + 32 * s + 8 * q);
                    const bf16x8 wh1 = *(const bf16x8*)(WH + (16 + fr) * 1032 + 32 * s + 8 * q), wl1 = *(const bf16x8*)(WL + (16 + fr) * 1032 + 32 * s + 8 * q);
                    acc0 = __builtin_amdgcn_mfma_f32_16x16x32_bf16(xa.v, wh0, acc0, 0, 0, 0); acc0 = __builtin_amdgcn_mfma_f32_16x16x32_bf16(xa.v, wl0, acc0, 0, 0, 0);
                    acc1 = __builtin_amdgcn_mfma_f32_16x16x32_bf16(xa.v, wh1, acc1, 0, 0, 0); acc1 = __builtin_amdgcn_mfma_f32_16x16x32_bf16(xa.v, wl1, acc1, 0, 0, 0);
                }
            }
        }
        sm += __shfl_xor(sm, 16); sm += __shfl_xor(sm, 32); sq += __shfl_xor(sq, 16); sq += __shfl_xor(sq, 32);
        const float mean = sm * (1.0f / 1024.0f);
        const float rstd = rsqrtf(fmaxf(sq * (1.0f / 1024.0f) - mean * mean, 0.f) + 1e-5f);
        {
            const float u0 = uv[fr], u1 = uv[16 + fr], v0 = uv[32 + fr], v1 = uv[48 + fr];
            float p0[4], p1[4];
#pragma unroll
            for (int j = 0; j < 4; ++j) {
                const float mj = __shfl(mean, 4 * q + j), rj = __shfl(rstd, 4 * q + j);
                const float l0 = rj * (acc0[j] - mj * u0) + v0, l1 = rj * (acc1[j] - mj * u1) + v1;
                float mx = fmaxf(l0, l1);
                mx = fmaxf(mx, __shfl_xor(mx, 1)); mx = fmaxf(mx, __shfl_xor(mx, 2)); mx = fmaxf(mx, __shfl_xor(mx, 4)); mx = fmaxf(mx, __shfl_xor(mx, 8));
                p0[j] = __expf(l0 - mx); p1[j] = __expf(l1 - mx);
            }
            const int qb = lane & ~3;
#pragma unroll
            for (int j = 0; j < 4; ++j) {
                int i1[2], i2[2]; float w1[2], w2[2];
#pragma unroll
                for (int nt = 0; nt < 2; ++nt) {
                    const float pv = nt ? p1[j] : p0[j];
                    const float q0 = __shfl(pv, qb), q1 = __shfl(pv, qb + 1), q2 = __shfl(pv, qb + 2), q3 = __shfl(pv, qb + 3);
                    int a1 = 0; float b1 = q0;
                    if (q1 > b1) { b1 = q1; a1 = 1; } if (q2 > b1) { b1 = q2; a1 = 2; } if (q3 > b1) { b1 = q3; a1 = 3; }
                    int a2 = -1; float b2 = -1.f;
                    if (a1 != 0 && q0 > b2) { b2 = q0; a2 = 0; } if (a1 != 1 && q1 > b2) { b2 = q1; a2 = 1; }
                    if (a1 != 2 && q2 > b2) { b2 = q2; a2 = 2; } if (a1 != 3 && q3 > b2) { b2 = q3; a2 = 3; }
                    i1[nt] = a1; i2[nt] = a2; w1[nt] = b1; w2[nt] = b2;
                }
                float score = w1[0] + w2[0]; int gsel = fr >> 2;
                { const float s1 = w1[1] + w2[1]; if (s1 > score) { score = s1; gsel = 4 + (fr >> 2); } }
#pragma unroll
                for (int o = 4; o <= 8; o <<= 1) {
                    const float os = __shfl_xor(score, o); const int og = __shfl_xor(gsel, o);
                    if (os > score || (os == score && og < gsel)) { score = os; gsel = og; }
                }
                const int src = 16 * q + (gsel & 3) * 4, hsel = gsel >> 2;
                const int si1 = hsel ? __shfl(i1[1], src) : __shfl(i1[0], src), si2 = hsel ? __shfl(i2[1], src) : __shfl(i2[0], src);
                const float sv1 = hsel ? __shfl(w1[1], src) : __shfl(w1[0], src), sv2 = hsel ? __shfl(w2[1], src) : __shfl(w2[0], src);
                if (fr == 0) {
                    const int tk = g * 128 + wid * 16 + 4 * q + j;
                    const int e1 = gsel * 4 + si1, e2 = gsel * 4 + si2;
                    const float den = 1.0f / (sv1 + sv2);
                    toke[tk * 2] = e1; toke[tk * 2 + 1] = e2;
                    tokg[tk * 2] = sv1 * den; tokg[tk * 2 + 1] = sv2 * den;
                    atomicAdd(&cntl[e1], 1); atomicAdd(&cntl[e2], 1);
                }
            }
        }
        {
            u16* x1row = X1 + (size_t)tok * 1024 + 8 * q; u16* hrow = hb + (size_t)tok * 1024 + 8 * q;
            const float mr = -mean * rstd;
#pragma unroll 1
            for (int s8 = 0; s8 < 4; ++s8) {
                uint4 xs[8];
#pragma unroll
                for (int j = 0; j < 8; ++j) xs[j] = *(const uint4*)(xrow + 32 * (8 * s8 + j));
                __builtin_amdgcn_sched_barrier(0);
#pragma unroll
                for (int j = 0; j < 8; ++j) {
                    const int s = 8 * s8 + j, c0 = 32 * s + 8 * q;
                    const uint4 xu = xs[j];
                    const float xv[8] = {lo2f(xu.x), hi2f(xu.x), lo2f(xu.y), hi2f(xu.y), lo2f(xu.z), hi2f(xu.z), lo2f(xu.w), hi2f(xu.w)};
                    const float4 g0 = *(const float4*)(prm + c0), g1 = *(const float4*)(prm + c0 + 4), b0 = *(const float4*)(prm + 1024 + c0), b1 = *(const float4*)(prm + 1024 + c0 + 4);
                    const float4 G0 = *(const float4*)(prm + 2048 + c0), G1 = *(const float4*)(prm + 2048 + c0 + 4), B0 = *(const float4*)(prm + 3072 + c0), B1 = *(const float4*)(prm + 3072 + c0 + 4);
                    const float gv[8] = {g0.x, g0.y, g0.z, g0.w, g1.x, g1.y, g1.z, g1.w}, bv[8] = {b0.x, b0.y, b0.z, b0.w, b1.x, b1.y, b1.z, b1.w};
                    const float Gv[8] = {G0.x, G0.y, G0.z, G0.w, G1.x, G1.y, G1.z, G1.w}, Bv[8] = {B0.x, B0.y, B0.z, B0.w, B1.x, B1.y, B1.z, B1.w};
                    float y[8], hh[8];
#pragma unroll
                    for (int e = 0; e < 8; ++e) { const float z = xv[e] * rstd + mr; y[e] = z * gv[e] + bv[e]; hh[e] = z * Gv[e] + Bv[e]; }
                    *(uint4*)(x1row + 32 * s) = make_uint4(pack2(y[0], y[1]), pack2(y[2], y[3]), pack2(y[4], y[5]), pack2(y[6], y[7]));
                    *(uint4*)(hrow + 32 * s) = make_uint4(pack2(hh[0], hh[1]), pack2(hh[2], hh[3]), pack2(hh[4], hh[5]), pack2(hh[6], hh[7]));
                }
            }
        }
        __syncthreads();
        if (t < 32) cnt[g * 32 + t] = cntl[t];
    }
}

__device__ __forceinline__ void phase_scatter(const PP p, char* smem) {
    const int t = tid_opaque();
    int* part = (int*)smem;
    int* tot = part + 512; int* pstart = tot + 32; int* tstart = pstart + 32; int* base = tstart + 33; int* cursor = base + 32;
    const int* cnt = (const int*)(p.ws() + OFF_CNT);
    const int* toke = (const int*)(p.ws() + OFF_TOKE);
    int* toks = (int*)(p.ws() + OFF_TOKS); int* sltk = (int*)(p.ws() + OFF_SLTK); int* meta = (int*)(p.ws() + OFF_META);
    __syncthreads();
    { const int e = t & 31, pt = t >> 5; int s = 0;
      int cv0[16];
#pragma unroll
      for (int g = 0; g < 16; ++g) cv0[g] = cnt[(pt * 16 + g) * 32 + e];
#pragma unroll
      for (int g = 0; g < 16; g += 4) asm volatile("" : "+v"(cv0[g]), "+v"(cv0[g + 1]), "+v"(cv0[g + 2]), "+v"(cv0[g + 3]));
#pragma unroll
      for (int g = 0; g < 16; ++g) s += cv0[g];
      part[pt * 32 + e] = s; }
    __syncthreads();
    if (t < 32) { int s = 0; for (int q = 0; q < 16; ++q) s += part[q * 32 + t]; tot[t] = s; }
    __syncthreads();
    if (t == 0) { int ps = 0, ts = 0; for (int e = 0; e < 32; ++e) { pstart[e] = ps; tstart[e] = ts; const int nt = (tot[e] + 255) >> 8; ps += nt * 256; ts += nt; } tstart[32] = ts; }
    __syncthreads();
    for (int g = blockIdx.x; g < 256; g += gridDim.x) {
        if (t < 32) {
            int bsum = pstart[t];
            for (int q = 0; q < (g >> 4); ++q) bsum += part[q * 32 + t];
            int cv[15];
#pragma unroll
            for (int q = 0; q < 15; ++q) { const int gq = (g & ~15) + q; cv[q] = (gq < g) ? cnt[gq * 32 + t] : 0; }
#pragma unroll
            for (int q = 0; q < 15; ++q) bsum += cv[q];
            base[t] = bsum; cursor[t] = 0;
        }
        __syncthreads();
        if (t < 256) {
            const int tok = g * 128 + (t >> 1);
            const int e = toke[tok * 2 + (t & 1)];
            const int pos = atomicAdd(&cursor[e], 1);
            const int slot = base[e] + pos;
            sltk[slot] = tok; toks[tok * 2 + (t & 1)] = slot;
        }
        __syncthreads();
        if (g == 0) {
            if (t < 32) { meta[t] = tot[t]; meta[32 + t] = pstart[t]; }
            if (t < 33) meta[64 + t] = tstart[t];
            if (t < 32) { const int e0 = pstart[t] + tot[t], e1 = pstart[t] + (((tot[t] + 255) >> 8) << 8); int z_ = 0; asm volatile("" : "+v"(z_)); for (int s = e0; s < e1; ++s) sltk[s] = z_; }
        }
    }
}

constexpr int HLD = 768;
struct SchedMoe {
    const int* lm; const char* A; const char* B; int nct; size_t bexp, bct, astep; int ntot; int layer;
    __device__ __forceinline__ bool operator()(int i, g8::Unit& u) const {
        int id; if (!xcd_deal(i, ntot, id)) return false;
        const int rt = id / nct, ct = id - rt * nct;
        const int ln_ = (int)(threadIdx.x & 63u);
        const int e = __popcll(__ballot(ln_ >= 1 && ln_ < 32 && lm[64 + (ln_ & 31)] <= rt));
        const int slot0 = lm[32 + e] + (rt - lm[64 + e]) * 256;
        u.pm = rt; u.pn = ct; u.aux = slot0;
        u.a = A + (size_t)slot0 * astep;
        u.b = B + (size_t)(layer * 32 + e) * bexp + (size_t)ct * bct;
        return true;
    }
};
struct EpiSwiGLU {
    u16* H;
    __device__ __forceinline__ void operator()(const f32x4 (&acc)[2][2][4][2], const g8::Unit& u, int wr, int wc, int fr, int fq) const {
#pragma unroll
        for (int ai = 0; ai < 2; ++ai)
#pragma unroll
            for (int m = 0; m < 4; ++m) {
                const size_t row = (size_t)u.aux + ai * 128 + wr * 64 + m * 16 + fr;
                unsigned w[4];
#pragma unroll
                for (int n = 0; n < 2; ++n) {
                    float hv[4];
#pragma unroll
                    for (int j = 0; j < 4; ++j) { const float gv = acc[ai][0][m][n][j], uv = acc[ai][1][m][n][j]; hv[j] = gv * __builtin_amdgcn_rcpf(1.0f + __expf(-gv)) * uv; }
                    w[2 * n] = pack2(hv[0], hv[1]); w[2 * n + 1] = pack2(hv[2], hv[3]);
                }
                *(uint4*)(H + row * HLD + u.pn * 128 + wc * 32 + fq * 8) = make_uint4(w[0], w[1], w[2], w[3]);
                __builtin_amdgcn_sched_barrier(0);
            }
    }
};
__device__ __forceinline__ void phase_moe1(const PP p, char* smem, int layer) {
    int* lm = (int*)(smem + 132096);
    const int* meta = (const int*)(p.ws() + OFF_META);
    __syncthreads();
    { const int t_ = tid_opaque(); if (t_ < 97) lm[t_] = meta[t_]; }
    __syncthreads();
    SchedMoe S; S.lm = lm; S.A = p.ws() + OFF_HBUF; S.B = p.ws() + OFF_WGU; S.nct = 6; S.bexp = (size_t)1536 * 1024 * 2; S.bct = (size_t)256 * 1024 * 2; S.astep = 0;
    S.ntot = lm[64 + 32] * 6; S.layer = layer;
    EpiSwiGLU E; E.H = (u16*)(p.ws() + MOE_H);
    g8::gemm<true, true>((G8_LAS unsigned char*)smem, 1024, 1024, 1024, (const int*)(p.ws() + OFF_SLTK), S, E);
}

struct EpiBf16Slots {
    u16* Y;
    __device__ __forceinline__ void operator()(const f32x4 (&acc)[2][2][4][2], const g8::Unit& u, int wr, int wc, int fr, int fq) const {
#pragma unroll
        for (int ai = 0; ai < 2; ++ai)
#pragma unroll
            for (int m = 0; m < 4; ++m) {
                const size_t row = (size_t)u.aux + ai * 128 + wr * 64 + m * 16 + fr;
#pragma unroll
                for (int bj = 0; bj < 2; ++bj) {
                    const f32x4 v0 = acc[ai][bj][m][0], v1 = acc[ai][bj][m][1];
                    *(uint4*)(Y + row * 1024 + u.pn * 256 + bj * 128 + wc * 32 + fq * 8) = make_uint4(pack2(v0[0], v0[1]), pack2(v0[2], v0[3]), pack2(v1[0], v1[1]), pack2(v1[2], v1[3]));
                }
            }
    }
};
__device__ __forceinline__ void phase_moe2(const PP p, char* smem, int layer) {
    int* lm = (int*)(smem + 132096);
    const int* meta = (const int*)(p.ws() + OFF_META);
    __syncthreads();
    { const int t_ = tid_opaque(); if (t_ < 97) lm[t_] = meta[t_]; }
    __syncthreads();
    SchedMoe S; S.lm = lm; S.A = p.ws() + MOE_H; S.B = p.ws() + OFF_WD; S.nct = 4; S.bexp = (size_t)1024 * FF * 2; S.bct = (size_t)256 * FF * 2; S.astep = (size_t)HLD * 2;
    S.ntot = lm[64 + 32] * 4; S.layer = layer;
    EpiBf16Slots E; E.Y = (u16*)(p.ws() + MOE_Y);
    g8::gemm<true, false>((G8_LAS unsigned char*)smem, 768, HLD, FF, nullptr, S, E);
}

__device__ __forceinline__ void phase_lnb(const PP p, int layer) {
    const int t = tid_opaque(); const int lane = t & 63, wid = t >> 6;
    const float* ada = (const float*)(p.ws() + OFF_ADA) + (size_t)layer * 2 * 6144;
    const float* adan = (const float*)(p.ws() + OFF_ADA) + (size_t)(layer + 1) * 2 * 6144;
    const float* lng = p.in(4) + (size_t)(layer * 2 + 1) * 1024; const float* lnb = p.in(5) + (size_t)(layer * 2 + 1) * 1024;
    const u16* Y = (const u16*)(p.ws() + MOE_Y);
    const int* toks = (const int*)(p.ws() + OFF_TOKS); const float* tokg = (const float*)(p.ws() + OFF_TOKG);
    u16* hb = (u16*)(p.ws() + OFF_HBUF);
    const u16* X1 = (const u16*)(p.ws() + OFF_MIX);
    const int tstride = gridDim.x * 8;
    int tok = blockIdx.x * 8 + wid;
    int ns0 = 0, ns1 = 0; float ng0 = 0.f, ng1 = 0.f;
    float4 nx[4]; uint2 nya[4], nyb[4];
    float cg0 = 0.f, cg1 = 0.f;
    float4 pg[4], pb[4], pG2[4], pB2[4], pga[4]; int cur_b = -1;
#pragma unroll
    for (int q4 = 0; q4 < 4; ++q4) { pg[q4] = *(const float4*)(lng + 4 * lane + 256 * q4); pb[q4] = *(const float4*)(lnb + 4 * lane + 256 * q4); pG2[q4] = pg[q4]; pB2[q4] = pb[q4]; pga[q4] = pg[q4]; }
    if (tok < T_) {
        const int s0 = toks[tok * 2], s1 = toks[tok * 2 + 1]; cg0 = tokg[tok * 2]; cg1 = tokg[tok * 2 + 1];
#pragma unroll
        for (int q4 = 0; q4 < 4; ++q4) {
            const int c0 = 4 * lane + 256 * q4;
            nx[q4] = up4(*(const uint2*)(X1 + (size_t)tok * 1024 + c0));
            nya[q4] = *(const uint2*)(Y + (size_t)s0 * 1024 + c0); nyb[q4] = *(const uint2*)(Y + (size_t)s1 * 1024 + c0);
        }
        if (tok + tstride < T_) { ns0 = toks[(tok + tstride) * 2]; ns1 = toks[(tok + tstride) * 2 + 1]; ng0 = tokg[(tok + tstride) * 2]; ng1 = tokg[(tok + tstride) * 2 + 1]; }
    }
#pragma unroll 1
    for (; tok < T_; tok += tstride) {
        const int b = tok >> 14;
        if (b != cur_b) {
            cur_b = b;
#pragma unroll
            for (int q4 = 0; q4 < 4; ++q4) {
                const int c0 = 4 * lane + 256 * q4;
                pga[q4] = *(const float4*)(ada + b * 6144 + 5120 + c0);
                if (layer < 3) {
                    const float4 sh = *(const float4*)(adan + b * 6144 + c0), sc = *(const float4*)(adan + b * 6144 + 1024 + c0);
                    pG2[q4] = make_float4(pg[q4].x * (1.f + sc.x), pg[q4].y * (1.f + sc.y), pg[q4].z * (1.f + sc.z), pg[q4].w * (1.f + sc.w));
                    pB2[q4] = make_float4(pb[q4].x * (1.f + sc.x) + sh.x, pb[q4].y * (1.f + sc.y) + sh.y, pb[q4].z * (1.f + sc.z) + sh.z, pb[q4].w * (1.f + sc.w) + sh.w);
                }
            }
        }
        const float g0 = cg0, g1 = cg1;
        float* xr = p.out() + (size_t)tok * 1024;
        u16* xbr = (u16*)p.out() + (size_t)T_ * 1024 + (size_t)tok * 1024;
        float v[16];
#pragma unroll
        for (int q4 = 0; q4 < 4; ++q4) {
            const int c0 = 4 * lane + 256 * q4;
            const float4 x = nx[q4];
            const uint2 ya = nya[q4], yb = nyb[q4];
            const float4 gg = pga[q4];
            v[q4 * 4 + 0] = ALPHA_F * x.x + gg.x * (g0 * lo2f(ya.x) + g1 * lo2f(yb.x));
            v[q4 * 4 + 1] = ALPHA_F * x.y + gg.y * (g0 * hi2f(ya.x) + g1 * hi2f(yb.x));
            v[q4 * 4 + 2] = ALPHA_F * x.z + gg.z * (g0 * lo2f(ya.y) + g1 * lo2f(yb.y));
            v[q4 * 4 + 3] = ALPHA_F * x.w + gg.w * (g0 * hi2f(ya.y) + g1 * hi2f(yb.y));
        }
        {
            const int tn = tok + tstride;
            if (tn < T_) {
                cg0 = ng0; cg1 = ng1;
#pragma unroll
                for (int q4 = 0; q4 < 4; ++q4) {
                    const int c0 = 4 * lane + 256 * q4;
                    nx[q4] = up4(*(const uint2*)(X1 + (size_t)tn * 1024 + c0));
                    nya[q4] = *(const uint2*)(Y + (size_t)ns0 * 1024 + c0); nyb[q4] = *(const uint2*)(Y + (size_t)ns1 * 1024 + c0);
                }
                const int t2 = tn + tstride;
                if (t2 < T_) { ns0 = toks[t2 * 2]; ns1 = toks[t2 * 2 + 1]; ng0 = tokg[t2 * 2]; ng1 = tokg[t2 * 2 + 1]; }
            }
        }
        float sm = 0.f;
#pragma unroll
        for (int e = 0; e < 16; ++e) sm += v[e];
        const float mean = wave_sum(sm) * (1.0f / 1024.0f);
        float sq = 0.f;
#pragma unroll
        for (int e = 0; e < 16; ++e) { v[e] -= mean; sq += v[e] * v[e]; }
        const float rstd = rsqrtf(wave_sum(sq) * (1.0f / 1024.0f) + 1e-5f);
#pragma unroll
        for (int q4 = 0; q4 < 4; ++q4) {
            const int c0 = 4 * lane + 256 * q4;
            const float4 gg = pg[q4], bb = pb[q4];
            const float z0 = v[q4 * 4 + 0] * rstd, z1 = v[q4 * 4 + 1] * rstd, z2 = v[q4 * 4 + 2] * rstd, z3 = v[q4 * 4 + 3] * rstd;
            float4 y;
            y.x = z0 * gg.x + bb.x; y.y = z1 * gg.y + bb.y; y.z = z2 * gg.z + bb.z; y.w = z3 * gg.w + bb.w;
            if (layer == 3) *(float4*)(xr + c0) = y;
            if (layer < 3) {
                *(uint2*)(xbr + c0) = make_uint2(pack2(y.x, y.y), pack2(y.z, y.w));
                const float4 G2 = pG2[q4], B2 = pB2[q4];
                uint2 o; o.x = pack2(z0 * G2.x + B2.x, z1 * G2.y + B2.y); o.y = pack2(z2 * G2.z + B2.z, z3 * G2.w + B2.w);
                *(uint2*)(hb + (size_t)tok * 1024 + c0) = o;
            }
        }
    }
}

__device__ __forceinline__ void phase_hdn(const PP p, int i) {
    const int t = tid_opaque(); const int lane = t & 63, wid = t >> 6;
    const float* w1 = p.in(28) + (size_t)i * 33 * 64; const float* w2 = p.in(30) + (size_t)i * 4096; const float* w3 = p.in(32) + (size_t)i * 4096;
    const float b1 = p.in(29)[i * 64 + lane], b2 = p.in(31)[i * 64 + lane], b3 = p.in(33)[i * 64 + lane], frq = p.in(34)[i * 64 + lane];
    float W1c[33], W2c[64], W3c[64];
#pragma unroll
    for (int q = 0; q < 33; ++q) W1c[q] = w1[q * 64 + lane];
#pragma unroll
    for (int q = 0; q < 64; ++q) { W2c[q] = w2[q * 64 + lane]; W3c[q] = w3[q * 64 + lane]; }
    u16* hdn = (u16*)(p.ws() + OFF_HDN) + (size_t)i * L_ * 64;
    const float two_pi_over_L = (float)(6.283185307179586 / 16384.0);
    for (int l = blockIdx.x * 8 + wid; l < L_; l += gridDim.x * 8) {
        float zv = 0.f;
        if (lane == 0) zv = (float)l / (float)(L_ - 1);
        else if (lane <= 32) {
            const int bnd = (lane - 1) & 15;
            const float fb = 1e-4f + (float)bnd * ((15.0f - 1e-4f) / 15.0f);
            const float ang = (two_pi_over_L * (float)l) * fb;
            zv = (lane <= 16) ? cosf(ang) : -sinf(ang);
        }
        float pre = b1;
#pragma unroll
        for (int q = 0; q < 33; ++q) pre += __int_as_float(__builtin_amdgcn_readlane(__float_as_int(zv), q)) * W1c[q];
        float hcur = sinf(frq * pre);
        pre = b2;
#pragma unroll
        for (int q = 0; q < 64; ++q) pre += __int_as_float(__builtin_amdgcn_readlane(__float_as_int(hcur), q)) * W2c[q];
        hcur = sinf(frq * pre);
        pre = b3;
#pragma unroll
        for (int q = 0; q < 64; ++q) pre += __int_as_float(__builtin_amdgcn_readlane(__float_as_int(hcur), q)) * W3c[q];
        hcur = sinf(frq * pre);
        hdn[(size_t)l * 64 + lane] = f2bf(hcur);
    }
}

struct EpiUT {
    u16* UT;
    __device__ __forceinline__ void operator()(const f32x4 (&acc)[2][2][4][2], const g8::Unit& u, int wr, int wc, int fr, int fq) const {
#pragma unroll
        for (int ai = 0; ai < 2; ++ai)
#pragma unroll
            for (int m = 0; m < 4; ++m) {
                const int ch = u.pm * 256 + ai * 128 + wr * 64 + m * 16 + fr;
#pragma unroll
                for (int bj = 0; bj < 2; ++bj) {
                    const int tk = u.pn * 256 + bj * 128 + wc * 32 + fq * 8;
                    const int b = tk >> 14, t0 = tk & (L_ - 1);
                    const f32x4 v0 = acc[ai][bj][m][0], v1 = acc[ai][bj][m][1];
                    *(uint4*)(UT + ((size_t)(b * 3072 + ch)) * L_ + t0) = make_uint4(pack2(v0[0], v0[1]), pack2(v0[2], v0[3]), pack2(v1[0], v1[1]), pack2(v1[2], v1[3]));
                }
            }
    }
};
__device__ __forceinline__ void phase_g3(const PP p, char* smem, int i) {
    SchedGrid S; S.A = p.ws() + OFF_WINH + (size_t)i * 3072 * 1024 * 2; S.B = p.ws() + OFF_HBUF; S.nunits = 12 * 128; S.npn = 128;
    S.astep = (size_t)256 * 1024 * 2; S.bstep = (size_t)256 * 1024 * 2;
    EpiUT E; E.UT = (u16*)(p.ws() + HY_UT);
    g8::gemm<true, false>((G8_LAS unsigned char*)smem, 1024, 1024, 1024, nullptr, S, E);
}

__device__ __forceinline__ void phase_taps(const PP p, char* smem, int i) {
    const u16* A = (const u16*)(p.ws() + OFF_W4T) + (size_t)i * 4096 * 64;
    const u16* B = (const u16*)(p.ws() + OFF_HDN) + (size_t)i * L_ * 64;
    u16* taps = (u16*)(p.ws() + HY_TAPS);
    auto dec = [&](int id) __attribute__((always_inline)) { SKTile tl; tl.A = A + (size_t)(id >> 7) * 256 * 64; tl.lda = 64; tl.B = B + (size_t)(id & 127) * 128 * 64; tl.ldb = 64; tl.nk = 1; return tl; };
    auto epi = [&](int id, f32x4 (&acc)[4][4]) __attribute__((always_inline)) {
        const int tm = id >> 7, tn = id & 127;
        EPI_T( const int row = tm * 256 + r, col = tn * 128 + c0; const int ch = row & 1023;
               const float ad = 3.070113457325394f + (float)ch * (12.280453829301576f / 1023.0f);
               float tv[4];
               _Pragma("unroll") for (int j = 0; j < 4; ++j) { const float tl = (float)(col + j) * (1.0f / (float)(L_ - 1)); tv[j] = v[j] * __expf(-tl * ad); }
               *(uint2*)(taps + (size_t)row * L_ + col) = make_uint2(pack2(tv[0], tv[1]), pack2(tv[2], tv[3])); )
    };
    gemm_smallk_loop<true>((u16*)smem, 16 * 128, dec, epi);
}

__device__ __forceinline__ float2 cmul(float2 a, float2 b) { return make_float2(a.x * b.x - a.y * b.y, a.x * b.y + a.y * b.x); }
__device__ __forceinline__ void fft_fwd(float2* X) {
    const int t = threadIdx.x;
#pragma unroll 1
    for (int s = 0; s < 7; ++s) {
        const int lq = 12 - 2 * s, q = 1 << lq;
        const float invM = 1.0f / (float)(q << 2);
        __syncthreads();
        const bool shared_tw = (lq <= 9);
        float2 w1c = make_float2(1.f, 0.f), w2c = w1c, w3c = w1c;
        if (shared_tw) { const float rv = (float)(t & (q - 1)) * invM; w1c = make_float2(__builtin_amdgcn_cosf(rv), -__builtin_amdgcn_sinf(rv)); w2c = cmul(w1c, w1c); w3c = cmul(w2c, w1c); }
#pragma unroll 1
        for (int hb = 0; hb < 4; ++hb) {
            float2 a[2][4]; int bs[2];
#pragma unroll
            for (int u = 0; u < 2; ++u) {
                const int g = t + 512 * (hb * 2 + u), blk = g >> lq, j = g & (q - 1);
                bs[u] = (blk << (lq + 2)) + j;
                a[u][0] = X[bs[u]]; a[u][1] = X[bs[u] + q]; a[u][2] = X[bs[u] + 2 * q]; a[u][3] = X[bs[u] + 3 * q];
            }
#pragma unroll
            for (int u = 0; u < 2; ++u) {
                float2 w1 = w1c, w2 = w2c, w3 = w3c;
                if (!shared_tw) {
                    const int j = bs[u] & (q - 1);
                    const float rev = (float)j * invM;
                    w1 = make_float2(__builtin_amdgcn_cosf(rev), -__builtin_amdgcn_sinf(rev));
                    w2 = cmul(w1, w1); w3 = cmul(w2, w1);
                }
                const float2 a0 = a[u][0], a1 = a[u][1], a2 = a[u][2], a3 = a[u][3];
                const float2 b0 = make_float2(a0.x + a2.x, a0.y + a2.y), b1 = make_float2(a0.x - a2.x, a0.y - a2.y);
                const float2 b2 = make_float2(a1.x + a3.x, a1.y + a3.y), b3 = make_float2(a1.x - a3.x, a1.y - a3.y);
                const float2 y0 = make_float2(b0.x + b2.x, b0.y + b2.y), y2 = make_float2(b0.x - b2.x, b0.y - b2.y);
                const float2 y1 = make_float2(b1.x + b3.y, b1.y - b3.x), y3 = make_float2(b1.x - b3.y, b1.y + b3.x);
                X[bs[u]] = y0; X[bs[u] + q] = cmul(y1, w1); X[bs[u] + 2 * q] = cmul(y2, w2); X[bs[u] + 3 * q] = cmul(y3, w3);
                __builtin_amdgcn_sched_barrier(0);
            }
        }
    }
    __syncthreads();
}
__device__ __forceinline__ void fft_inv(float2* X) {
    const int t = threadIdx.x;
#pragma unroll 1
    for (int s = 6; s >= 0; --s) {
        const int lq = 12 - 2 * s, q = 1 << lq;
        const float invM = 1.0f / (float)(q << 2);
        __syncthreads();
        const bool shared_tw = (lq <= 9);
        float2 w1c = make_float2(1.f, 0.f), w2c = w1c, w3c = w1c;
        if (shared_tw) { const float rv = (float)(t & (q - 1)) * invM; w1c = make_float2(__builtin_amdgcn_cosf(rv), __builtin_amdgcn_sinf(rv)); w2c = cmul(w1c, w1c); w3c = cmul(w2c, w1c); }
#pragma unroll 1
        for (int hb = 0; hb < 4; ++hb) {
            float2 a[2][4]; int bs[2];
#pragma unroll
            for (int u = 0; u < 2; ++u) {
                const int g = t + 512 * (hb * 2 + u), blk = g >> lq, j = g & (q - 1);
                bs[u] = (blk << (lq + 2)) + j;
                a[u][0] = X[bs[u]]; a[u][1] = X[bs[u] + q]; a[u][2] = X[bs[u] + 2 * q]; a[u][3] = X[bs[u] + 3 * q];
            }
#pragma unroll
            for (int u = 0; u < 2; ++u) {
                float2 w1 = w1c, w2 = w2c, w3 = w3c;
                if (!shared_tw) {
                    const int j = bs[u] & (q - 1);
                    const float rev = (float)j * invM;
                    w1 = make_float2(__builtin_amdgcn_cosf(rev), __builtin_amdgcn_sinf(rev));
                    w2 = cmul(w1, w1); w3 = cmul(w2, w1);
                }
                const float2 c0 = a[u][0], c1 = cmul(a[u][1], w1), c2 = cmul(a[u][2], w2), c3 = cmul(a[u][3], w3);
                const float2 e0 = make_float2(c0.x + c2.x, c0.y + c2.y), e1 = make_float2(c0.x - c2.x, c0.y - c2.y);
                const float2 e2 = make_float2(c1.x + c3.x, c1.y + c3.y), e3 = make_float2(c1.x - c3.x, c1.y - c3.y);
                X[bs[u]] = make_float2(e0.x + e2.x, e0.y + e2.y);
                X[bs[u] + q] = make_float2(e1.x - e3.y, e1.y + e3.x);
                X[bs[u] + 2 * q] = make_float2(e0.x - e2.x, e0.y - e2.y);
                X[bs[u] + 3 * q] = make_float2(e1.x + e3.y, e1.y - e3.x);
                __builtin_amdgcn_sched_barrier(0);
            }
        }
    }
    __syncthreads();
}
__device__ __forceinline__ void cv8(const uint4 u, const u16 pv, const u16 nv, int n0, float w0, float w1, float w2, float cb, float (&out)[8]) {
    float v[10];
    v[0] = (n0 > 0) ? bf2f(pv) : 0.f;
    v[1] = lo2f(u.x); v[2] = hi2f(u.x); v[3] = lo2f(u.y); v[4] = hi2f(u.y); v[5] = lo2f(u.z); v[6] = hi2f(u.z); v[7] = lo2f(u.w); v[8] = hi2f(u.w);
    v[9] = (n0 + 8 < L_) ? bf2f(nv) : 0.f;
#pragma unroll
    for (int e = 0; e < 8; ++e) out[e] = w0 * v[e] + w1 * v[e + 1] + w2 * v[e + 2] + cb;
}

constexpr int HLD2 = 136;
__device__ __forceinline__ bf16x8 neg8(bf16x8 v) { union { bf16x8 v; unsigned u[4]; } c; c.v = v; c.u[0] ^= 0x80008000u; c.u[1] ^= 0x80008000u; c.u[2] ^= 0x80008000u; c.u[3] ^= 0x80008000u; return c.v; }
template <int MODE>
__device__ __forceinline__ void cmm128(const u16* A0, const u16* A1, const u16* B0, const u16* B1, int wid, int fr, int fq, f32x4 (&accr)[8], f32x4 (&acci)[8]) {
#pragma unroll
    for (int nt = 0; nt < 8; ++nt) { accr[nt] = f32x4{0.f, 0.f, 0.f, 0.f}; acci[nt] = f32x4{0.f, 0.f, 0.f, 0.f}; }
    const u16* a0p = A0 + (16 * wid + fr) * HLD2 + 8 * fq; const u16* a1p = A1 + (16 * wid + fr) * HLD2 + 8 * fq;
    const u16* b0p = B0 + fr * HLD2 + 8 * fq; const u16* b1p = B1 + fr * HLD2 + 8 * fq;
    bf16x8 a0 = *(const bf16x8*)a0p, a1 = *(const bf16x8*)a1p;
    bf16x8 b0 = *(const bf16x8*)b0p, b1 = *(const bf16x8*)b1p;
#pragma unroll 1
    for (int s = 0; s < 4; ++s) {
        const bf16x8 na = neg8(MODE == 1 ? a0 : a1);
        bf16x8 a0n = a0, a1n = a1;
#pragma unroll
        for (int nt = 0; nt < 8; ++nt) {
            bf16x8 b0n, b1n;
            if (nt < 7) { b0n = *(const bf16x8*)(b0p + (nt + 1) * 16 * HLD2 + 32 * s); b1n = *(const bf16x8*)(b1p + (nt + 1) * 16 * HLD2 + 32 * s); }
            else        { b0n = *(const bf16x8*)(b0p + 32 * (s + 1)); b1n = *(const bf16x8*)(b1p + 32 * (s + 1)); }
            if (nt == 3) { a0n = *(const bf16x8*)(a0p + 32 * (s + 1)); a1n = *(const bf16x8*)(a1p + 32 * (s + 1)); }
            __builtin_amdgcn_sched_barrier(0);
            accr[nt] = __builtin_amdgcn_mfma_f32_16x16x32_bf16(a0, b0, accr[nt], 0, 0, 0);
            acci[nt] = __builtin_amdgcn_mfma_f32_16x16x32_bf16(MODE == 1 ? na : a0, b1, acci[nt], 0, 0, 0);
            accr[nt] = __builtin_amdgcn_mfma_f32_16x16x32_bf16(MODE == 0 ? na : a1, b1, accr[nt], 0, 0, 0);
            acci[nt] = __builtin_amdgcn_mfma_f32_16x16x32_bf16(MODE == 2 ? na : a1, b0, acci[nt], 0, 0, 0);
            __builtin_amdgcn_sched_barrier(0);
            b0 = b0n; b1 = b1n;
        }
        a0 = a0n; a1 = a1n;
    }
}
template <int TW>
__device__ __forceinline__ void store_T128(const f32x4 (&accr)[8], const f32x4 (&acci)[8], u16* PR, u16* PI, int wid, int fr, int fq) {
    const int R0 = 16 * wid + 4 * fq;
#pragma unroll
    for (int nt = 0; nt < 8; ++nt) {
        const int col = 16 * nt + fr;
        float re[4], im[4];
#pragma unroll
        for (int j = 0; j < 4; ++j) {
            const float xr = accr[nt][j], xi = acci[nt][j];
            if (TW == 0) { re[j] = xr; im[j] = xi; }
            else {
                const float rev = (float)((R0 + j) * col) * (1.0f / 16384.0f);
                const float cs = __builtin_amdgcn_cosf(rev), sn = __builtin_amdgcn_sinf(rev);
                if (TW == 1) { re[j] = xr * cs + xi * sn; im[j] = xi * cs - xr * sn; }
                else         { re[j] = xr * cs - xi * sn; im[j] = xi * cs + xr * sn; }
            }
        }
        *(uint2*)(PR + col * HLD2 + R0) = make_uint2(pack2(re[0], re[1]), pack2(re[2], re[3]));
        *(uint2*)(PI + col * HLD2 + R0) = make_uint2(pack2(im[0], im[1]), pack2(im[2], im[3]));
        __builtin_amdgcn_sched_barrier(0);
    }
}
__device__ __forceinline__ void fft128_fwd(const u16* FC, const u16* FS, u16* DR, u16* DI, int wid, int fr, int fq, f32x4 (&accr)[8], f32x4 (&acci)[8]) {
    __syncthreads();
    cmm128<1>(DR, DI, FC, FS, wid, fr, fq, accr, acci);
    __syncthreads();
    store_T128<1>(accr, acci, DR, DI, wid, fr, fq);
    __syncthreads();
    cmm128<2>(FC, FS, DR, DI, wid, fr, fq, accr, acci);
}
__device__ __forceinline__ void fft128_inv(const u16* FC, const u16* FS, u16* DR, u16* DI, int wid, int fr, int fq, f32x4 (&accr)[8], f32x4 (&acci)[8]) {
    __syncthreads();
    store_T128<0>(accr, acci, DR, DI, wid, fr, fq);
    __syncthreads();
    cmm128<0>(DR, DI, FC, FS, wid, fr, fq, accr, acci);
    __syncthreads();
    store_T128<2>(accr, acci, DR, DI, wid, fr, fq);
    __syncthreads();
    cmm128<0>(FC, FS, DR, DI, wid, fr, fq, accr, acci);
}

__device__ __forceinline__ void phase_hyena(const PP p, char* smem, int i) {
    const int t_outer = tid_opaque();
    int t = t_outer; int lane = t & 63, wid = t >> 6, fr = lane & 15, fq = lane >> 4;
    u16* FC = (u16*)smem; u16* FS = FC + 128 * HLD2; u16* DR = FS + 128 * HLD2; u16* DI = DR + 128 * HLD2;
    unsigned* TT = (unsigned*)DR;
    float* red = (float*)(smem + 4 * 128 * HLD2 * 2);
    const u16* taps = (const u16*)(p.ws() + HY_TAPS);
    const u16* UT = (const u16*)(p.ws() + HY_UT);
    u16* Y2T = (u16*)(p.ws() + HY_Y2T);
    unsigned* zT = (unsigned*)(p.ws() + HY_Y1) + (size_t)blockIdx.x * 65536;
    float4* AS = (float4*)(p.ws() + HY_SPEC) + (size_t)blockIdx.x * 8192;
    const float* cw = p.in(26) + (size_t)i * 3 * 3072; const float* cbp = p.in(27) + (size_t)i * 3072;
    const float invN = 1.0f / 32768.0f;
    __syncthreads();
    for (int e = t; e < 128 * 128; e += NTHR) {
        const int u = e >> 7, v = e & 127;
        const float rev = (float)((u * v) & 127) * (1.0f / 128.0f);
        FC[u * HLD2 + v] = f2bf(__builtin_amdgcn_cosf(rev)); FS[u * HLD2 + v] = f2bf(__builtin_amdgcn_sinf(rev));
    }
#pragma unroll 1
    for (int c = blockIdx.x; c < 1024; c += gridDim.x) {
        __syncthreads();
#pragma unroll 1
        for (int arr = 0; arr < 3; ++arr) {
            const int ch = (arr == 0) ? (2048 + c) : ((arr == 1) ? c : (1024 + c));
            const float w0 = cw[ch], w1 = cw[3072 + ch], w2 = cw[6144 + ch], wb = cbp[ch];
            const u16* u0 = UT + (size_t)(0 * 3072 + ch) * L_; const u16* u1 = UT + (size_t)(1 * 3072 + ch) * L_;
            uint4 ua[4], ub[4]; unsigned pa[4], na[4], pb2[4], nb2[4];
#pragma unroll
            for (int g4 = 0; g4 < 4; ++g4) {
                const int n0 = 8 * (t + 512 * g4), np = max(n0 - 1, 0), nn = min(n0 + 8, L_ - 1);
                ua[g4] = *(const uint4*)(u0 + n0); ub[g4] = *(const uint4*)(u1 + n0);
                pa[g4] = u0[np]; na[g4] = u0[nn]; pb2[g4] = u1[np]; nb2[g4] = u1[nn];
            }
            __builtin_amdgcn_sched_barrier(0);
#pragma unroll
            for (int g4 = 0; g4 < 4; ++g4) asm volatile("" : "+v"(pa[g4]), "+v"(na[g4]), "+v"(pb2[g4]), "+v"(nb2[g4]));
#pragma unroll
            for (int g4 = 0; g4 < 4; ++g4) {
                const int n0 = 8 * (t + 512 * g4);
                float a[8], b[8];
                cv8(ua[g4], (u16)pa[g4], (u16)na[g4], n0, w0, w1, w2, wb, a); cv8(ub[g4], (u16)pb2[g4], (u16)nb2[g4], n0, w0, w1, w2, wb, b);
                unsigned* d = zT + arr * 16384 + n0;
                *(uint4*)d = make_uint4(pack2(a[0], b[0]), pack2(a[1], b[1]), pack2(a[2], b[2]), pack2(a[3], b[3]));
                *(uint4*)(d + 4) = make_uint4(pack2(a[4], b[4]), pack2(a[5], b[5]), pack2(a[6], b[6]), pack2(a[7], b[7]));
            }
        }
#pragma unroll 1
        for (int o = 0; o < 2; ++o) {
            const u16* tf = taps + (size_t)(o * 2048 + c) * L_;
            const u16* tg = taps + (size_t)(o * 2048 + 1024 + c) * L_;
            const float skip = p.in(36)[(size_t)(i * 2 + o) * 1024 + c];
            const unsigned* gT = zT + (1 + o) * 16384;
            float inv = 0.f;
            unsigned dpk[16], apk[32];
#pragma unroll
            for (int q = 0; q < 32; ++q) apk[q] = 0u;
#pragma unroll
            for (int q = 0; q < 16; ++q) dpk[q] = 0u;
#pragma unroll 1
            for (int half = 0; half < 2; ++half) {
                t = t_outer; asm volatile("" : "+v"(t)); lane = t & 63; wid = t >> 6; fr = lane & 15; fq = lane >> 4;
                f32x4 accr[8], acci[8];
                __syncthreads();
                {
                    if (half == 0) {
                        float fv[4][8], gv[4][8];
#pragma unroll
                        for (int k = 0; k < 4; ++k) {
                            const int task = t + 512 * k, b = task & 127, a0 = (task >> 7) * 8;
#pragma unroll
                            for (int e = 0; e < 8; ++e) {
                                const int n = 128 * (a0 + e) + b;
                                const u16 fu = tf[n], gu = tg[(L_ - n) & (L_ - 1)];
                                fv[k][e] = bf2f(fu); gv[k][e] = (n == 0) ? 0.f : bf2f(gu);
                            }
                        }
                        __builtin_amdgcn_sched_barrier(0);
#pragma unroll
                        for (int k = 0; k < 4; ++k)
#pragma unroll
                            for (int e = 0; e < 8; e += 2) dpk[k * 4 + (e >> 1)] = pack2(fv[k][e] - gv[k][e], fv[k][e + 1] - gv[k][e + 1]);
                        float ssum = 0.f;
#pragma unroll
                        for (int k = 0; k < 4; ++k)
#pragma unroll
                            for (int e = 0; e < 8; ++e) ssum += fabsf(fv[k][e]) + fabsf(gv[k][e]);
                        ssum = wave_sum(ssum);
                        if (lane == 0) red[wid] = ssum;
#pragma unroll
                        for (int k = 0; k < 4; ++k) {
                            const int task = t + 512 * k, b = task & 127, a0 = (task >> 7) * 8;
                            float xr[8];
#pragma unroll
                            for (int e = 0; e < 8; ++e) xr[e] = fv[k][e] + gv[k][e];
                            *(uint4*)(DR + b * HLD2 + a0) = make_uint4(pack2(xr[0], xr[1]), pack2(xr[2], xr[3]), pack2(xr[4], xr[5]), pack2(xr[6], xr[7]));
                            *(uint4*)(DI + b * HLD2 + a0) = make_uint4(0u, 0u, 0u, 0u);
                        }
                    } else {
#pragma unroll
                        for (int k = 0; k < 4; ++k) {
                            const int task = t + 512 * k, b = task & 127, a0 = (task >> 7) * 8;
                            float xr[8], xi[8];
#pragma unroll
                            for (int e = 0; e < 8; ++e) {
                                const int n = 128 * (a0 + e) + b;
                                const unsigned dq = dpk[k * 4 + (e >> 1)];
                                const float rev = (float)n * invN, dd = (e & 1) ? hi2f(dq) : lo2f(dq);
                                xr[e] = dd * __builtin_amdgcn_cosf(rev); xi[e] = -dd * __builtin_amdgcn_sinf(rev);
                            }
                            *(uint4*)(DR + b * HLD2 + a0) = make_uint4(pack2(xr[0], xr[1]), pack2(xr[2], xr[3]), pack2(xr[4], xr[5]), pack2(xr[6], xr[7]));
                            *(uint4*)(DI + b * HLD2 + a0) = make_uint4(pack2(xi[0], xi[1]), pack2(xi[2], xi[3]), pack2(xi[4], xi[5]), pack2(xi[6], xi[7]));
                        }
                    }
                }
                fft128_fwd(FC, FS, DR, DI, wid, fr, fq, accr, acci);
                if (half == 0) {
                    float tot = 0.f;
#pragma unroll
                    for (int q = 0; q < 8; ++q) tot += red[q];
                    inv = 1.0f / (tot + 1e-6f);
                }
                unsigned Fr[32];
#pragma unroll
                for (int nt = 0; nt < 8; ++nt)
#pragma unroll
                    for (int j = 0; j < 4; ++j) Fr[nt * 4 + j] = pack2(accr[nt][j] * inv, acci[nt][j] * inv);
                t = t_outer; asm volatile("" : "+v"(t)); lane = t & 63; wid = t >> 6; fr = lane & 15; fq = lane >> 4;
                __syncthreads();
                {
                    unsigned zq[4][8];
#pragma unroll
                    for (int k = 0; k < 4; ++k) {
                        const int task = t + 512 * k, b = task & 127, a0 = (task >> 7) * 8;
#pragma unroll
                        for (int e = 0; e < 8; ++e) zq[k][e] = zT[128 * (a0 + e) + b];
                    }
                    if (half == 0) {
#pragma unroll
                        for (int k = 0; k < 4; ++k) {
                            const int task = t + 512 * k, b = task & 127, a0 = (task >> 7) * 8;
                            const unsigned zz[8] = {zq[k][0], zq[k][1], zq[k][2], zq[k][3], zq[k][4], zq[k][5], zq[k][6], zq[k][7]};
                            *(uint4*)(DR + b * HLD2 + a0) = make_uint4((zz[0] & 0xffffu) | (zz[1] << 16), (zz[2] & 0xffffu) | (zz[3] << 16), (zz[4] & 0xffffu) | (zz[5] << 16), (zz[6] & 0xffffu) | (zz[7] << 16));
                            *(uint4*)(DI + b * HLD2 + a0) = make_uint4((zz[0] >> 16) | (zz[1] & 0xffff0000u), (zz[2] >> 16) | (zz[3] & 0xffff0000u), (zz[4] >> 16) | (zz[5] & 0xffff0000u), (zz[6] >> 16) | (zz[7] & 0xffff0000u));
                        }
                    } else {
#pragma unroll
                        for (int k = 0; k < 4; ++k) {
                            const int task = t + 512 * k, b = task & 127, a0 = (task >> 7) * 8;
                            const unsigned zz[8] = {zq[k][0], zq[k][1], zq[k][2], zq[k][3], zq[k][4], zq[k][5], zq[k][6], zq[k][7]};
                            float xr[8], xi[8];
#pragma unroll
                            for (int e = 0; e < 8; ++e) {
                                const float zr = lo2f(zz[e]), zi = hi2f(zz[e]);
                                const float rev = (float)(128 * (a0 + e) + b) * invN; const float cs = __builtin_amdgcn_cosf(rev), sn = __builtin_amdgcn_sinf(rev);
                                xr[e] = zr * cs + zi * sn; xi[e] = zi * cs - zr * sn;
                            }
                            *(uint4*)(DR + b * HLD2 + a0) = make_uint4(pack2(xr[0], xr[1]), pack2(xr[2], xr[3]), pack2(xr[4], xr[5]), pack2(xr[6], xr[7]));
                            *(uint4*)(DI + b * HLD2 + a0) = make_uint4(pack2(xi[0], xi[1]), pack2(xi[2], xi[3]), pack2(xi[4], xi[5]), pack2(xi[6], xi[7]));
                        }
                    }
                }
                fft128_fwd(FC, FS, DR, DI, wid, fr, fq, accr, acci);
                t = t_outer; asm volatile("" : "+v"(t)); lane = t & 63; wid = t >> 6; fr = lane & 15; fq = lane >> 4;
#pragma unroll
                for (int nt = 0; nt < 8; ++nt)
#pragma unroll
                    for (int j = 0; j < 4; ++j) {
                        const float fr_ = lo2f(Fr[nt * 4 + j]), fi_ = hi2f(Fr[nt * 4 + j]);
                        const float xr = accr[nt][j], xi = acci[nt][j];
                        accr[nt][j] = xr * fr_ - xi * fi_; acci[nt][j] = xr * fi_ + xi * fr_;
                    }
                unsigned zc[4][4], gc[4][4];
#pragma unroll
                for (int k = 0; k < 4; ++k)
#pragma unroll
                    for (int j = 0; j < 4; ++j) { zc[k][j] = 0u; gc[k][j] = 0u; }
                if (half == 1) {
#pragma unroll
                    for (int k = 0; k < 4; ++k)
#pragma unroll
                        for (int j = 0; j < 4; ++j) { const int ix = 128 * (16 * wid + 4 * fq + j) + 16 * k + fr; zc[k][j] = zT[ix]; gc[k][j] = gT[ix]; }
                }
                fft128_inv(FC, FS, DR, DI, wid, fr, fq, accr, acci);
                if (half == 0) {
#pragma unroll
                    for (int nt = 0; nt < 8; ++nt) {
#pragma unroll
                        for (int j = 0; j < 4; ++j) apk[nt * 4 + j] = pack2(accr[nt][j], acci[nt][j]);
                    }
                } else {
                    t = t_outer; asm volatile("" : "+v"(t)); lane = t & 63; wid = t >> 6; fr = lane & 15; fq = lane >> 4;
                    const int a0 = 16 * wid + 4 * fq;
#pragma unroll
                    for (int nb = 0; nb < 2; ++nb) {
                        unsigned zq4[4][4], gq4[4][4], zn4[4][4], gn4[4][4];
#pragma unroll
                        for (int k = 0; k < 4; ++k)
#pragma unroll
                            for (int j = 0; j < 4; ++j) { zq4[k][j] = zc[k][j]; gq4[k][j] = gc[k][j]; zn4[k][j] = 0u; gn4[k][j] = 0u; }
                        if (nb == 0) {
#pragma unroll
                            for (int k = 0; k < 4; ++k) {
                                const int b = 16 * (4 + k) + fr;
#pragma unroll
                                for (int j = 0; j < 4; ++j) { zn4[k][j] = zT[128 * (a0 + j) + b]; gn4[k][j] = gT[128 * (a0 + j) + b]; }
                            }
                        }
                        __builtin_amdgcn_sched_barrier(0);
#pragma unroll
                        for (int k = 0; k < 4; ++k) {
                            const int nt = 4 * nb + k, b = 16 * nt + fr;
                            const float are[4] = {lo2f(apk[nt * 4 + 0]), lo2f(apk[nt * 4 + 1]), lo2f(apk[nt * 4 + 2]), lo2f(apk[nt * 4 + 3])}, aim[4] = {hi2f(apk[nt * 4 + 0]), hi2f(apk[nt * 4 + 1]), hi2f(apk[nt * 4 + 2]), hi2f(apk[nt * 4 + 3])};
                            const unsigned zz[4] = {zq4[k][0], zq4[k][1], zq4[k][2], zq4[k][3]}, gg[4] = {gq4[k][0], gq4[k][1], gq4[k][2], gq4[k][3]};
                            unsigned yo[4];
#pragma unroll
                            for (int j = 0; j < 4; ++j) {
                                const int n = 128 * (a0 + j) + b;
                                const float rev = (float)n * invN; const float cs = __builtin_amdgcn_cosf(rev), sn = __builtin_amdgcn_sinf(rev);
                                const float br = accr[nt][j] * cs - acci[nt][j] * sn, bi = acci[nt][j] * cs + accr[nt][j] * sn;
                                const float yr = ((are[j] + br) * invN + lo2f(zz[j]) * skip) * lo2f(gg[j]);
                                const float yi = ((aim[j] + bi) * invN + hi2f(zz[j]) * skip) * hi2f(gg[j]);
                                yo[j] = pack2(yr, yi);
                                if (o == 1) { Y2T[(size_t)(0 * 1024 + c) * L_ + n] = (u16)(yo[j] & 0xffffu); Y2T[(size_t)(1 * 1024 + c) * L_ + n] = (u16)(yo[j] >> 16); }
                            }
                            if (o == 0) {
#pragma unroll
                                for (int j = 0; j < 4; ++j) zT[128 * (a0 + j) + b] = yo[j];
                            }
                        }
#pragma unroll
                        for (int k = 0; k < 4; ++k)
#pragma unroll
                            for (int j = 0; j < 4; ++j) { zc[k][j] = zn4[k][j]; gc[k][j] = gn4[k][j]; }
                    }
                }
            }
        }
    }
}

__device__ __forceinline__ void phase_transpose(const PP p, char* smem) {
    const int t = tid_opaque();
    u16* tile = (u16*)smem;
    const u16* Y2T = (const u16*)(p.ws() + HY_Y2T);
    u16* Y2 = (u16*)(p.ws() + HY_Y2);
    const int r = t >> 3, ch = t & 7;
    for (int base = blockIdx.x * 8; base < 8192; base += gridDim.x * 8) {
        uint4 u[8];
#pragma unroll
        for (int k = 0; k < 8; ++k) {
            const int id = base + k, b = id >> 12, c0 = ((id >> 8) & 15) * 64, n0 = (id & 255) * 64;
            u[k] = *(const uint4*)(Y2T + ((size_t)(b * 1024 + c0 + r)) * L_ + n0 + ch * 8);
        }
        __syncthreads();
#pragma unroll
        for (int k = 0; k < 8; ++k) {
            u16* d = tile + k * (64 * 66) + r * 66 + ch * 8;
            d[0] = (u16)(u[k].x & 0xffff); d[1] = (u16)(u[k].x >> 16); d[2] = (u16)(u[k].y & 0xffff); d[3] = (u16)(u[k].y >> 16);
            d[4] = (u16)(u[k].z & 0xffff); d[5] = (u16)(u[k].z >> 16); d[6] = (u16)(u[k].w & 0xffff); d[7] = (u16)(u[k].w >> 16);
        }
        __syncthreads();
#pragma unroll
        for (int k = 0; k < 8; ++k) {
            const int id = base + k, b = id >> 12, c0 = ((id >> 8) & 15) * 64, n0 = (id & 255) * 64;
            const u16* tk = tile + k * (64 * 66);
            unsigned w[4];
#pragma unroll
            for (int e = 0; e < 4; ++e) w[e] = (unsigned)tk[(ch * 8 + 2 * e) * 66 + r] | ((unsigned)tk[(ch * 8 + 2 * e + 1) * 66 + r] << 16);
            *(uint4*)(Y2 + ((size_t)b * L_ + n0 + r) * 1024 + c0 + ch * 8) = make_uint4(w[0], w[1], w[2], w[3]);
        }
    }
}

}

__device__ __forceinline__ PP pq(KP kp) { asm volatile("" : "+s"(kp)); PP r; r.k = kp; return r; }
__global__ void __launch_bounds__(512, 2) fwd_kernel(P p_unused) {
    KP kp = (KP)__builtin_amdgcn_kernarg_segment_ptr();
    extern __shared__ __attribute__((aligned(16))) char smem_raw[];
    char* smem = smem_raw + 16;
    if (threadIdx.x == 0) *(uint4*)smem_raw = make_uint4(0u, 0u, 0u, 0u);
    __syncthreads();
    (void)xcd_barrier_post((unsigned*)(pq(kp).ws() + OFF_BAR), (volatile LAS unsigned*)smem_raw);
#define GRID_BARRIER() do { XcdBarrier b_; b_.bar = (unsigned*)(pq(kp).ws() + OFF_BAR); b_.x = xb_xcc_id(); b_.st = (volatile LAS unsigned*)smem_raw; xcd_barrier(b_); } while (0)
    phase_prologue_a(pq(kp), smem);
    phase_hdn(pq(kp), 0);
    phase_hdn(pq(kp), 1);
    GRID_BARRIER();
    phase_prologue_b(pq(kp));
    GRID_BARRIER();
#pragma unroll 1
    for (int layer = 0; layer < 4; ++layer) {
        const int i = layer >> 1;
        if ((layer & 1) == 0) {
            phase_g1(pq(kp), smem, i);
            GRID_BARRIER();
            phase_na(pq(kp), smem, i);
            phase_rwprep(pq(kp), i);
            GRID_BARRIER();
            phase_lora(pq(kp), smem, i);
            GRID_BARRIER();
            phase_scanA(pq(kp), smem);
            GRID_BARRIER();
            phase_scanB1(pq(kp));
            GRID_BARRIER();
            phase_scanB2(pq(kp));
            GRID_BARRIER();
            phase_combine(pq(kp), i);
            GRID_BARRIER();
        } else {
            phase_g3(pq(kp), smem, i);
            __syncthreads();
            phase_taps(pq(kp), smem, i);
            GRID_BARRIER();
            phase_hyena(pq(kp), smem, i);
            GRID_BARRIER();
            phase_transpose(pq(kp), smem);
            GRID_BARRIER();
        }
        phase_gout(pq(kp), smem, (const u16*)(pq(kp).ws() + ((layer & 1) ? HY_Y2 : OFF_MIX)), (const u16*)(pq(kp).ws() + ((layer & 1) ? OFF_WOUTH : OFF_WOUTE)) + (size_t)i * 1024 * 1024, layer);
        GRID_BARRIER();
        phase_lna(pq(kp), smem, layer);
        GRID_BARRIER();
        phase_scatter(pq(kp), smem);
        GRID_BARRIER();
        phase_moe1(pq(kp), smem, layer);
        GRID_BARRIER();
        phase_moe2(pq(kp), smem, layer);
        GRID_BARRIER();
        phase_lnb(pq(kp), layer);
        GRID_BARRIER();
    }
}

extern "C" void kernel_launch(void* const* d_in, const int* in_sizes, int n_in,
                              void* d_out, int out_size, void* d_ws, size_t ws_size,
                              hipStream_t stream) {
    static int grid = 0;
    if (!grid) {
        int dev = 0, cus = 0, per_cu = 0;
        hipGetDevice(&dev);
        hipDeviceGetAttribute(&cus, hipDeviceAttributeMultiprocessorCount, dev);
        hipFuncSetAttribute((const void*)fwd_kernel, hipFuncAttributeMaxDynamicSharedMemorySize, LDS_BYTES);
        hipOccupancyMaxActiveBlocksPerMultiprocessor(&per_cu, fwd_kernel, NTHR, LDS_BYTES);
        if (per_cu < 1) { fprintf(stderr, "occupancy query returned %d\n", per_cu); per_cu = 1; }
        grid = cus;
    }
    if (ws_size < WS_NEED || n_in < 38) { fprintf(stderr, "workspace too small: %zu < %zu\n", ws_size, (size_t)WS_NEED); return; }
    hipMemsetAsync(d_ws, 0, XCD_BAR_WORDS * sizeof(unsigned), stream);
    P p{};
    for (int i = 0; i < 38; ++i) p.in[i] = (const float*)d_in[i];
    p.out = (float*)d_out; p.ws = (char*)d_ws;
    hipLaunchKernelGGL(fwd_kernel, dim3(grid), dim3(NTHR), LDS_BYTES, stream, p);
}
```
